# Optimizing an MI355X kernel written in HIP

```python
import jax, jax.numpy as jnp
from jax import lax
import numpy as np

D_MODEL = 1024
BATCH = 8
SEQ = 8192
DEPTH = 2

GRID_W = 64
CTX_LEN = 256
D_MIX = D_MODEL
D_CONV = D_MIX // 2
CONV_W = 3
D_MLSTM = D_MIX - D_CONV
N_HEADS = 4
HEAD_DIM = D_MLSTM // N_HEADS
CHUNK = 128
N_EXPERTS = 16
CAPACITY_FACTOR = 2
D_EXPERT = 1408
N_MOD = 6
EPS = 1e-6
D_PROJ = 3 * D_CONV + 4 * D_MLSTM + 4 * N_HEADS

kernel_name = "hybrid_conv_mlstm_ecmoe_dit"


def rmsnorm(x, g):
    xf = x.astype(jnp.float32)
    y = xf * lax.rsqrt(jnp.mean(xf * xf, axis=-1, keepdims=True) + EPS)
    return (y * g.astype(jnp.float32)).astype(x.dtype)


def split_mod(m):
    m = m.reshape(m.shape[0], N_MOD, D_MODEL)
    return [m[:, j, None, :] for j in range(N_MOD)]


def modulate(h, shift, scale):
    return h * (1 + scale) + shift


def split_proj(u):
    pts = [D_CONV, 2 * D_CONV, 3 * D_CONV,
           3 * D_CONV + D_MLSTM, 3 * D_CONV + 2 * D_MLSTM,
           3 * D_CONV + 3 * D_MLSTM, 3 * D_CONV + 4 * D_MLSTM]
    return jnp.split(u, pts, axis=-1)


def dwconv3(u, w, b):
    ch = u.shape[-1]
    y = lax.conv_general_dilated(u, w[:, None, :].astype(u.dtype), window_strides=(1,),
                                 padding=((CONV_W // 2, CONV_W // 2),),
                                 dimension_numbers=('NWC', 'WIO', 'NWC'), feature_group_count=ch)
    return y + b.astype(u.dtype)


def conv_rows(u, w, b):
    bn, n, ch = u.shape
    rows = n // GRID_W
    return dwconv3(u.reshape(bn * rows, GRID_W, ch), w, b).reshape(bn, n, ch)


def mlstm_inputs(q, k, v, gates, gate_b):
    bn, n, _ = q.shape
    def heads(t):
        return t.reshape(bn, n, N_HEADS, HEAD_DIM).transpose(0, 2, 1, 3).astype(jnp.float32)
    g = (gates.astype(jnp.float32) + gate_b.reshape(-1).astype(jnp.float32))
    g = g.reshape(bn, n, 4, N_HEADS).transpose(2, 0, 3, 1)
    return heads(q) * HEAD_DIM ** -0.5, heads(k), heads(v), g


def mlstm_scan(q, k, v, i_pre, log_f, state):
    bn, nh, n, dh = q.shape
    nc = n // CHUNK
    def chunks(t):
        return jnp.moveaxis(t.reshape(bn, nh, nc, CHUNK, *t.shape[3:]), 2, 0)
    incl = jnp.tril(jnp.ones((CHUNK, CHUNK), dtype=bool))

    def body(carry, xs):
        C, nv, m = carry
        qb, kb, vb, ib, fb = xs
        b = jnp.cumsum(fb, axis=-1)
        a = b + m[..., None]
        dmat = jnp.where(incl, b[..., :, None] - b[..., None, :] + ib[..., None, :], -jnp.inf)
        m_t = jnp.maximum(a, jnp.max(dmat, axis=-1))
        w_intra = jnp.exp(dmat - m_t[..., None])
        w_inter = jnp.exp(a - m_t)
        s = jnp.einsum('bhtk,bhsk->bhts', qb, kb) * w_intra
        num = w_inter[..., None] * jnp.einsum('bhtk,bhkv->bhtv', qb, C) + jnp.einsum('bhts,bhsv->bhtv', s, vb)
        den = w_inter * jnp.einsum('bhtk,bhk->bht', qb, nv) + jnp.sum(s, axis=-1)
        h = num / jnp.maximum(jnp.abs(den), jnp.exp(-m_t))[..., None]
        m_new = m_t[..., -1]
        w_state = jnp.exp(b[..., -1] + m - m_new)
        w_tok = jnp.exp(b[..., -1:] - b + ib - m_new[..., None])
        C_new = w_state[..., None, None] * C + jnp.einsum('bhs,bhsk,bhsv->bhkv', w_tok, kb, vb)
        n_new = w_state[..., None] * nv + jnp.einsum('bhs,bhsk->bhk', w_tok, kb)
        return (C_new, n_new, m_new), h

    state, h = lax.scan(body, state, tuple(chunks(t) for t in (q, k, v, i_pre, log_f)))
    return jnp.moveaxis(h, 0, 2).reshape(bn, nh, n, dh), state


def mlstm_bidir(pc, pl, gate_b):
    qc, kc, vc, gc = mlstm_inputs(pc[0], pc[1], pc[2], pc[3], gate_b)
    ql, kl, vl, gl = mlstm_inputs(pl[0], pl[1], pl[2], pl[3], gate_b)
    bn = ql.shape[0]
    init = (jnp.zeros((bn, N_HEADS, HEAD_DIM, HEAD_DIM), jnp.float32),
            jnp.zeros((bn, N_HEADS, HEAD_DIM), jnp.float32),
            jnp.zeros((bn, N_HEADS), jnp.float32))
    outs_c, outs_l = [], []
    for d in range(2):
        flip = (lambda t: jnp.flip(t, axis=2)) if d == 1 else (lambda t: t)
        i_c, f_c = gc[2 * d], jax.nn.log_sigmoid(gc[2 * d + 1])
        i_l, f_l = gl[2 * d], jax.nn.log_sigmoid(gl[2 * d + 1])
        h_c, st = mlstm_scan(flip(qc), flip(kc), flip(vc), flip(i_c), flip(f_c), init)
        h_l, _ = mlstm_scan(flip(ql), flip(kl), flip(vl), flip(i_l), flip(f_l), st)
        outs_c.append(flip(h_c))
        outs_l.append(flip(h_l))
    return outs_c[0] + outs_c[1], outs_l[0] + outs_l[1]


def mlstm_out(h, o, g_head, dtype):
    hn = h * lax.rsqrt(jnp.mean(h * h, axis=-1, keepdims=True) + EPS) * g_head.astype(jnp.float32)[None, :, None, :]
    bn, nh, n, dh = h.shape
    hn = hn.transpose(0, 2, 1, 3).reshape(bn, n, nh * dh)
    return (jax.nn.sigmoid(o.astype(jnp.float32)) * hn).astype(dtype)


def mixer(p_self, h_mlstm, conv_fn, conv_w, conv_b, g_head, w_out):
    b_gate, c_gate, x_in, o = p_self[0], p_self[1], p_self[2], p_self[6]
    y_conv = b_gate * conv_fn(c_gate * x_in, conv_w, conv_b)
    y_mlstm = mlstm_out(h_mlstm, o, g_head, b_gate.dtype)
    return jnp.concatenate([y_conv, y_mlstm], axis=-1) @ w_out


def expert_choice_moe(h, w_router, w_gate, w_up, w_down):
    n = h.shape[1]
    cap = CAPACITY_FACTOR * n // N_EXPERTS

    def one_set(hs):
        aff = jax.nn.softmax(jnp.einsum('nd,de->en', hs, w_router).astype(jnp.float32), axis=0)
        g, idx = lax.top_k(aff, cap)
        xe = hs[idx]
        a = jnp.einsum('ecd,edf->ecf', xe, w_gate)
        u = jnp.einsum('ecd,edf->ecf', xe, w_up)
        ye = jnp.einsum('ecf,efd->ecd', jax.nn.silu(a) * u, w_down) * g[..., None].astype(hs.dtype)
        return jax.ops.segment_sum(ye.reshape(-1, hs.shape[-1]), idx.reshape(-1), num_segments=n)

    return lax.map(one_set, h)


def setup_inputs(seed: int = 0) -> dict:
    key = jax.random.key(seed)
    ks = jax.random.split(key, 24)
    def nrm(k, shape, s):
        return jax.random.normal(k, shape, jnp.float32) * s
    d = D_MODEL
    gate_b = jnp.stack([nrm(ks[10], (DEPTH, N_HEADS), 0.1),
                        3.0 + 3.0 * jax.random.uniform(ks[11], (DEPTH, N_HEADS), jnp.float32),
                        nrm(ks[12], (DEPTH, N_HEADS), 0.1),
                        3.0 + 3.0 * jax.random.uniform(ks[13], (DEPTH, N_HEADS), jnp.float32)], axis=1)
    return {
        "x": nrm(ks[0], (BATCH, SEQ, d), 1.0),
        "c": nrm(ks[1], (BATCH, d), 1.0),
        "ctx": nrm(ks[2], (BATCH, CTX_LEN, d), 1.0),
        "c_ctx": nrm(ks[3], (d,), 1.0),
        "w_mod": nrm(ks[4], (DEPTH, d, N_MOD * d), 0.5 * d ** -0.5),
        "b_mod": nrm(ks[5], (DEPTH, N_MOD * d), 0.01),
        "g_norm1": 1.0 + nrm(ks[6], (DEPTH, d), 0.02),
        "g_norm2": 1.0 + nrm(ks[7], (DEPTH, d), 0.02),
        "w_in": nrm(ks[8], (DEPTH, d, D_PROJ), d ** -0.5),
        "w_out": nrm(ks[9], (DEPTH, D_MIX, d), D_MIX ** -0.5),
        "conv_w": nrm(ks[14], (DEPTH, CONV_W, D_CONV), CONV_W ** -0.5),
        "conv_b": nrm(ks[15], (DEPTH, D_CONV), 0.01),
        "gate_b": gate_b,
        "g_head": 1.0 + nrm(ks[16], (DEPTH, N_HEADS, HEAD_DIM), 0.02),
        "w_router": nrm(ks[17], (DEPTH, d, N_EXPERTS), d ** -0.5),
        "w_gate_e": nrm(ks[18], (DEPTH, N_EXPERTS, d, D_EXPERT), d ** -0.5),
        "w_up_e": nrm(ks[19], (DEPTH, N_EXPERTS, d, D_EXPERT), d ** -0.5),
        "w_down_e": nrm(ks[20], (DEPTH, N_EXPERTS, D_EXPERT, d), D_EXPERT ** -0.5),
        "g_final": 1.0 + nrm(ks[21], (d,), 0.02),
    }


def reference(x, c, ctx, c_ctx, w_mod, b_mod, g_norm1, g_norm2, w_in, w_out, conv_w, conv_b,
              gate_b, g_head, w_router, w_gate_e, w_up_e, w_down_e, g_final):
    xl, xc = x, ctx
    for layer in range(DEPTH):
        last = layer == DEPTH - 1
        ml = split_mod(jax.nn.silu(c) @ w_mod[layer] + b_mod[layer])
        mc = split_mod(jax.nn.silu(c_ctx)[None] @ w_mod[layer] + b_mod[layer])

        hl = modulate(rmsnorm(xl, g_norm1[layer]), ml[0], ml[1])
        hc = modulate(rmsnorm(xc, g_norm1[layer]), mc[0], mc[1])
        pl = split_proj(hl @ w_in[layer])
        pc = split_proj(hc @ w_in[layer])
        hm_c, hm_l = mlstm_bidir((pc[3], pc[4], pc[5], pc[7]), (pl[3], pl[4], pl[5], pl[7]), gate_b[layer])
        yl = mixer(pl, hm_l, conv_rows, conv_w[layer], conv_b[layer], g_head[layer], w_out[layer])
        xl = xl + ml[2] * yl
        if not last:
            yc = mixer(pc, hm_c, dwconv3, conv_w[layer], conv_b[layer], g_head[layer], w_out[layer])
            xc = xc + mc[2] * yc

        hl = modulate(rmsnorm(xl, g_norm2[layer]), ml[3], ml[4])
        xl = xl + ml[5] * expert_choice_moe(hl, w_router[layer], w_gate_e[layer], w_up_e[layer], w_down_e[layer])
        if not last:
            hc = modulate(rmsnorm(xc, g_norm2[layer]), mc[3], mc[4])
            xc = xc + mc[5] * expert_choice_moe(hc, w_router[layer], w_gate_e[layer], w_up_e[layer], w_down_e[layer])
    return rmsnorm(xl, g_final)
```

```cpp
#include <hip/hip_runtime.h>
#include <cstdio>
#include <cstdint>

#ifndef MK_ONE_LAUNCH
#define MK_ONE_LAUNCH 0
#endif

#define GAS __attribute__((address_space(1)))
#define LAS __attribute__((address_space(3)))
typedef unsigned short bf16;
typedef short bf16x8 __attribute__((ext_vector_type(8)));
typedef short s16x4 __attribute__((ext_vector_type(4)));
typedef float f32x4 __attribute__((ext_vector_type(4)));
typedef float f32x2 __attribute__((ext_vector_type(2)));
typedef unsigned u32x4 __attribute__((ext_vector_type(4)));
typedef unsigned u32x2 __attribute__((ext_vector_type(2)));

constexpr int D = 1024, NB = 8, SEQ = 8192, CTXL = 256, DEPTH = 2;
constexpr int NLAT = NB * SEQ, NCTX = NB * CTXL, NTOK = NLAT + NCTX;
constexpr int DPROJ = 3600, NU = 3584;
constexpr int NH = 4, DH = 128, NCH_C = 2, NCH_L = 64, NCH = 66;
constexpr int NE = 16, DE = 1408, CAP_L = 1024, CAP_C = 32;
constexpr int NSLOT_L = NB * NE * CAP_L, NSLOT = NSLOT_L + NB * NE * CAP_C;
constexpr int NMOD = 6;
constexpr float EPS = 1e-6f;
constexpr float LOG2E = 1.4426950408889634f;
constexpr int UC_B = 0, UC_C = 512, UC_X = 1024, UC_Q = 1536, UC_K = 2048, UC_V = 2560, UC_O = 3072;

constexpr size_t MiB = 1u << 20;
constexpr size_t WS_CTL = 0, CTL_ZERO_BYTES = 1 * MiB;
constexpr size_t WS_MODV = 1 * MiB;
constexpr size_t WS_WG = 1 * MiB + 512 * 1024;
constexpr size_t WS_WR = WS_WG + 64 * 1024;
constexpr size_t WS_GATES = 2 * MiB;
constexpr size_t WS_AFFT = 7 * MiB;
constexpr size_t WS_INV = 12 * MiB;
constexpr size_t WS_IDX = 17 * MiB;
constexpr size_t WS_GSEL = 18 * MiB;
constexpr size_t WS_SCAL = 19 * MiB;
constexpr size_t WS_NS = 20 * MiB;
constexpr size_t WS_XC = 24 * MiB;
constexpr size_t WS_WIN = 32 * MiB;
constexpr size_t WS_WOUT = 39 * MiB;
constexpr size_t WS_WGU = 41 * MiB;
constexpr size_t WS_WD = 129 * MiB;
constexpr size_t WS_H = 173 * MiB;
constexpr size_t WS_R = 305 * MiB;
constexpr size_t WS_U = WS_R;
constexpr size_t WS_CS = WS_R + 462 * MiB;
constexpr size_t WS_XE = WS_R;
constexpr size_t WS_HM = WS_R + 264 * MiB;
constexpr size_t WS_END = WS_R + 627 * MiB;
static_assert((size_t)NTOK * NU * 2 == 462 * MiB && (size_t)NSLOT * 1024 * 2 == 264 * MiB && (size_t)NSLOT * DE * 2 == 363 * MiB, "sizes");
static_assert(WS_CS + (size_t)NB * NH * NCH * 2 * 32768 <= WS_END, "CS");

constexpr int RING_BYTES = 131072, TAB_OFF = 131072, TAB_BYTES = 16384, MISC_OFF = TAB_OFF + TAB_BYTES, LDS_BYTES = MISC_OFF + 256;

__device__ __forceinline__ unsigned cvt_pk_bf16(float lo, float hi) { unsigned r; asm volatile("v_cvt_pk_bf16_f32 %0, %1, %2" : "=v"(r) : "v"(lo), "v"(hi)); return r; }
__device__ __forceinline__ float bf_lo(unsigned w) { return __uint_as_float(w << 16); }
__device__ __forceinline__ float bf_hi(unsigned w) { return __uint_as_float(w & 0xffff0000u); }
__device__ __forceinline__ float wave_sum(float v) {
#pragma unroll
    for (int o = 1; o < 64; o <<= 1) v += __shfl_xor(v, o);
    return v;
}
__device__ __forceinline__ float fexp2(float x) { return __builtin_amdgcn_exp2f(x); }
__device__ __forceinline__ float fexp(float x) { return __builtin_amdgcn_exp2f(x * LOG2E); }
#define LDS_WAIT() asm volatile("s_waitcnt lgkmcnt(0)" ::: "memory")
#define VM_WAIT() asm volatile("s_waitcnt vmcnt(0)" ::: "memory")

namespace pg8 {
constexpr int BM = 256, BK = 64, HALF = 128, HTB = HALF * BK * 2, STAGE_BYTES = 8 * HTB, NXCD = 8, WGM = 8;
__host__ __device__ __forceinline__ int lds_byte(int r, int c) { const int st = (r >> 4) * 2 + (c >> 5), rr = r & 15, cc = c & 31, ob = rr * 64 + cc * 2; return st * 1024 + (ob ^ (((ob >> 9) & 1) << 5)); }
__host__ __device__ __forceinline__ void stage_rc(int b, int& R, int& C) { const int st = b / 1024, sb = b % 1024, swz = sb ^ (((sb >> 9) & 1) << 5); R = (st >> 1) * 16 + swz / 64; C = (st & 1) * 32 + (swz % 64) / 2; }
__host__ __device__ __forceinline__ int perm32(int rho) { const int n = rho >> 4, i = rho & 15; return 8 * (i >> 2) + 4 * n + (i & 3); }

struct Unit { int pm, pn, bt; };
struct Gemm { const bf16* A; const bf16* Bt; int K; };

struct Sched {
    int nM, nN, nwg, G, c, moe;
    __device__ __forceinline__ void init(int nM_, int nN_, int G_, int c_, int moe_) { nM = nM_; nN = nN_; nwg = nM * nN; G = G_; c = c_; moe = moe_; }
    __device__ __forceinline__ bool next(int i, Unit& u) const {
        const long L = (long)i * G + c; if (L >= nwg) return false;
        int wgid = (int)L; { const int q = nwg / NXCD, r = nwg % NXCD, xcd = wgid % NXCD, off = wgid / NXCD; wgid = (xcd < r ? xcd * (q + 1) : r * (q + 1) + (xcd - r) * q) + off; }
        const int nig = WGM * nN, gid = wgid / nig, fm = gid * WGM, gsz = (nM - fm) < WGM ? (nM - fm) : WGM;
        u.pm = fm + ((wgid % nig) % gsz); u.pn = (wgid % nig) / gsz;
        u.bt = moe ? ((u.pm < 512 ? (u.pm >> 5) : (u.pm - 512)) * nN + u.pn) : u.pn;
        return true;
    }
};

struct EpiU {
    static constexpr bool PERM = true;
    bf16* O; int ldc;
    __device__ __forceinline__ void operator()(const f32x4 (&acc)[2][2][4][2], const Unit& u, int wr, int wc, int fr, int fq) const {
        const int row0 = u.pm * BM + wr * 64 + fr, col0 = u.pn * BM + wc * 32 + 8 * fq;
#pragma unroll
        for (int ai = 0; ai < 2; ++ai)
#pragma unroll
            for (int m = 0; m < 4; ++m) { bf16* rowp = O + (size_t)(row0 + ai * HALF + m * 16) * ldc + col0;
#pragma unroll
                for (int bj = 0; bj < 2; ++bj) { const f32x4 v0 = acc[ai][bj][m][0], v1 = acc[ai][bj][m][1];
                    u32x4 w; w.x = cvt_pk_bf16(v0[0], v0[1]); w.y = cvt_pk_bf16(v0[2], v0[3]); w.z = cvt_pk_bf16(v1[0], v1[1]); w.w = cvt_pk_bf16(v1[2], v1[3]);
                    *(u32x4*)(rowp + bj * HALF) = w; } }
    }
};
struct EpiRes {
    static constexpr bool PERM = false;
    const float* base_lat; const float* base_ctx; float* out_lat; float* out_ctx; const float* modv;
    __device__ __forceinline__ void operator()(const f32x4 (&acc)[2][2][4][2], const Unit& u, int wr, int wc, int fr, int fq) const {
        const bool lat = u.pm < 256; const int g = lat ? (u.pm >> 5) : 8;
        const int rowt = (lat ? u.pm : u.pm - 256) * BM + wr * 64 + fr, col0 = u.pn * BM + wc * 32 + 4 * fq;
        const float* base = lat ? base_lat : base_ctx; float* out = lat ? out_lat : out_ctx;
        f32x4 gv[2][2];
#pragma unroll
        for (int bj = 0; bj < 2; ++bj)
#pragma unroll
            for (int n = 0; n < 2; ++n) gv[bj][n] = *(const f32x4*)(modv + g * 6144 + 2 * 1024 + col0 + bj * HALF + n * 16);
#pragma unroll
        for (int ai = 0; ai < 2; ++ai)
#pragma unroll
            for (int m = 0; m < 4; ++m) { const size_t off = (size_t)(rowt + ai * HALF + m * 16) * D + col0;
#pragma unroll
                for (int bj = 0; bj < 2; ++bj)
#pragma unroll
                    for (int n = 0; n < 2; ++n) { const f32x4 bs = *(const f32x4*)(base + off + bj * HALF + n * 16); *(f32x4*)(out + off + bj * HALF + n * 16) = bs + gv[bj][n] * acc[ai][bj][m][n]; }
                asm volatile("" ::: "memory"); }
    }
};
struct EpiGU {
    static constexpr bool PERM = true;
    bf16* O;
    __device__ __forceinline__ void operator()(const f32x4 (&acc)[2][2][4][2], const Unit& u, int wr, int wc, int fr, int fq) const {
        const int row0 = u.pm * BM + wr * 64 + fr, col0 = u.pn * HALF + wc * 32 + 8 * fq;
#pragma unroll
        for (int ai = 0; ai < 2; ++ai)
#pragma unroll
            for (int m = 0; m < 4; ++m) { bf16* rowp = O + (size_t)(row0 + ai * HALF + m * 16) * DE + col0;
                float r[8];
#pragma unroll
                for (int n = 0; n < 2; ++n)
#pragma unroll
                    for (int j = 0; j < 4; ++j) { const float a = acc[ai][0][m][n][j], b = acc[ai][1][m][n][j]; r[4 * n + j] = a * __builtin_amdgcn_rcpf(1.0f + fexp2(-a * LOG2E)) * b; }
                u32x4 w; w.x = cvt_pk_bf16(r[0], r[1]); w.y = cvt_pk_bf16(r[2], r[3]); w.z = cvt_pk_bf16(r[4], r[5]); w.w = cvt_pk_bf16(r[6], r[7]);
                *(u32x4*)rowp = w; }
    }
};
struct EpiD {
    static constexpr bool PERM = true;
    bf16* O; const float* gsel;
    __device__ __forceinline__ void operator()(const f32x4 (&acc)[2][2][4][2], const Unit& u, int wr, int wc, int fr, int fq) const {
        const int row0 = u.pm * BM + wr * 64 + fr, col0 = u.pn * BM + wc * 32 + 8 * fq;
#pragma unroll
        for (int ai = 0; ai < 2; ++ai)
#pragma unroll
            for (int m = 0; m < 4; ++m) { const int row = row0 + ai * HALF + m * 16; const float gs = gsel[row]; bf16* rowp = O + (size_t)row * D + col0;
#pragma unroll
                for (int bj = 0; bj < 2; ++bj) { const f32x4 v0 = acc[ai][bj][m][0] * gs, v1 = acc[ai][bj][m][1] * gs;
                    u32x4 w; w.x = cvt_pk_bf16(v0[0], v0[1]); w.y = cvt_pk_bf16(v0[2], v0[3]); w.z = cvt_pk_bf16(v1[0], v1[1]); w.w = cvt_pk_bf16(v1[2], v1[3]);
                    *(u32x4*)(rowp + bj * HALF) = w; } }
    }
};

template <class Epi>
__device__ __forceinline__ void gemm_phase(LAS unsigned char* lds, const Gemm g, const Sched& S, const Epi& E, const int tid) {
    const int wid = __builtin_amdgcn_readfirstlane(tid >> 6), lane = tid & 63, wr = wid >> 2, wc = wid & 3, fr = lane & 15, fq = lane >> 4;
    const int K = g.K, nt = K / BK;
    unsigned voffA[2], voffB[2];
#pragma unroll
    for (int i = 0; i < 2; ++i) { int R, C; stage_rc(tid * 16 + i * 8192, R, C); const int Rb = Epi::PERM ? ((R & ~31) + perm32(R & 31)) : R;
        voffA[i] = (unsigned)(R * K + C) * 2u; voffB[i] = (unsigned)(Rb * K + C) * 2u; }
    const size_t kstep = (size_t)(BK * 2);
    const size_t hstep = (size_t)HALF * K * 2;
    const size_t tstep = 2 * hstep;
    const unsigned ldsw = (unsigned)wid * 1024u;
    const int aoff = lds_byte(wr * 64 + fr, fq * 8), boff = lds_byte(wc * 32 + fr, fq * 8);
#define PG8_SA(b, h) (((b) * 2 + (h)) * HTB)
#define PG8_SB(b, h) ((4 + (b) * 2 + (h)) * HTB)
#define PG8_STAGE(bufoff, gbase, voff) do { _Pragma("unroll") for (int _i = 0; _i < 2; ++_i) \
        __builtin_amdgcn_global_load_lds((const unsigned*)((const char*)(gbase) + (voff)[_i]), (LAS unsigned*)(lds + (bufoff) + ldsw + _i * 8192), 16, 0, 0); } while (0)
#define PG8_LDA(dst, b, h) do { _Pragma("unroll") for (int m = 0; m < 4; ++m) _Pragma("unroll") for (int k = 0; k < 2; ++k) dst[m][k] = *(const LAS bf16x8*)(lds + PG8_SA(b, h) + aoff + m * 2048 + k * 1024); } while (0)
#define PG8_LDB(dst, b, h) do { _Pragma("unroll") for (int n = 0; n < 2; ++n) _Pragma("unroll") for (int k = 0; k < 2; ++k) dst[n][k] = *(const LAS bf16x8*)(lds + PG8_SB(b, h) + boff + n * 2048 + k * 1024); } while (0)
#define PG8_MMA(ai, bj, At, Bt) do { __builtin_amdgcn_s_setprio(1); _Pragma("unroll") for (int m = 0; m < 4; ++m) _Pragma("unroll") for (int n = 0; n < 2; ++n) _Pragma("unroll") for (int k = 0; k < 2; ++k) \
        acc[ai][bj][m][n] = __builtin_amdgcn_mfma_f32_16x16x32_bf16(Bt[n][k], At[m][k], acc[ai][bj][m][n], 0, 0, 0); __builtin_amdgcn_s_setprio(0); } while (0)
#define PG8_WAIT_V(n) asm volatile("s_waitcnt vmcnt(" #n ")" ::: "memory")
#define PG8_WAIT_L(n) asm volatile("s_waitcnt lgkmcnt(" #n ")" ::: "memory")
#define PG8_BAR __builtin_amdgcn_s_barrier()
#define PG8_SCHED __builtin_amdgcn_sched_barrier(0)
    Unit cur, nxt; int ui = 0;
    if (!S.next(0, cur)) return;
    f32x4 acc[2][2][4][2];
#pragma unroll
    for (int a = 0; a < 2; ++a)
#pragma unroll
        for (int b = 0; b < 2; ++b)
#pragma unroll
            for (int m = 0; m < 4; ++m)
#pragma unroll
                for (int n = 0; n < 2; ++n) acc[a][b][m][n] = (f32x4){0.f, 0.f, 0.f, 0.f};
    bf16x8 At[4][2], B0[2][2], B1[2][2];
    const char* cA = (const char*)g.A + (size_t)cur.pm * tstep; const char* cB = (const char*)g.Bt + (size_t)cur.bt * tstep;
    PG8_STAGE(PG8_SB(0, 0), cB, voffB); PG8_STAGE(PG8_SB(0, 1), cB + hstep, voffB); PG8_STAGE(PG8_SA(0, 0), cA, voffA); PG8_STAGE(PG8_SA(0, 1), cA + hstep, voffA);
    if (wr == 1) PG8_BAR;
    PG8_WAIT_V(2); PG8_BAR;
    PG8_STAGE(PG8_SB(1, 0), cB + kstep, voffB); PG8_STAGE(PG8_SA(1, 0), cA + kstep, voffA); PG8_STAGE(PG8_SB(1, 1), cB + hstep + kstep, voffB);
    PG8_WAIT_V(6); PG8_BAR;
    for (;;) {
        const bool has_next = S.next(ui + 1, nxt);
        const char* nA = has_next ? (const char*)g.A + (size_t)nxt.pm * tstep : cA; const char* nB = has_next ? (const char*)g.Bt + (size_t)nxt.bt * tstep : cB;
        for (int t = 0; t < nt; t += 2) {
            const bool last = (t == nt - 2);
            const char* a1 = cA + (size_t)(t + 1) * kstep;
            const char* a2 = last ? nA : cA + (size_t)(t + 2) * kstep; const char* b2 = last ? nB : cB + (size_t)(t + 2) * kstep;
            const char* a3 = a2 + kstep; const char* b3 = b2 + kstep;
            PG8_LDB(B0, 0, 0); PG8_LDB(B1, 0, 1); PG8_SCHED; PG8_LDA(At, 0, 0); PG8_STAGE(PG8_SA(1, 1), a1 + hstep, voffA);
            PG8_WAIT_V(8); PG8_WAIT_L(0); PG8_BAR; PG8_MMA(0, 0, At, B0); PG8_MMA(0, 1, At, B1); PG8_BAR; PG8_SCHED;
            PG8_LDA(At, 0, 1); PG8_STAGE(PG8_SB(0, 0), b2, voffB); PG8_STAGE(PG8_SB(0, 1), b2 + hstep, voffB); PG8_STAGE(PG8_SA(0, 0), a2, voffA);
            PG8_WAIT_V(8); PG8_WAIT_L(0); PG8_BAR; PG8_MMA(1, 0, At, B0); PG8_MMA(1, 1, At, B1); PG8_BAR; PG8_SCHED;
            PG8_LDB(B0, 1, 0); PG8_LDB(B1, 1, 1); PG8_SCHED; PG8_LDA(At, 1, 0); PG8_STAGE(PG8_SA(0, 1), a2 + hstep, voffA);
            PG8_WAIT_V(8); PG8_WAIT_L(0); PG8_BAR; PG8_MMA(0, 0, At, B0); PG8_MMA(0, 1, At, B1); PG8_BAR; PG8_SCHED;
            PG8_LDA(At, 1, 1); PG8_STAGE(PG8_SB(1, 0), b3, voffB); PG8_STAGE(PG8_SB(1, 1), b3 + hstep, voffB); PG8_STAGE(PG8_SA(1, 0), a3, voffA);
            PG8_WAIT_V(8); PG8_WAIT_L(0); PG8_BAR; PG8_MMA(1, 0, At, B0); PG8_MMA(1, 1, At, B1); PG8_BAR; PG8_SCHED;
        }
        if (wr == 0) PG8_BAR;
        E(acc, cur, wr, wc, fr, fq);
        if (!has_next) break;
#pragma unroll
        for (int a = 0; a < 2; ++a)
#pragma unroll
            for (int b = 0; b < 2; ++b)
#pragma unroll
                for (int m = 0; m < 4; ++m)
#pragma unroll
                    for (int n = 0; n < 2; ++n) acc[a][b][m][n] = (f32x4){0.f, 0.f, 0.f, 0.f};
        cur = nxt; cA = nA; cB = nB; ++ui;
        if (wr == 1) PG8_BAR;
    }
    PG8_WAIT_V(0);
    PG8_BAR;
#undef PG8_SA
#undef PG8_SB
#undef PG8_STAGE
#undef PG8_LDA
#undef PG8_LDB
#undef PG8_MMA
#undef PG8_WAIT_V
#undef PG8_WAIT_L
#undef PG8_BAR
#undef PG8_SCHED
}
}

#define XB_TMO      128
#define XB_XCNT(j)  (256  + 64 * (j))
#define XB_XSUB(j)  (1280 + 64 * (j))
#define XB_XGEN(j)  (2304 + 64 * (j))
#define XB_TOP      3328
#define XB_TOPGEN   3392
#define XCD_BAR_WORDS 3456
#define XB_SPIN_CAP (1u << 18)
__device__ __forceinline__ unsigned xb_ld(unsigned* p)              { return __hip_atomic_load(p, __ATOMIC_RELAXED, __HIP_MEMORY_SCOPE_AGENT); }
__device__ __forceinline__ unsigned xb_add(unsigned* p, unsigned v) { return __hip_atomic_fetch_add(p, v, __ATOMIC_RELAXED, __HIP_MEMORY_SCOPE_AGENT); }
__device__ __forceinline__ unsigned xb_xcc_id() { return (unsigned)__builtin_amdgcn_s_getreg((3 << 11) | 20) & 0xFu; }
#define XB_SPIN(cond, bar) do { unsigned _sp = 0; while (cond) { __builtin_amdgcn_s_sleep(1); \
    if ((++_sp & 255u) == 0u) { if (xb_ld(&(bar)[XB_TMO])) break; if (_sp > XB_SPIN_CAP) { atomicAdd(&(bar)[XB_TMO], 1u); break; } } } } while (0)
struct XcdBarrier { unsigned* bar; unsigned x; volatile LAS unsigned* st; };
__device__ __forceinline__ XcdBarrier xcd_barrier_post(unsigned* bar, volatile LAS unsigned* st) {
    XcdBarrier b; b.bar = bar; b.x = xb_xcc_id(); b.st = st;
    if (threadIdx.x == 0) (void)xb_add(&bar[XB_XCNT(b.x)], 1u);
    return b;
}
__device__ __forceinline__ void xcd_barrier_complete(unsigned* bar, unsigned x, unsigned& nloc, unsigned& nx) {
    const unsigned G = gridDim.x * gridDim.y * gridDim.z;
    unsigned sum, cnt, mine, sp = 0u;
    for (;;) {
        sum = 0u; cnt = 0u; mine = 0u;
#pragma unroll
        for (unsigned j = 0; j < 16; ++j) { const unsigned c = xb_ld(&bar[XB_XCNT(j)]); sum += c; cnt += (c > 0u) ? 1u : 0u; mine = (j == x) ? c : mine; }
        if (sum == G) break;
        __builtin_amdgcn_s_sleep(1);
        if ((++sp & 255u) == 0u) { if (xb_ld(&bar[XB_TMO])) break; if (sp > XB_SPIN_CAP) { atomicAdd(&bar[XB_TMO], 1u); break; } }
    }
    nloc = mine > 0u ? mine : 1u; nx = cnt > 0u ? cnt : 1u;
}
__device__ __forceinline__ void xcd_barrier(const XcdBarrier& b) {
    asm volatile("s_waitcnt vmcnt(0)" ::: "memory");
    __syncthreads();
    if (threadIdx.x == 0) {
        unsigned* bar = b.bar;
        __builtin_amdgcn_s_waitcnt(0);
        unsigned nloc = b.st[0], nx = b.st[1];
        if (nloc == 0u) { xcd_barrier_complete(bar, b.x, nloc, nx); b.st[0] = nloc; b.st[1] = nx; }
        const unsigned old = xb_add(&bar[XB_XSUB(b.x)], 1u);
        const unsigned gen = old / nloc;
        if (old + 1u == (gen + 1u) * nloc) {
            __builtin_amdgcn_fence(__ATOMIC_RELEASE, "agent");
            asm volatile("s_waitcnt vmcnt(0)" ::: "memory");
            const unsigned og = xb_add(&bar[XB_TOP], 1u);
            const unsigned tg = og / nx;
            if (og + 1u == (tg + 1u) * nx) xb_add(&bar[XB_TOPGEN], 1u);
            else XB_SPIN(xb_ld(&bar[XB_TOPGEN]) == tg, bar);
            __builtin_amdgcn_fence(__ATOMIC_ACQUIRE, "agent");
            xb_add(&bar[XB_XGEN(b.x)], 1u);
            asm volatile("s_waitcnt vmcnt(0)" ::: "memory");
        } else {
            XB_SPIN(xb_ld(&bar[XB_XGEN(b.x)]) == gen, bar);
            __builtin_amdgcn_fence(__ATOMIC_ACQUIRE, "agent");
            asm volatile("s_waitcnt vmcnt(0)" ::: "memory");
        }
    }
    __syncthreads();
}

struct Args { const float* in[19]; float* out; unsigned char* ws; int ph_lo, ph_hi; };
enum { IN_X = 0, IN_C, IN_CTX, IN_CCTX, IN_WMOD, IN_BMOD, IN_G1, IN_G2, IN_WIN, IN_WOUT, IN_CONVW, IN_CONVB, IN_GATEB, IN_GHEAD, IN_WROUTER, IN_WGATE, IN_WUP, IN_WDOWN, IN_GFINAL };

__device__ __forceinline__ void ph_prologue(const Args& a, LAS unsigned char* lds, int vcu, int G, int tid, int wave, int lane) {
    unsigned char* ws = a.ws;
    bf16* wg = (bf16*)(ws + WS_WG); bf16* wrt = (bf16*)(ws + WS_WR);
    const float* w_in = a.in[IN_WIN]; const float* w_router = a.in[IN_WROUTER];
    for (int i = vcu * 512 + tid; i < 2 * 16 * 1024; i += G * 512) { const int L = i >> 14, j = (i >> 10) & 15, k = i & 1023;
        wg[i] = (bf16)(cvt_pk_bf16(w_in[((size_t)L * 1024 + k) * DPROJ + NU + j], 0.f) & 0xffffu);
        wrt[i] = (bf16)(cvt_pk_bf16(w_router[((size_t)L * 1024 + k) * NE + j], 0.f) & 0xffffu); }
    LAS float* sv = (LAS float*)lds;
    LAS float* red = (LAS float*)(lds + 9 * 1024 * 4);
    const float* c = a.in[IN_C]; const float* cctx = a.in[IN_CCTX];
    for (int i = tid; i < 9 * 1024; i += 512) { const int g = i >> 10, k = i & 1023; const float v = g < 8 ? c[g * 1024 + k] : cctx[k]; sv[i] = v / (1.0f + __expf(-v)); }
    __syncthreads();
    const float* w_mod = a.in[IN_WMOD]; const float* b_mod = a.in[IN_BMOD]; float* modv = (float*)(ws + WS_MODV);
    for (int item = vcu; item < 2 * 96; item += G) {
        const int L = item / 96, cb = item % 96, col = cb * 64 + lane;
        float acc[9];
#pragma unroll
        for (int g = 0; g < 9; ++g) acc[g] = 0.f;
        for (int kk = 0; kk < 128; ++kk) { const int k = wave * 128 + kk; const float wv = w_mod[((size_t)L * 1024 + k) * 6144 + col];
#pragma unroll
            for (int g = 0; g < 9; ++g) acc[g] += sv[g * 1024 + k] * wv; }
#pragma unroll
        for (int g = 0; g < 9; ++g) red[(wave * 9 + g) * 64 + lane] = acc[g];
        __syncthreads();
        for (int o = tid; o < 9 * 64; o += 512) { const int g = o >> 6, l = o & 63; float s = b_mod[L * 6144 + cb * 64 + l];
#pragma unroll
            for (int w = 0; w < 8; ++w) s += red[(w * 9 + g) * 64 + l];
            modv[(size_t)(L * 9 + g) * 6144 + cb * 64 + l] = s; }
        __syncthreads();
    }
}

__device__ __forceinline__ void transpose_item(const float* src, int ld, int k0, int n0, bf16* dst, int dstK, int row0, float scale, LAS float* scr, int lane) {
#pragma unroll 8
    for (int i = 0; i < 32; ++i) { const int kk = 2 * i + (lane >> 5); scr[kk * 33 + (lane & 31)] = src[(size_t)(k0 + kk) * ld + n0 + (lane & 31)] * scale; }
    LDS_WAIT(); asm volatile("" ::: "memory");
    const int c = lane & 7;
#pragma unroll
    for (int j = 0; j < 4; ++j) { const int n = (lane >> 3) + 8 * j; const LAS float* s = scr + (8 * c) * 33 + n;
        u32x4 o; o.x = cvt_pk_bf16(s[0 * 33], s[1 * 33]); o.y = cvt_pk_bf16(s[2 * 33], s[3 * 33]); o.z = cvt_pk_bf16(s[4 * 33], s[5 * 33]); o.w = cvt_pk_bf16(s[6 * 33], s[7 * 33]);
        *(u32x4*)(dst + (size_t)(row0 + n) * dstK + k0 + 8 * c) = o; }
    LDS_WAIT(); asm volatile("" ::: "memory");
}
__device__ __forceinline__ void ph_convert(const Args& a, int L, LAS unsigned char* lds, int vcu, int G, int wave, int lane) {
    unsigned char* ws = a.ws;
    LAS float* scr = (LAS float*)(lds + wave * 16384);
    const int gw = vcu * 8 + wave, NGW = G * 8;
    constexpr int NI_IN = 16 * 112, NI_OUT = 16 * 32, NI_E = 704, NI_GU = NE * 2 * NI_E, NI_DN = NE * NI_E, NITEMS = NI_IN + NI_OUT + NI_GU + NI_DN;
    for (int it = gw; it < NITEMS; it += NGW) {
        int r = it;
        if (r < NI_IN) { const int kb = r / 112, nb = r % 112, n0 = 32 * nb;
            transpose_item(a.in[IN_WIN] + (size_t)L * 1024 * DPROJ, DPROJ, 64 * kb, n0, (bf16*)(ws + WS_WIN), 1024, n0, (n0 >= UC_Q && n0 < UC_K) ? 0.08838834764831845f : 1.0f, scr, lane); continue; }
        r -= NI_IN;
        if (r < NI_OUT) { const int kb = r / 32, nb = r % 32;
            transpose_item(a.in[IN_WOUT] + (size_t)L * 1024 * 1024, 1024, 64 * kb, 32 * nb, (bf16*)(ws + WS_WOUT), 1024, 32 * nb, 1.0f, scr, lane); continue; }
        r -= NI_OUT;
        if (r < NI_GU) { const int e = r / (2 * NI_E), rr = r % (2 * NI_E), which = rr / NI_E, q = rr % NI_E, kb = q / 44, nb = q % 44, n0 = 32 * nb;
            const float* src = (which ? a.in[IN_WUP] : a.in[IN_WGATE]) + ((size_t)L * NE + e) * 1024 * DE;
            transpose_item(src, DE, 64 * kb, n0, (bf16*)(ws + WS_WGU) + (size_t)e * 2816 * 1024, 1024, 256 * (n0 >> 7) + 128 * which + (n0 & 127), 1.0f, scr, lane); continue; }
        r -= NI_GU;
        { const int e = r / NI_E, q = r % NI_E, kb = q / 32, nb = q % 32;
            transpose_item(a.in[IN_WDOWN] + ((size_t)L * NE + e) * DE * 1024, 1024, 64 * kb, 32 * nb, (bf16*)(ws + WS_WD) + (size_t)e * 1024 * DE, DE, 32 * nb, 1.0f, scr, lane); }
    }
}

__device__ __forceinline__ void row_load(const float* p, int lane, f32x4 (&v)[4]) {
#pragma unroll
    for (int j = 0; j < 4; ++j) v[j] = *((const f32x4*)p + lane + 64 * j);
}
__device__ __forceinline__ float row_rstd(const f32x4 (&v)[4]) {
    float s = 0.f;
#pragma unroll
    for (int j = 0; j < 4; ++j) s += (v[j].x * v[j].x + v[j].y * v[j].y) + (v[j].z * v[j].z + v[j].w * v[j].w);
    return __builtin_amdgcn_rsqf(wave_sum(s) * (1.0f / D) + EPS);
}
__device__ __forceinline__ void row_mod_store(const f32x4 (&v)[4], float rstd, const float* gn, const float* shift, const float* scale, bf16* hrow, int lane) {
#pragma unroll
    for (int j = 0; j < 4; ++j) { const int c = 4 * lane + 256 * j; const f32x4 g = *(const f32x4*)(gn + c), sh = *(const f32x4*)(shift + c), sc = *(const f32x4*)(scale + c);
        const f32x4 h = v[j] * rstd * g * (sc + 1.0f) + sh;
        u32x2 w; w.x = cvt_pk_bf16(h.x, h.y); w.y = cvt_pk_bf16(h.z, h.w); *(u32x2*)(hrow + c) = w; }
}
constexpr int WT_STRIDE = 2064;
__device__ __forceinline__ void stage_wt(const bf16* wt, LAS unsigned char* lds, int tid) {
    for (int i = tid; i < 16 * 128; i += 512) { const int r = i >> 7, ch = i & 127; *(LAS u32x4*)(lds + r * WT_STRIDE + ch * 16) = *(const u32x4*)(wt + r * 1024 + ch * 8); }
    __syncthreads();
}
template <bool TOKFIRST>
__device__ __forceinline__ f32x4 skinny16(const bf16* hrows, LAS unsigned char* wl, int lane) {
    const int r = lane & 15, g = lane >> 4;
    f32x4 acc = {0.f, 0.f, 0.f, 0.f};
    const bf16* hp = hrows + (size_t)r * 1024 + 8 * g;
    const LAS unsigned char* wp = wl + r * WT_STRIDE + 16 * g;
#pragma unroll
    for (int kb = 0; kb < 4; ++kb) {
        bf16x8 hf[8];
#pragma unroll
        for (int k = 0; k < 8; ++k) hf[k] = __builtin_nontemporal_load((const bf16x8*)(hp + 32 * (kb * 8 + k)));
#pragma unroll
        for (int k = 0; k < 8; ++k) { const bf16x8 wf = *(const LAS bf16x8*)(wp + 64 * (kb * 8 + k));
            acc = TOKFIRST ? __builtin_amdgcn_mfma_f32_16x16x32_bf16(hf[k], wf, acc, 0, 0, 0) : __builtin_amdgcn_mfma_f32_16x16x32_bf16(wf, hf[k], acc, 0, 0, 0); }
    }
    return acc;
}

__device__ __forceinline__ int row_cond(int row) { return row < NLAT ? (row >> 13) : 8; }

__device__ __forceinline__ void gates_store(const f32x4 acc, const float* gate_b_l, float* gates, int row0, int lane) {
    const int fq = lane >> 4; const f32x4 gb = *(const f32x4*)(gate_b_l + 4 * fq);
    *(f32x4*)(gates + (size_t)(row0 + (lane & 15)) * 16 + 4 * fq) = acc + gb;
}
__device__ __forceinline__ void router_store(const f32x4 acc, float* afft, int row0, int lane) {
    f32x4 mx = acc;
#pragma unroll
    for (int o = 1; o < 16; o <<= 1) { f32x4 t; t.x = __shfl_xor(mx.x, o); t.y = __shfl_xor(mx.y, o); t.z = __shfl_xor(mx.z, o); t.w = __shfl_xor(mx.w, o);
        mx.x = fmaxf(mx.x, t.x); mx.y = fmaxf(mx.y, t.y); mx.z = fmaxf(mx.z, t.z); mx.w = fmaxf(mx.w, t.w); }
    f32x4 ex; ex.x = __expf(acc.x - mx.x); ex.y = __expf(acc.y - mx.y); ex.z = __expf(acc.z - mx.z); ex.w = __expf(acc.w - mx.w);
    f32x4 sm = ex;
#pragma unroll
    for (int o = 1; o < 16; o <<= 1) { f32x4 t; t.x = __shfl_xor(sm.x, o); t.y = __shfl_xor(sm.y, o); t.z = __shfl_xor(sm.z, o); t.w = __shfl_xor(sm.w, o); sm = sm + t; }
    f32x4 o4; o4.x = ex.x / sm.x; o4.y = ex.y / sm.y; o4.z = ex.z / sm.z; o4.w = ex.w / sm.w;
    *(f32x4*)(afft + (size_t)(lane & 15) * NTOK + row0 + 4 * (lane >> 4)) = o4;
}

__device__ __forceinline__ void ph_prepass1_l0(const Args& a, LAS unsigned char* lds, int vcu, int G, int tid, int wave, int lane) {
    unsigned char* ws = a.ws; const int L = 0;
    stage_wt((const bf16*)(ws + WS_WG) + (size_t)L * 16 * 1024, lds + TAB_OFF - 16 * WT_STRIDE, tid);
    LAS unsigned char* wl = lds + TAB_OFF - 16 * WT_STRIDE;
    const float* modv = (const float*)(ws + WS_MODV) + (size_t)L * 9 * 6144; const float* gn = a.in[IN_G1] + L * 1024;
    bf16* H = (bf16*)(ws + WS_H); float* gates = (float*)(ws + WS_GATES);
    for (int grp = vcu * 8 + wave; grp < NTOK / 16; grp += G * 8) {
        const int row0 = grp * 16, g = row_cond(row0);
        const float* src = row0 < NLAT ? a.in[IN_X] + (size_t)row0 * D : a.in[IN_CTX] + (size_t)(row0 - NLAT) * D;
        for (int r = 0; r < 16; ++r) { f32x4 v[4]; row_load(src + (size_t)r * D, lane, v); const float rstd = row_rstd(v);
            row_mod_store(v, rstd, gn, modv + g * 6144 + 0 * 1024, modv + g * 6144 + 1 * 1024, H + (size_t)(row0 + r) * D, lane); }
        VM_WAIT();
        const f32x4 acc = skinny16<false>(H + (size_t)row0 * D, wl, lane);
        gates_store(acc, a.in[IN_GATEB] + L * 16, gates, row0, lane);
    }
}

__device__ __forceinline__ void ph_prepass2(const Args& a, int L, LAS unsigned char* lds, int vcu, int G, int tid, int wave, int lane) {
    unsigned char* ws = a.ws;
    LAS unsigned char* wl = lds;
    stage_wt((const bf16*)(ws + WS_WR) + (size_t)L * 16 * 1024, wl, tid);
    const float* modv = (const float*)(ws + WS_MODV) + (size_t)L * 9 * 6144; const float* gn = a.in[IN_G2] + L * 1024;
    bf16* H = (bf16*)(ws + WS_H); float* afft = (float*)(ws + WS_AFFT);
    const int ngrp = (L == 0 ? NTOK : NLAT) / 16;
    for (int grp = vcu * 8 + wave; grp < ngrp; grp += G * 8) {
        const int row0 = grp * 16, g = row_cond(row0);
        const float* src = row0 < NLAT ? a.out + (size_t)row0 * D : (const float*)(ws + WS_XC) + (size_t)(row0 - NLAT) * D;
        for (int r = 0; r < 16; ++r) { f32x4 v[4]; row_load(src + (size_t)r * D, lane, v); const float rstd = row_rstd(v);
            row_mod_store(v, rstd, gn, modv + g * 6144 + 3 * 1024, modv + g * 6144 + 4 * 1024, H + (size_t)(row0 + r) * D, lane); }
        VM_WAIT();
        const f32x4 acc = skinny16<true>(H + (size_t)row0 * D, wl, lane);
        router_store(acc, afft, row0, lane);
    }
}

__device__ __forceinline__ void ph_combine(const Args& a, int L, LAS unsigned char* lds, int vcu, int G, int tid, int wave, int lane) {
    unsigned char* ws = a.ws; const bool last = (L == DEPTH - 1);
    LAS unsigned char* wl = lds;
    if (!last) stage_wt((const bf16*)(ws + WS_WG) + (size_t)(L + 1) * 16 * 1024, wl, tid);
    const float* modv = (const float*)(ws + WS_MODV) + (size_t)L * 9 * 6144;
    const float* modn = (const float*)(ws + WS_MODV) + (size_t)(L + 1 < DEPTH ? L + 1 : L) * 9 * 6144;
    const float* gn = last ? a.in[IN_GFINAL] : a.in[IN_G1] + (L + 1) * 1024;
    bf16* H = (bf16*)(ws + WS_H); float* gates = (float*)(ws + WS_GATES);
    const bf16* ye = (const bf16*)(ws + WS_XE); const int* inv = (const int*)(ws + WS_INV);
    const int ngrp = (last ? NLAT : NTOK) / 16;
    for (int grp = vcu * 8 + wave; grp < ngrp; grp += G * 8) {
        const int row0 = grp * 16, g = row_cond(row0);
        float* xs = row0 < NLAT ? a.out + (size_t)row0 * D : (float*)(ws + WS_XC) + (size_t)(row0 - NLAT) * D;
        for (int r = 0; r < 16; ++r) {
            f32x4 v[4]; row_load(xs + (size_t)r * D, lane, v);
            const int myinv = inv[(size_t)(row0 + r) * 16 + (lane & 15)];
            f32x4 s[4];
#pragma unroll
            for (int j = 0; j < 4; ++j) s[j] = (f32x4){0.f, 0.f, 0.f, 0.f};
            for (int e = 0; e < NE; ++e) { const int slot = __shfl(myinv, e);
                if (slot >= 0) { const bf16* yr = ye + (size_t)slot * D;
#pragma unroll
                    for (int j = 0; j < 4; ++j) { const u32x2 w = *(const u32x2*)(yr + 4 * lane + 256 * j); s[j].x += bf_lo(w.x); s[j].y += bf_hi(w.x); s[j].z += bf_lo(w.y); s[j].w += bf_hi(w.y); } } }
#pragma unroll
            for (int j = 0; j < 4; ++j) { const f32x4 g2 = *(const f32x4*)(modv + g * 6144 + 5 * 1024 + 4 * lane + 256 * j); v[j] = v[j] + g2 * s[j]; }
            const float rstd = row_rstd(v);
            if (last) {
#pragma unroll
                for (int j = 0; j < 4; ++j) { const f32x4 gf = *(const f32x4*)(gn + 4 * lane + 256 * j); *((f32x4*)(xs + (size_t)r * D) + lane + 64 * j) = v[j] * rstd * gf; }
            } else {
#pragma unroll
                for (int j = 0; j < 4; ++j) *((f32x4*)(xs + (size_t)r * D) + lane + 64 * j) = v[j];
                row_mod_store(v, rstd, gn, modn + g * 6144 + 0 * 1024, modn + g * 6144 + 1 * 1024, H + (size_t)(row0 + r) * D, lane);
            }
        }
        if (!last) { VM_WAIT();
            const f32x4 acc = skinny16<false>(H + (size_t)row0 * D, wl, lane);
            gates_store(acc, a.in[IN_GATEB] + (L + 1) * 16, gates, row0, lane); }
    }
}

__device__ __forceinline__ unsigned img_off(unsigned row, unsigned ch) { return 256u * row + 16u * (ch ^ (((row & 3u) << 2) | ((row >> 2) & 3u))); }
__device__ __forceinline__ bf16x8 frag_row(const LAS unsigned char* img, int lane, int rb, int s) { return *(const LAS bf16x8*)(img + img_off((unsigned)((lane & 15) + 16 * rb), (unsigned)(4 * s + (lane >> 4)))); }
__device__ __forceinline__ bf16x8 frag_tr(const LAS unsigned char* img, int lane, int c, int ks) {
    const unsigned g = (unsigned)lane >> 4, q = ((unsigned)lane & 15u) >> 2, p = (unsigned)lane & 3u;
    const s16x4 lo = __builtin_amdgcn_ds_read_tr16_b64_v4i16((LAS s16x4*)(img + img_off(32u * ks + 8u * g + q, 2u * c + (p >> 1)) + 8u * (p & 1u)));
    const s16x4 hi = __builtin_amdgcn_ds_read_tr16_b64_v4i16((LAS s16x4*)(img + img_off(32u * ks + 8u * g + 4u + q, 2u * c + (p >> 1)) + 8u * (p & 1u)));
    return __builtin_shufflevector(lo, hi, 0, 1, 2, 3, 4, 5, 6, 7);
}
__device__ __forceinline__ int chunk_row0(int b, int c) { return c < NCH_C ? NLAT + b * CTXL + c * 128 : b * SEQ + (c - NCH_C) * 128; }
__device__ __forceinline__ int state_idx(int b, int h, int c, int d) { return ((b * NH + h) * NCH + c) * 2 + d; }

struct GateScan { float b0, b1, g0, g1, cm0, cm1, B, G; };
__device__ __forceinline__ float logsigmoid(float x) { return fminf(x, 0.f) - log1pf(__expf(-fabsf(x))); }
__device__ __forceinline__ GateScan gate_scan(int d, int lane, float i0, float i1, float f0, float f1) {
    GateScan o; const float l0 = logsigmoid(f0), l1 = logsigmoid(f1);
    float inc = l0 + l1;
    if (d == 0) {
#pragma unroll
        for (int s = 1; s < 64; s <<= 1) { const float t = __shfl_up(inc, s); if (lane >= s) inc += t; }
        o.b1 = inc; o.b0 = inc - l1; o.B = __shfl(inc, 63);
    } else {
#pragma unroll
        for (int s = 1; s < 64; s <<= 1) { const float t = __shfl_down(inc, s); if (lane + s < 64) inc += t; }
        o.b0 = inc; o.b1 = inc - l0; o.B = __shfl(inc, 0);
    }
    o.g0 = i0 - o.b0; o.g1 = i1 - o.b1;
    float pm = fmaxf(o.g0, o.g1);
    if (d == 0) {
#pragma unroll
        for (int s = 1; s < 64; s <<= 1) { const float t = __shfl_up(pm, s); if (lane >= s) pm = fmaxf(pm, t); }
        float pe = __shfl_up(pm, 1); if (lane == 0) pe = -INFINITY;
        o.cm0 = fmaxf(pe, o.g0); o.cm1 = fmaxf(o.cm0, o.g1); o.G = __shfl(pm, 63);
    } else {
#pragma unroll
        for (int s = 1; s < 64; s <<= 1) { const float t = __shfl_down(pm, s); if (lane + s < 64) pm = fmaxf(pm, t); }
        float pe = __shfl_down(pm, 1); if (lane == 63) pe = -INFINITY;
        o.cm1 = fmaxf(pe, o.g1); o.cm0 = fmaxf(o.cm1, o.g0); o.G = __shfl(pm, 0);
    }
    return o;
}
__device__ __forceinline__ u32x4 scale_bf8(u32x4 v, float w) {
    u32x4 o; o.x = cvt_pk_bf16(bf_lo(v.x) * w, bf_hi(v.x) * w); o.y = cvt_pk_bf16(bf_lo(v.y) * w, bf_hi(v.y) * w); o.z = cvt_pk_bf16(bf_lo(v.z) * w, bf_hi(v.z) * w); o.w = cvt_pk_bf16(bf_lo(v.w) * w, bf_hi(v.w) * w); return o;
}

__device__ __forceinline__ void ph_mlstm_a(const Args& a, LAS unsigned char* lds, int vcu, int G, int tid, int wave, int lane) {
    unsigned char* ws = a.ws;
    const bf16* U = (const bf16*)(ws + WS_U); const float* gates = (const float*)(ws + WS_GATES);
    bf16* CS = (bf16*)(ws + WS_CS); float* NS = (float*)(ws + WS_NS); float* SCAL = (float*)(ws + WS_SCAL);
    LAS unsigned char* imgV = lds; LAS unsigned char* imgK0 = lds + 32768; LAS unsigned char* imgK1 = lds + 65536;
    LAS float* wtab = (LAS float*)(lds + TAB_OFF);
    const int wr4 = wave >> 1, wc2 = wave & 1, fr = lane & 15, fq = lane >> 4;
    for (int u = vcu; u < NB * NH * NCH; u += G) {
        const int b = u / (NH * NCH), h = (u / NCH) % NH, c = u % NCH, row0 = chunk_row0(b, c);
        u32x4 kreg[4], vreg[4];
#pragma unroll
        for (int i = 0; i < 4; ++i) { const int id = tid + 512 * i, r = id >> 4, ch = id & 15; const bf16* rp = U + (size_t)(row0 + r) * NU + 128 * h + 8 * ch;
            kreg[i] = *(const u32x4*)(rp + UC_K); vreg[i] = *(const u32x4*)(rp + UC_V); }
        if (wave < 2) { const int d = wave, t0 = 2 * lane; const float* gp = gates + (size_t)(row0 + t0) * 16 + h;
            const GateScan gs = gate_scan(d, lane, gp[(2 * d) * 4], gp[16 + (2 * d) * 4], gp[(2 * d + 1) * 4], gp[16 + (2 * d + 1) * 4]);
            wtab[d * 128 + t0] = fexp(gs.g0 - gs.G); wtab[d * 128 + t0 + 1] = fexp(gs.g1 - gs.G);
            if (lane == 0) { float* sc = SCAL + (size_t)state_idx(b, h, c, d) * 4; sc[0] = gs.B; sc[1] = gs.B + gs.G; } }
        __syncthreads();
#pragma unroll
        for (int i = 0; i < 4; ++i) { const int id = tid + 512 * i, r = id >> 4, ch = id & 15; const unsigned o = img_off((unsigned)r, (unsigned)ch);
            *(LAS u32x4*)(imgV + o) = vreg[i]; *(LAS u32x4*)(imgK0 + o) = scale_bf8(kreg[i], wtab[r]); *(LAS u32x4*)(imgK1 + o) = scale_bf8(kreg[i], wtab[128 + r]); }
        __syncthreads();
        f32x4 acc[2][2][4];
#pragma unroll
        for (int d = 0; d < 2; ++d)
#pragma unroll
            for (int mi = 0; mi < 2; ++mi)
#pragma unroll
                for (int ni = 0; ni < 4; ++ni) acc[d][mi][ni] = (f32x4){0.f, 0.f, 0.f, 0.f};
#pragma unroll 1
        for (int ks = 0; ks < 4; ++ks) {
            bf16x8 vf[2];
#pragma unroll
            for (int mi = 0; mi < 2; ++mi) vf[mi] = frag_tr(imgV, lane, 2 * wr4 + mi, ks);
#pragma unroll
            for (int d = 0; d < 2; ++d)
#pragma unroll
                for (int ni = 0; ni < 4; ++ni) { const bf16x8 kf = frag_tr(d ? imgK1 : imgK0, lane, 4 * wc2 + ni, ks);
#pragma unroll
                    for (int mi = 0; mi < 2; ++mi) acc[d][mi][ni] = __builtin_amdgcn_mfma_f32_16x16x32_bf16(kf, vf[mi], acc[d][mi][ni], 0, 0, 0); }
        }
        {
            const int d = tid >> 8, kd = (tid & 255) >> 1, half = tid & 1; const LAS unsigned char* im = d ? imgK1 : imgK0; float s = 0.f;
            for (int t = 0; t < 64; ++t) { const int sr = 64 * half + t; s += __uint_as_float((unsigned)(*(const LAS unsigned short*)(im + img_off((unsigned)sr, (unsigned)(kd >> 3)) + 2 * (kd & 7))) << 16); }
            s += __shfl_xor(s, 1);
            if (half == 0) NS[(size_t)state_idx(b, h, c, d) * 128 + kd] = s;
        }
#pragma unroll
        for (int d = 0; d < 2; ++d) { bf16* cs = CS + (size_t)state_idx(b, h, c, d) * 16384;
#pragma unroll
            for (int mi = 0; mi < 2; ++mi)
#pragma unroll
                for (int ni = 0; ni < 4; ++ni) { const int vd = 32 * wr4 + 16 * mi + fr, kd0 = 64 * wc2 + 16 * ni + 4 * fq; const f32x4 v = acc[d][mi][ni];
                    u32x2 w; w.x = cvt_pk_bf16(v[0], v[1]); w.y = cvt_pk_bf16(v[2], v[3]); *(u32x2*)(cs + vd * 128 + kd0) = w; } }
        __syncthreads();
    }
}

__device__ __forceinline__ int scan_chunk(int d, int p) { return d == 0 ? p : (p < NCH_C ? NCH_C - 1 - p : NCH + NCH_C - 1 - p); }
__device__ __forceinline__ void ph_scan(const Args& a, LAS unsigned char* lds, int vcu, int G, int tid) {
    unsigned char* ws = a.ws;
    bf16* CS = (bf16*)(ws + WS_CS); float* NS = (float*)(ws + WS_NS); float* SCAL = (float*)(ws + WS_SCAL);
    LAS float* coef = (LAS float*)lds;
    for (int w0 = vcu * 512; w0 < NB * NH * 2 * 2048; w0 += G * 512) {
        const int seq = w0 >> 11, d = seq & 1, bh = seq >> 1, chunk = (w0 & 2047) + tid;
        if (tid < 64) {
            float m = 0.f;
            for (int p = 0; p < NCH; ++p) { const int c = scan_chunk(d, p); float* sc = SCAL + (size_t)((bh * NCH + c) * 2 + d) * 4;
                const float B = sc[0], ml = sc[1], mn = fmaxf(B + m, ml);
                if (tid == 0) { coef[2 * p] = fexp(B + m - mn); coef[2 * p + 1] = fexp(ml - mn); if ((w0 & 2047) == 0) sc[2] = m; }
                m = mn; }
        }
        __syncthreads();
        float st[8];
#pragma unroll
        for (int j = 0; j < 8; ++j) st[j] = 0.f;
        u32x4* base = (u32x4*)(CS + (size_t)(bh * NCH) * 2 * 16384) + chunk;
#define SCAN_PTR(p) (base + (size_t)(scan_chunk(d, (p)) * 2 + d) * 2048)
#define SCAN_STEP(reg, p) do { const u32x4 dc = reg; if ((p) + 3 < NCH) reg = *SCAN_PTR((p) + 3); \
            u32x4 o; o.x = cvt_pk_bf16(st[0], st[1]); o.y = cvt_pk_bf16(st[2], st[3]); o.z = cvt_pk_bf16(st[4], st[5]); o.w = cvt_pk_bf16(st[6], st[7]); *SCAN_PTR(p) = o; \
            const float ca = coef[2 * (p)], cb = coef[2 * (p) + 1]; \
            st[0] = ca * st[0] + cb * bf_lo(dc.x); st[1] = ca * st[1] + cb * bf_hi(dc.x); st[2] = ca * st[2] + cb * bf_lo(dc.y); st[3] = ca * st[3] + cb * bf_hi(dc.y); \
            st[4] = ca * st[4] + cb * bf_lo(dc.z); st[5] = ca * st[5] + cb * bf_hi(dc.z); st[6] = ca * st[6] + cb * bf_lo(dc.w); st[7] = ca * st[7] + cb * bf_hi(dc.w); } while (0)
        u32x4 r0 = *SCAN_PTR(0), r1 = *SCAN_PTR(1), r2 = *SCAN_PTR(2);
        for (int p = 0; p < NCH; p += 3) { SCAN_STEP(r0, p); SCAN_STEP(r1, p + 1); SCAN_STEP(r2, p + 2); }
#undef SCAN_STEP
#undef SCAN_PTR
        if ((w0 & 2047) == 0 && tid < 128) {
            float sn = 0.f;
            for (int p = 0; p < NCH; ++p) { float* np = NS + (size_t)((bh * NCH + scan_chunk(d, p)) * 2 + d) * 128 + tid; const float dn = *np; *np = sn; sn = coef[2 * p] * sn + coef[2 * p + 1] * dn; }
        }
        __syncthreads();
    }
}

__device__ __forceinline__ void ph_mlstm_c(const Args& a, int L, LAS unsigned char* lds, int vcu, int G, int tid, int wave, int lane) {
    unsigned char* ws = a.ws;
    const bf16* U = (const bf16*)(ws + WS_U); const float* gates = (const float*)(ws + WS_GATES);
    const bf16* CS = (const bf16*)(ws + WS_CS); const float* NS = (const float*)(ws + WS_NS); const float* SCAL = (const float*)(ws + WS_SCAL);
    bf16* H = (bf16*)(ws + WS_H); const float* ghead = a.in[IN_GHEAD] + L * NH * DH;
    LAS unsigned char* imgQ = lds; LAS unsigned char* imgK = lds + 32768; LAS unsigned char* imgV = lds + 65536; LAS unsigned char* imgC = lds + 98304;
    LAS float* T_GAM = (LAS float*)(lds + TAB_OFF); LAS float* T_M = T_GAM + 256; LAS float* T_WI = T_M + 256; LAS float* T_FL = T_WI + 256; LAS float* T_NP = T_FL + 256; LAS float* T_QN = T_NP + 256;
    LAS float* T_RS = T_QN + 256;
    LAS float* T_SS = T_RS + 512;
    const int wr4 = wave >> 1, wc2 = wave & 1, fr = lane & 15, fq = lane >> 4;
    const int c_lo = (L == DEPTH - 1) ? NCH_C : 0, nc = NCH - c_lo;
    for (int u = vcu; u < NB * NH * nc; u += G) {
        const int b = u / (NH * nc), h = (u / nc) % NH, c = c_lo + u % nc, row0 = chunk_row0(b, c);
        const int si0 = state_idx(b, h, c, 0);
        u32x4 cb4[4];
        {
            u32x4 qr[4], kr[4], vr[4], cr[4];
#pragma unroll
            for (int i = 0; i < 4; ++i) { const int id = tid + 512 * i, r = id >> 4, ch = id & 15; const bf16* rp = U + (size_t)(row0 + r) * NU + 128 * h + 8 * ch;
                qr[i] = *(const u32x4*)(rp + UC_Q); kr[i] = *(const u32x4*)(rp + UC_K); vr[i] = *(const u32x4*)(rp + UC_V);
                cr[i] = *((const u32x4*)(CS + (size_t)si0 * 16384) + id); }
            if (wave < 2) { const int d = wave, t0 = 2 * lane; const float* gp = gates + (size_t)(row0 + t0) * 16 + h;
                const GateScan gs = gate_scan(d, lane, gp[(2 * d) * 4], gp[16 + (2 * d) * 4], gp[(2 * d + 1) * 4], gp[16 + (2 * d + 1) * 4]);
                const float mp = SCAL[(size_t)(si0 + d) * 4 + 2];
                const float M0 = fmaxf(mp, gs.cm0), M1 = fmaxf(mp, gs.cm1);
                T_GAM[d * 128 + t0] = gs.g0 * LOG2E; T_GAM[d * 128 + t0 + 1] = gs.g1 * LOG2E;
                T_M[d * 128 + t0] = M0 * LOG2E; T_M[d * 128 + t0 + 1] = M1 * LOG2E;
                T_WI[d * 128 + t0] = fexp(mp - M0); T_WI[d * 128 + t0 + 1] = fexp(mp - M1);
                T_FL[d * 128 + t0] = fexp(-(gs.b0 + M0)); T_FL[d * 128 + t0 + 1] = fexp(-(gs.b1 + M1)); }
            if (tid < 256) T_NP[tid] = NS[(size_t)(si0 + (tid >> 7)) * 128 + (tid & 127)];
#pragma unroll
            for (int i = 0; i < 4; ++i) { const int id = tid + 512 * i, r = id >> 4, ch = id & 15; const unsigned o = img_off((unsigned)r, (unsigned)ch);
                *(LAS u32x4*)(imgQ + o) = qr[i]; *(LAS u32x4*)(imgK + o) = kr[i]; *(LAS u32x4*)(imgV + o) = vr[i]; *(LAS u32x4*)(imgC + o) = cr[i]; }
        }
        __syncthreads();
        f32x4 S[2][4];
#pragma unroll
        for (int mi = 0; mi < 2; ++mi)
#pragma unroll
            for (int ni = 0; ni < 4; ++ni) S[mi][ni] = (f32x4){0.f, 0.f, 0.f, 0.f};
#pragma unroll 1
        for (int ks = 0; ks < 4; ++ks) { bf16x8 qf[2];
#pragma unroll
            for (int mi = 0; mi < 2; ++mi) qf[mi] = frag_row(imgQ, lane, 2 * wr4 + mi, ks);
#pragma unroll
            for (int ni = 0; ni < 4; ++ni) { const bf16x8 kf = frag_row(imgK, lane, 4 * wc2 + ni, ks);
#pragma unroll
                for (int mi = 0; mi < 2; ++mi) S[mi][ni] = __builtin_amdgcn_mfma_f32_16x16x32_bf16(kf, qf[mi], S[mi][ni], 0, 0, 0); } }
        {
            const int t = tid >> 2, part = tid & 3; float s0 = 0.f, s1 = 0.f;
#pragma unroll
            for (int cc = 0; cc < 4; ++cc) { const int ch = 4 * part + cc; const u32x4 qv = *(const LAS u32x4*)(imgQ + img_off((unsigned)t, (unsigned)ch)); const LAS float* n0 = T_NP + 8 * ch; const LAS float* n1 = T_NP + 128 + 8 * ch;
                const float qe[8] = {bf_lo(qv.x), bf_hi(qv.x), bf_lo(qv.y), bf_hi(qv.y), bf_lo(qv.z), bf_hi(qv.z), bf_lo(qv.w), bf_hi(qv.w)};
#pragma unroll
                for (int e = 0; e < 8; ++e) { s0 += qe[e] * n0[e]; s1 += qe[e] * n1[e]; } }
            s0 += __shfl_xor(s0, 1); s0 += __shfl_xor(s0, 2); s1 += __shfl_xor(s1, 1); s1 += __shfl_xor(s1, 2);
            if (part == 0) { T_QN[t] = s0; T_QN[128 + t] = s1; }
        }
        __syncthreads();
        f32x4 hs[2][4];
#pragma unroll
        for (int mi = 0; mi < 2; ++mi)
#pragma unroll
            for (int ni = 0; ni < 4; ++ni) hs[mi][ni] = (f32x4){0.f, 0.f, 0.f, 0.f};
#pragma unroll
        for (int d = 0; d < 2; ++d) {
            f32x4 acc[2][4];
#pragma unroll
            for (int mi = 0; mi < 2; ++mi)
#pragma unroll
                for (int ni = 0; ni < 4; ++ni) acc[mi][ni] = (f32x4){0.f, 0.f, 0.f, 0.f};
#pragma unroll 1
            for (int ks = 0; ks < 4; ++ks) { bf16x8 qf[2];
#pragma unroll
                for (int mi = 0; mi < 2; ++mi) qf[mi] = frag_row(imgQ, lane, 2 * wr4 + mi, ks);
#pragma unroll
                for (int ni = 0; ni < 4; ++ni) { const bf16x8 cf = frag_row(imgC, lane, 4 * wc2 + ni, ks);
#pragma unroll
                    for (int mi = 0; mi < 2; ++mi) acc[mi][ni] = __builtin_amdgcn_mfma_f32_16x16x32_bf16(cf, qf[mi], acc[mi][ni], 0, 0, 0); } }
#pragma unroll
            for (int mi = 0; mi < 2; ++mi) { const int t = 32 * wr4 + 16 * mi + fr; const float Mt = T_M[d * 128 + t], wi = T_WI[d * 128 + t]; float rs = 0.f;
#pragma unroll
                for (int ni = 0; ni < 4; ++ni) { const int s0 = 64 * wc2 + 16 * ni + 4 * fq; const f32x4 gm = *(const LAS f32x4*)(T_GAM + d * 128 + s0); float sp[4];
#pragma unroll
                    for (int j = 0; j < 4; ++j) { const int s = s0 + j; const bool ok = d == 0 ? (s <= t) : (s >= t); const float w = ok ? fexp2(gm[j] - Mt) : 0.f; sp[j] = S[mi][ni][j] * w; rs += sp[j]; }
                    u32x2 w2; w2.x = cvt_pk_bf16(sp[0], sp[1]); w2.y = cvt_pk_bf16(sp[2], sp[3]);
                    *(LAS u32x2*)(imgK + img_off((unsigned)t, (unsigned)(s0 >> 3)) + 2 * (s0 & 7)) = w2;
                    acc[mi][ni] = acc[mi][ni] * wi; }
                rs += __shfl_xor(rs, 16); rs += __shfl_xor(rs, 32);
                if (fq == 0) T_RS[(d * 128 + t) * 2 + wc2] = rs; }
            __syncthreads();
#pragma unroll 1
            for (int ks = 0; ks < 4; ++ks) { bf16x8 sf[2];
#pragma unroll
                for (int mi = 0; mi < 2; ++mi) sf[mi] = frag_row(imgK, lane, 2 * wr4 + mi, ks);
#pragma unroll
                for (int ni = 0; ni < 4; ++ni) { const bf16x8 vf = frag_tr(imgV, lane, 4 * wc2 + ni, ks);
#pragma unroll
                    for (int mi = 0; mi < 2; ++mi) acc[mi][ni] = __builtin_amdgcn_mfma_f32_16x16x32_bf16(vf, sf[mi], acc[mi][ni], 0, 0, 0); } }
#pragma unroll
            for (int mi = 0; mi < 2; ++mi) { const int t = 32 * wr4 + 16 * mi + fr;
                const float den = T_WI[d * 128 + t] * T_QN[d * 128 + t] + T_RS[(d * 128 + t) * 2] + T_RS[(d * 128 + t) * 2 + 1];
                const float rinv = 1.0f / fmaxf(fabsf(den), T_FL[d * 128 + t]);
#pragma unroll
                for (int ni = 0; ni < 4; ++ni) hs[mi][ni] = hs[mi][ni] + acc[mi][ni] * rinv; }
            if (d == 0) { __syncthreads();
#pragma unroll
                for (int i = 0; i < 4; ++i) { const int id = tid + 512 * i; cb4[i] = *((const u32x4*)(CS + (size_t)(si0 + 1) * 16384) + id); }
#pragma unroll
                for (int i = 0; i < 4; ++i) { const int id = tid + 512 * i; *(LAS u32x4*)(imgC + img_off((unsigned)(id >> 4), (unsigned)(id & 15))) = cb4[i]; }
                __syncthreads(); }
        }
#pragma unroll
        for (int mi = 0; mi < 2; ++mi) { const int t = 32 * wr4 + 16 * mi + fr; float ss = 0.f;
#pragma unroll
            for (int ni = 0; ni < 4; ++ni) { const f32x4 v = hs[mi][ni]; ss += (v[0] * v[0] + v[1] * v[1]) + (v[2] * v[2] + v[3] * v[3]); }
            ss += __shfl_xor(ss, 16); ss += __shfl_xor(ss, 32);
            if (fq == 0) T_SS[t * 2 + wc2] = ss; }
        __syncthreads();
#pragma unroll
        for (int mi = 0; mi < 2; ++mi) { const int t = 32 * wr4 + 16 * mi + fr; const float rstd = __builtin_amdgcn_rsqf((T_SS[t * 2] + T_SS[t * 2 + 1]) * (1.0f / DH) + EPS);
#pragma unroll
            for (int ni = 0; ni < 4; ++ni) { const int vd0 = 64 * wc2 + 16 * ni + 4 * fq; const u32x2 ow = *(const u32x2*)(U + (size_t)(row0 + t) * NU + UC_O + 128 * h + vd0);
                const f32x4 gh = *(const f32x4*)(ghead + h * DH + vd0); const f32x4 v = hs[mi][ni];
                const float o0 = bf_lo(ow.x), o1 = bf_hi(ow.x), o2 = bf_lo(ow.y), o3 = bf_hi(ow.y);
                const float y0 = v[0] * rstd * gh[0] / (1.0f + fexp(-o0)), y1 = v[1] * rstd * gh[1] / (1.0f + fexp(-o1)), y2 = v[2] * rstd * gh[2] / (1.0f + fexp(-o2)), y3 = v[3] * rstd * gh[3] / (1.0f + fexp(-o3));
                u32x2 w; w.x = cvt_pk_bf16(y0, y1); w.y = cvt_pk_bf16(y2, y3);
                *(u32x2*)(H + (size_t)(row0 + t) * D + 512 + 128 * h + vd0) = w; } }
        __syncthreads();
    }
}

__device__ __forceinline__ void ph_conv(const Args& a, int L, int vcu, int G, int wave, int lane) {
    unsigned char* ws = a.ws; const bf16* U = (const bf16*)(ws + WS_U); bf16* H = (bf16*)(ws + WS_H);
    const float* cw = a.in[IN_CONVW] + L * 3 * 512 + 8 * lane; const float* cbp = a.in[IN_CONVB] + L * 512 + 8 * lane;
    float w0[8], w1[8], w2[8], bb[8];
#pragma unroll
    for (int e = 0; e < 8; ++e) { w0[e] = cw[e]; w1[e] = cw[512 + e]; w2[e] = cw[1024 + e]; bb[e] = cbp[e]; }
    const int nrows = (L == DEPTH - 1) ? NLAT : NTOK;
    for (int row = vcu * 8 + wave; row < nrows; row += G * 8) {
        bool lv, rv; if (row < NLAT) { const int t = row & 63; lv = t != 0; rv = t != 63; } else { const int t = (row - NLAT) & 255; lv = t != 0; rv = t != 255; }
        const bf16* rp = U + (size_t)row * NU + 8 * lane;
        const u32x4 zb = {0u, 0u, 0u, 0u};
        const u32x4 bv = *(const u32x4*)(rp + UC_B), c0 = *(const u32x4*)(rp + UC_C), x0 = *(const u32x4*)(rp + UC_X);
        const u32x4 cl = lv ? *(const u32x4*)(rp - NU + UC_C) : zb, xl = lv ? *(const u32x4*)(rp - NU + UC_X) : zb;
        const u32x4 cr = rv ? *(const u32x4*)(rp + NU + UC_C) : zb, xr = rv ? *(const u32x4*)(rp + NU + UC_X) : zb;
        float y[8];
#pragma unroll
        for (int q = 0; q < 4; ++q) {
            const float m0 = bf_lo(c0[q]) * bf_lo(x0[q]), m1 = bf_hi(c0[q]) * bf_hi(x0[q]);
            const float l0 = bf_lo(cl[q]) * bf_lo(xl[q]), l1 = bf_hi(cl[q]) * bf_hi(xl[q]);
            const float r0 = bf_lo(cr[q]) * bf_lo(xr[q]), r1 = bf_hi(cr[q]) * bf_hi(xr[q]);
            y[2 * q] = bf_lo(bv[q]) * (w0[2 * q] * l0 + w1[2 * q] * m0 + w2[2 * q] * r0 + bb[2 * q]);
            y[2 * q + 1] = bf_hi(bv[q]) * (w0[2 * q + 1] * l1 + w1[2 * q + 1] * m1 + w2[2 * q + 1] * r1 + bb[2 * q + 1]); }
        u32x4 o; o.x = cvt_pk_bf16(y[0], y[1]); o.y = cvt_pk_bf16(y[2], y[3]); o.z = cvt_pk_bf16(y[4], y[5]); o.w = cvt_pk_bf16(y[6], y[7]);
        *(u32x4*)(H + (size_t)row * D + 8 * lane) = o;
    }
}

__device__ __forceinline__ int block_sum(int v, LAS int* sh, int& par, int wave, int lane) {
    if (lane == 0) sh[par * 8 + wave] = v;
    __syncthreads();
    int s = 0;
#pragma unroll
    for (int w = 0; w < 8; ++w) s += sh[par * 8 + w];
    par ^= 1;
    return s;
}
__device__ __forceinline__ int block_excl_scan(int v, int& total, LAS int* sh, int& par, int wave, int lane) {
    int inc = v;
#pragma unroll
    for (int s = 1; s < 64; s <<= 1) { const int t = __shfl_up(inc, s); if (lane >= s) inc += t; }
    if (lane == 63) sh[par * 8 + wave] = inc;
    __syncthreads();
    int pre = 0, tot = 0;
#pragma unroll
    for (int w = 0; w < 8; ++w) { const int x = sh[par * 8 + w]; tot += x; if (w < wave) pre += x; }
    par ^= 1; total = tot;
    return pre + inc - v;
}
__device__ __forceinline__ void ph_topk(const Args& a, int L, LAS unsigned char* lds, int vcu, int G, int tid, int wave, int lane) {
    unsigned char* ws = a.ws; const float* afft = (const float*)(ws + WS_AFFT);
    int* idx = (int*)(ws + WS_IDX); float* gsel = (float*)(ws + WS_GSEL); int* inv = (int*)(ws + WS_INV);
    LAS int* sh = (LAS int*)lds; int par = 0;
    const int nitems = (L == 0) ? 256 : 128;
    for (int item = vcu; item < nitems; item += G) {
        const bool lat = item < 128; const int b = (item & 127) >> 4, e = item & 15;
        const int n = lat ? SEQ : CTXL, k = lat ? CAP_L : CAP_C, tok0 = lat ? b * SEQ : NLAT + b * CTXL;
        const int slot0 = lat ? (e * NB + b) * CAP_L : NSLOT_L + (e * NB + b) * CAP_C;
        const float* av = afft + (size_t)e * NTOK + tok0;
        unsigned v[16];
        if (tid * 16 < n) {
#pragma unroll
            for (int q = 0; q < 4; ++q) { const f32x4 x = *(const f32x4*)(av + tid * 16 + 4 * q); v[4 * q] = __float_as_uint(x.x); v[4 * q + 1] = __float_as_uint(x.y); v[4 * q + 2] = __float_as_uint(x.z); v[4 * q + 3] = __float_as_uint(x.w); }
        } else {
#pragma unroll
            for (int j = 0; j < 16; ++j) v[j] = 0u;
        }
        unsigned T = 0u;
        for (int bit = 30; bit >= 0; --bit) { const unsigned cand = T | (1u << bit); int cnt = 0;
#pragma unroll
            for (int j = 0; j < 16; ++j) cnt += (int)__popcll(__ballot(v[j] >= cand));
            if (block_sum(cnt, sh, par, wave, lane) >= k) T = cand; }
        int gtc = 0, eqc = 0;
#pragma unroll
        for (int j = 0; j < 16; ++j) { gtc += (v[j] > T) ? 1 : 0; eqc += (v[j] == T) ? 1 : 0; }
        int tot_gt, tot_eq;
        (void)block_excl_scan(gtc, tot_gt, sh, par, wave, lane);
        int eq_before = block_excl_scan(eqc, tot_eq, sh, par, wave, lane);
        const int need_eq = k - tot_gt;
        unsigned selmask = 0u; int nsel = 0;
#pragma unroll
        for (int j = 0; j < 16; ++j) { bool s = v[j] > T; if (v[j] == T) { s = eq_before < need_eq; ++eq_before; } if (s) { selmask |= 1u << j; ++nsel; } }
        int tot_sel; int pos = block_excl_scan(nsel, tot_sel, sh, par, wave, lane);
        if (tid * 16 < n) {
#pragma unroll
            for (int j = 0; j < 16; ++j) { const int tok = tok0 + tid * 16 + j;
                if (selmask & (1u << j)) { const int slot = slot0 + pos; ++pos; idx[slot] = tok; gsel[slot] = __uint_as_float(v[j]); inv[(size_t)tok * 16 + e] = slot; }
                else inv[(size_t)tok * 16 + e] = -1; }
        }
    }
}
__device__ __forceinline__ void ph_gather(const Args& a, int L, int vcu, int G, int wave, int lane) {
    unsigned char* ws = a.ws; const bf16* H = (const bf16*)(ws + WS_H); bf16* XE = (bf16*)(ws + WS_XE); const int* idx = (const int*)(ws + WS_IDX);
    const int nslot = (L == 0) ? NSLOT : NSLOT_L;
    for (int s = vcu * 8 + wave; s < nslot; s += G * 8) { const int row = idx[s];
        const u32x4 v0 = *((const u32x4*)(H + (size_t)row * D) + lane), v1 = *((const u32x4*)(H + (size_t)row * D) + 64 + lane);
        *((u32x4*)(XE + (size_t)s * D) + lane) = v0; *((u32x4*)(XE + (size_t)s * D) + 64 + lane) = v1; }
}

constexpr int PH_PER_LAYER = 12, N_PHASES = 1 + DEPTH * PH_PER_LAYER;
__global__ void __launch_bounds__(512, 2) mk_fwd(Args args) {
    extern __shared__ __attribute__((aligned(16))) unsigned char lds_raw[];
    LAS unsigned char* lds = (LAS unsigned char*)lds_raw;
    const int tid0 = threadIdx.x;
    const int G = gridDim.x; const int bx = blockIdx.x; const int vcu = (G % 8 == 0) ? (bx % 8) * (G / 8) + bx / 8 : bx;
    volatile LAS unsigned* MISC = (volatile LAS unsigned*)(lds + MISC_OFF);
    if (tid0 < 64) MISC[tid0] = 0u;
    __syncthreads();
    XcdBarrier bar = xcd_barrier_post((unsigned*)(args.ws + WS_CTL) + 4096, MISC + 8);
    const int lo = args.ph_lo, hi = args.ph_hi;
#define CAS __attribute__((address_space(4)))
#define OPQ() const CAS Args* ap_ = (const CAS Args*)__builtin_amdgcn_kernarg_segment_ptr(); asm volatile("" : "+s"(ap_)); Args A; \
    _Pragma("unroll") for (int i_ = 0; i_ < 19; ++i_) A.in[i_] = (const float*)(const GAS float*)(ap_->in[i_]); \
    A.out = (float*)(GAS float*)(ap_->out); A.ws = (unsigned char*)(GAS unsigned char*)(ap_->ws); A.ph_lo = 0; A.ph_hi = 0; unsigned char* ws = A.ws; (void)ws; \
    int tid = tid0; asm volatile("" : "+v"(tid)); const int lane = tid & 63, wave = __builtin_amdgcn_readfirstlane(tid >> 6); (void)lane; (void)wave
#ifndef MK_PHMASK
#define MK_PHMASK 0x1fff
#endif
#define EN(p) (((MK_PHMASK) >> (p)) & 1)
#define IN(k) (lo <= (k) && (k) < hi)
#define SEAM(k) do { if (IN(k) && IN((k) + 1)) xcd_barrier(bar); } while (0)
    if (EN(12) && IN(0)) { OPQ(); ph_prologue(A, lds, vcu, G, tid, wave, lane); }
    SEAM(0);
    for (int L = 0; L < DEPTH; ++L) {
        const int pb = 1 + L * PH_PER_LAYER;
        if (EN(0) && IN(pb + 0)) { OPQ(); ph_convert(A, L, lds, vcu, G, wave, lane); __syncthreads(); if (L == 0) ph_prepass1_l0(A, lds, vcu, G, tid, wave, lane); }
        SEAM(pb + 0);
        if (EN(1) && IN(pb + 1)) { OPQ(); pg8::Gemm g{(const bf16*)(ws + WS_H), (const bf16*)(ws + WS_WIN), 1024}; pg8::Sched S; S.init(NTOK / 256, NU / 256, G, bx, 0);
            pg8::EpiU E{(bf16*)(ws + WS_U), NU}; pg8::gemm_phase<pg8::EpiU>(lds, g, S, E, tid); }
        SEAM(pb + 1);
        if (EN(2) && IN(pb + 2)) { OPQ(); ph_mlstm_a(A, lds, vcu, G, tid, wave, lane); }
        SEAM(pb + 2);
        if (EN(3) && IN(pb + 3)) { OPQ(); ph_scan(A, lds, vcu, G, tid); }
        SEAM(pb + 3);
        if (EN(4) && IN(pb + 4)) { OPQ(); ph_mlstm_c(A, L, lds, vcu, G, tid, wave, lane); ph_conv(A, L, vcu, G, wave, lane); }
        SEAM(pb + 4);
        if (EN(5) && IN(pb + 5)) { OPQ(); pg8::Gemm g{(const bf16*)(ws + WS_H), (const bf16*)(ws + WS_WOUT), 1024}; pg8::Sched S; S.init((L == DEPTH - 1 ? NLAT : NTOK) / 256, 4, G, bx, 0);
            pg8::EpiRes E{L == 0 ? A.in[IN_X] : A.out, L == 0 ? A.in[IN_CTX] : (const float*)(ws + WS_XC), A.out, (float*)(ws + WS_XC), (const float*)(ws + WS_MODV) + (size_t)L * 9 * 6144};
            pg8::gemm_phase<pg8::EpiRes>(lds, g, S, E, tid); }
        SEAM(pb + 5);
        if (EN(6) && IN(pb + 6)) { OPQ(); ph_prepass2(A, L, lds, vcu, G, tid, wave, lane); }
        SEAM(pb + 6);
        if (EN(7) && IN(pb + 7)) { OPQ(); ph_topk(A, L, lds, vcu, G, tid, wave, lane); }
        SEAM(pb + 7);
        if (EN(8) && IN(pb + 8)) { OPQ(); ph_gather(A, L, vcu, G, wave, lane); }
        SEAM(pb + 8);
        if (EN(9) && IN(pb + 9)) { OPQ(); pg8::Gemm g{(const bf16*)(ws + WS_XE), (const bf16*)(ws + WS_WGU), 1024}; pg8::Sched S; S.init((L == 0 ? NSLOT : NSLOT_L) / 256, 11, G, bx, 1);
            pg8::EpiGU E{(bf16*)(ws + WS_HM)}; pg8::gemm_phase<pg8::EpiGU>(lds, g, S, E, tid); }
        SEAM(pb + 9);
        if (EN(10) && IN(pb + 10)) { OPQ(); pg8::Gemm g{(const bf16*)(ws + WS_HM), (const bf16*)(ws + WS_WD), DE}; pg8::Sched S; S.init((L == 0 ? NSLOT : NSLOT_L) / 256, 4, G, bx, 1);
            pg8::EpiD E{(bf16*)(ws + WS_XE), (const float*)(ws + WS_GSEL)}; pg8::gemm_phase<pg8::EpiD>(lds, g, S, E, tid); }
        SEAM(pb + 10);
        if (EN(11) && IN(pb + 11)) { OPQ(); ph_combine(A, L, lds, vcu, G, tid, wave, lane); }
        SEAM(pb + 11);
    }
#undef IN
#undef SEAM
}

extern "C" void kernel_launch(void* const* d_in, const int* in_sizes, int n_in, void* d_out, int out_size, void* d_ws, size_t ws_size, hipStream_t stream) {
    static int grid = 0;
    if (grid == 0) {
        if (n_in != 19 || out_size != NLAT * D || ws_size < WS_END) { fprintf(stderr, "kernel_launch: unexpected problem (n_in %d, out %d, ws %zu < %zu)\n", n_in, out_size, ws_size, (size_t)WS_END); grid = -1; return; }
        int dev = 0, cus = 0, per_cu = 0;
        if (hipGetDevice(&dev) != hipSuccess || hipDeviceGetAttribute(&cus, hipDeviceAttributeMultiprocessorCount, dev) != hipSuccess) { grid = -1; return; }
        if (hipFuncSetAttribute((const void*)mk_fwd, hipFuncAttributeMaxDynamicSharedMemorySize, LDS_BYTES) != hipSuccess) { fprintf(stderr, "kernel_launch: hipFuncSetAttribute failed\n"); grid = -1; return; }
        if (hipOccupancyMaxActiveBlocksPerMultiprocessor(&per_cu, (const void*)mk_fwd, 512, LDS_BYTES) != hipSuccess || per_cu < 1) fprintf(stderr, "kernel_launch: occupancy query says %d\n", per_cu);
        (void)hipGetLastError();
        grid = cus;
    }
    if (grid < 0) return;
    (void)hipMemsetAsync((char*)d_ws + WS_CTL, 0, CTL_ZERO_BYTES, stream);
    Args a{};
    for (int i = 0; i < 19; ++i) a.in[i] = (const float*)d_in[i];
    a.out = (float*)d_out; a.ws = (unsigned char*)d_ws;
#if MK_ONE_LAUNCH
    a.ph_lo = 0; a.ph_hi = N_PHASES;
    hipLaunchKernelGGL(mk_fwd, dim3(grid), dim3(512), LDS_BYTES, stream, a);
#else
    for (int p = 0; p < N_PHASES; ++p) { a.ph_lo = p; a.ph_hi = p + 1; hipLaunchKernelGGL(mk_fwd, dim3(grid), dim3(512), LDS_BYTES, stream, a); }
#endif
}
```

```cpp
#include <hip/hip_runtime.h>
#include <cstdio>
#include <cstdint>

#ifndef MK_ONE_LAUNCH
#define MK_ONE_LAUNCH 1
#endif

#define GAS __attribute__((address_space(1)))
#define LAS __attribute__((address_space(3)))
typedef unsigned short bf16;
typedef short bf16x8 __attribute__((ext_vector_type(8)));
typedef short s16x4 __attribute__((ext_vector_type(4)));
typedef float f32x4 __attribute__((ext_vector_type(4)));
typedef float f32x2 __attribute__((ext_vector_type(2)));
typedef unsigned u32x4 __attribute__((ext_vector_type(4)));
typedef unsigned u32x2 __attribute__((ext_vector_type(2)));

constexpr int D = 1024, NB = 8, SEQ = 8192, CTXL = 256, DEPTH = 2;
constexpr int NLAT = NB * SEQ, NCTX = NB * CTXL, NTOK = NLAT + NCTX;
constexpr int DPROJ = 3600, NU = 3584;
constexpr int NH = 4, DH = 128, NCH_C = 2, NCH_L = 64, NCH = 66;
constexpr int NE = 16, DE = 1408, CAP_L = 1024, CAP_C = 32;
constexpr int NSLOT_L = NB * NE * CAP_L, NSLOT = NSLOT_L + NB * NE * CAP_C;
constexpr int NMOD = 6;
constexpr float EPS = 1e-6f;
constexpr float LOG2E = 1.4426950408889634f;
constexpr int UC_B = 0, UC_C = 512, UC_X = 1024, UC_Q = 1536, UC_K = 2048, UC_V = 2560, UC_O = 3072;

constexpr size_t MiB = 1u << 20;
constexpr size_t WS_CTL = 0, CTL_ZERO_BYTES = 1 * MiB;
constexpr size_t WS_MODV = 1 * MiB;
constexpr size_t WS_WG = 1 * MiB + 512 * 1024;
constexpr size_t WS_WR = WS_WG + 64 * 1024;
constexpr size_t WS_GATES = 2 * MiB;
constexpr size_t WS_AFFT = 7 * MiB;
constexpr size_t WS_INV = 12 * MiB;
constexpr size_t WS_IDX = 17 * MiB;
constexpr size_t WS_GSEL = 18 * MiB;
constexpr size_t WS_SCAL = 19 * MiB;
constexpr size_t WS_NS = 20 * MiB;
constexpr size_t WS_XC = 24 * MiB;
constexpr size_t WS_WIN = 32 * MiB;
constexpr size_t WS_WOUT = 39 * MiB;
constexpr size_t WS_WGU = 41 * MiB;
constexpr size_t WS_WD = 129 * MiB;
constexpr size_t WS_H = 173 * MiB;
constexpr size_t WS_R = 305 * MiB;
constexpr size_t WS_U = WS_R;
constexpr size_t WS_CS = WS_R + 462 * MiB;
constexpr size_t WS_XE = WS_R;
constexpr size_t WS_HM = WS_R + 264 * MiB;
constexpr size_t WS_END = WS_R + 627 * MiB;
static_assert((size_t)NTOK * NU * 2 == 462 * MiB && (size_t)NSLOT * 1024 * 2 == 264 * MiB && (size_t)NSLOT * DE * 2 == 363 * MiB, "sizes");
static_assert(WS_CS + (size_t)NB * NH * NCH * 2 * 32768 <= WS_END, "CS");

constexpr int RING_BYTES = 131072, TAB_OFF = 131072, TAB_BYTES = 16384, MISC_OFF = TAB_OFF + TAB_BYTES, LDS_BYTES = MISC_OFF + 256;

__device__ __forceinline__ unsigned cvt_pk_bf16(float lo, float hi) { unsigned r; asm volatile("v_cvt_pk_bf16_f32 %0, %1, %2" : "=v"(r) : "v"(lo), "v"(hi)); return r; }
__device__ __forceinline__ float bf_lo(unsigned w) { return __uint_as_float(w << 16); }
__device__ __forceinline__ float bf_hi(unsigned w) { return __uint_as_float(w & 0xffff0000u); }
__device__ __forceinline__ float wave_sum(float v) {
#pragma unroll
    for (int o = 1; o < 64; o <<= 1) v += __shfl_xor(v, o);
    return v;
}
__device__ __forceinline__ float fexp2(float x) { return __builtin_amdgcn_exp2f(x); }
__device__ __forceinline__ float fexp(float x) { return __builtin_amdgcn_exp2f(x * LOG2E); }
#define LDS_WAIT() asm volatile("s_waitcnt lgkmcnt(0)" ::: "memory")
#define VM_WAIT() asm volatile("s_waitcnt vmcnt(0)" ::: "memory")

namespace pg8 {
constexpr int BM = 256, BK = 64, HALF = 128, HTB = HALF * BK * 2, STAGE_BYTES = 8 * HTB, NXCD = 8, WGM = 8;
__host__ __device__ __forceinline__ int lds_byte(int r, int c) { const int st = (r >> 4) * 2 + (c >> 5), rr = r & 15, cc = c & 31, ob = rr * 64 + cc * 2; return st * 1024 + (ob ^ (((ob >> 9) & 1) << 5)); }
__host__ __device__ __forceinline__ void stage_rc(int b, int& R, int& C) { const int st = b / 1024, sb = b % 1024, swz = sb ^ (((sb >> 9) & 1) << 5); R = (st >> 1) * 16 + swz / 64; C = (st & 1) * 32 + (swz % 64) / 2; }
__host__ __device__ __forceinline__ int perm32(int rho) { const int n = rho >> 4, i = rho & 15; return 8 * (i >> 2) + 4 * n + (i & 3); }

struct Unit { int pm, pn, bt; };
struct Gemm { const bf16* A; const bf16* Bt; int K; };

struct Sched {
    int nM, nN, nwg, G, c, moe;
    __device__ __forceinline__ void init(int nM_, int nN_, int G_, int c_, int moe_) { nM = nM_; nN = nN_; nwg = nM * nN; G = G_; c = c_; moe = moe_; }
    __device__ __forceinline__ bool next(int i, Unit& u) const {
        const long L = (long)i * G + c; if (L >= nwg) return false;
        int wgid = (int)L; { const int q = nwg / NXCD, r = nwg % NXCD, xcd = wgid % NXCD, off = wgid / NXCD; wgid = (xcd < r ? xcd * (q + 1) : r * (q + 1) + (xcd - r) * q) + off; }
        const int nig = WGM * nN, gid = wgid / nig, fm = gid * WGM, gsz = (nM - fm) < WGM ? (nM - fm) : WGM;
        u.pm = fm + ((wgid % nig) % gsz); u.pn = (wgid % nig) / gsz;
        u.bt = moe ? ((u.pm < 512 ? (u.pm >> 5) : (u.pm - 512)) * nN + u.pn) : u.pn;
        return true;
    }
};

struct EpiU {
    static constexpr bool PERM = true;
    bf16* O; int ldc;
    __device__ __forceinline__ void operator()(const f32x4 (&acc)[2][2][4][2], const Unit& u, int wr, int wc, int fr, int fq) const {
        const int row0 = u.pm * BM + wr * 64 + fr, col0 = u.pn * BM + wc * 32 + 8 * fq;
#pragma unroll
        for (int ai = 0; ai < 2; ++ai)
#pragma unroll
            for (int m = 0; m < 4; ++m) { bf16* rowp = O + (size_t)(row0 + ai * HALF + m * 16) * ldc + col0;
#pragma unroll
                for (int bj = 0; bj < 2; ++bj) { const f32x4 v0 = acc[ai][bj][m][0], v1 = acc[ai][bj][m][1];
                    u32x4 w; w.x = cvt_pk_bf16(v0[0], v0[1]); w.y = cvt_pk_bf16(v0[2], v0[3]); w.z = cvt_pk_bf16(v1[0], v1[1]); w.w = cvt_pk_bf16(v1[2], v1[3]);
                    *(u32x4*)(rowp + bj * HALF) = w; } }
    }
};
struct EpiRes {
    static constexpr bool PERM = false;
    const float* base_lat; const float* base_ctx; float* out_lat; float* out_ctx; const float* modv;
    __device__ __forceinline__ void operator()(const f32x4 (&acc)[2][2][4][2], const Unit& u, int wr, int wc, int fr, int fq) const {
        const bool lat = u.pm < 256; const int g = lat ? (u.pm >> 5) : 8;
        const int rowt = (lat ? u.pm : u.pm - 256) * BM + wr * 64 + fr, col0 = u.pn * BM + wc * 32 + 4 * fq;
        const float* base = lat ? base_lat : base_ctx; float* out = lat ? out_lat : out_ctx;
        f32x4 gv[2][2];
#pragma unroll
        for (int bj = 0; bj < 2; ++bj)
#pragma unroll
            for (int n = 0; n < 2; ++n) gv[bj][n] = *(const f32x4*)(modv + g * 6144 + 2 * 1024 + col0 + bj * HALF + n * 16);
#pragma unroll
        for (int ai = 0; ai < 2; ++ai)
#pragma unroll
            for (int m = 0; m < 4; ++m) { const size_t off = (size_t)(rowt + ai * HALF + m * 16) * D + col0;
#pragma unroll
                for (int bj = 0; bj < 2; ++bj)
#pragma unroll
                    for (int n = 0; n < 2; ++n) { const f32x4 bs = *(const f32x4*)(base + off + bj * HALF + n * 16); *(f32x4*)(out + off + bj * HALF + n * 16) = bs + gv[bj][n] * acc[ai][bj][m][n]; }
                asm volatile("" ::: "memory"); }
    }
};
struct EpiGU {
    static constexpr bool PERM = true;
    bf16* O;
    __device__ __forceinline__ void operator()(const f32x4 (&acc)[2][2][4][2], const Unit& u, int wr, int wc, int fr, int fq) const {
        const int row0 = u.pm * BM + wr * 64 + fr, col0 = u.pn * HALF + wc * 32 + 8 * fq;
#pragma unroll
        for (int ai = 0; ai < 2; ++ai)
#pragma unroll
            for (int m = 0; m < 4; ++m) { bf16* rowp = O + (size_t)(row0 + ai * HALF + m * 16) * DE + col0;
                float r[8];
#pragma unroll
                for (int n = 0; n < 2; ++n)
#pragma unroll
                    for (int j = 0; j < 4; ++j) { const float a = acc[ai][0][m][n][j], b = acc[ai][1][m][n][j]; r[4 * n + j] = a * __builtin_amdgcn_rcpf(1.0f + fexp2(-a * LOG2E)) * b; }
                u32x4 w; w.x = cvt_pk_bf16(r[0], r[1]); w.y = cvt_pk_bf16(r[2], r[3]); w.z = cvt_pk_bf16(r[4], r[5]); w.w = cvt_pk_bf16(r[6], r[7]);
                *(u32x4*)rowp = w; }
    }
};
struct EpiD {
    static constexpr bool PERM = true;
    bf16* O; const float* gsel;
    __device__ __forceinline__ void operator()(const f32x4 (&acc)[2][2][4][2], const Unit& u, int wr, int wc, int fr, int fq) const {
        const int row0 = u.pm * BM + wr * 64 + fr, col0 = u.pn * BM + wc * 32 + 8 * fq;
#pragma unroll
        for (int ai = 0; ai < 2; ++ai)
#pragma unroll
            for (int m = 0; m < 4; ++m) { const int row = row0 + ai * HALF + m * 16; const float gs = gsel[row]; bf16* rowp = O + (size_t)row * D + col0;
#pragma unroll
                for (int bj = 0; bj < 2; ++bj) { const f32x4 v0 = acc[ai][bj][m][0] * gs, v1 = acc[ai][bj][m][1] * gs;
                    u32x4 w; w.x = cvt_pk_bf16(v0[0], v0[1]); w.y = cvt_pk_bf16(v0[2], v0[3]); w.z = cvt_pk_bf16(v1[0], v1[1]); w.w = cvt_pk_bf16(v1[2], v1[3]);
                    *(u32x4*)(rowp + bj * HALF) = w; } }
    }
};

template <class Epi>
__device__ __forceinline__ void gemm_phase(LAS unsigned char* lds, const Gemm g, const Sched& S, const Epi& E, const int tid) {
    const int wid = __builtin_amdgcn_readfirstlane(tid >> 6), lane = tid & 63, wr = wid >> 2, wc = wid & 3, fr = lane & 15, fq = lane >> 4;
    const int K = g.K, nt = K / BK;
    unsigned voffA[2], voffB[2];
#pragma unroll
    for (int i = 0; i < 2; ++i) { int R, C; stage_rc(tid * 16 + i * 8192, R, C); const int Rb = Epi::PERM ? ((R & ~31) + perm32(R & 31)) : R;
        voffA[i] = (unsigned)(R * K + C) * 2u; voffB[i] = (unsigned)(Rb * K + C) * 2u; }
    const size_t kstep = (size_t)(BK * 2);
    const size_t hstep = (size_t)HALF * K * 2;
    const size_t tstep = 2 * hstep;
    const unsigned ldsw = (unsigned)wid * 1024u;
    const int aoff = lds_byte(wr * 64 + fr, fq * 8), boff = lds_byte(wc * 32 + fr, fq * 8);
#define PG8_SA(b, h) (((b) * 2 + (h)) * HTB)
#define PG8_SB(b, h) ((4 + (b) * 2 + (h)) * HTB)
#define PG8_STAGE(bufoff, gbase, voff) do { _Pragma("unroll") for (int _i = 0; _i < 2; ++_i) \
        __builtin_amdgcn_global_load_lds((const unsigned*)((const char*)(gbase) + (voff)[_i]), (LAS unsigned*)(lds + (bufoff) + ldsw + _i * 8192), 16, 0, 0); } while (0)
#define PG8_LDA(dst, b, h) do { _Pragma("unroll") for (int m = 0; m < 4; ++m) _Pragma("unroll") for (int k = 0; k < 2; ++k) dst[m][k] = *(const LAS bf16x8*)(lds + PG8_SA(b, h) + aoff + m * 2048 + k * 1024); } while (0)
#define PG8_LDB(dst, b, h) do { _Pragma("unroll") for (int n = 0; n < 2; ++n) _Pragma("unroll") for (int k = 0; k < 2; ++k) dst[n][k] = *(const LAS bf16x8*)(lds + PG8_SB(b, h) + boff + n * 2048 + k * 1024); } while (0)
#define PG8_MMA(ai, bj, At, Bt) do { __builtin_amdgcn_s_setprio(1); _Pragma("unroll") for (int m = 0; m < 4; ++m) _Pragma("unroll") for (int n = 0; n < 2; ++n) _Pragma("unroll") for (int k = 0; k < 2; ++k) \
        acc[ai][bj][m][n] = __builtin_amdgcn_mfma_f32_16x16x32_bf16(Bt[n][k], At[m][k], acc[ai][bj][m][n], 0, 0, 0); __builtin_amdgcn_s_setprio(0); } while (0)
#define PG8_WAIT_V(n) asm volatile("s_waitcnt vmcnt(" #n ")" ::: "memory")
#define PG8_WAIT_L(n) asm volatile("s_waitcnt lgkmcnt(" #n ")" ::: "memory")
#define PG8_BAR __builtin_amdgcn_s_barrier()
#define PG8_SCHED __builtin_amdgcn_sched_barrier(0)
    Unit cur, nxt; int ui = 0;
    if (!S.next(0, cur)) return;
    f32x4 acc[2][2][4][2];
#pragma unroll
    for (int a = 0; a < 2; ++a)
#pragma unroll
        for (int b = 0; b < 2; ++b)
#pragma unroll
            for (int m = 0; m < 4; ++m)
#pragma unroll
                for (int n = 0; n < 2; ++n) acc[a][b][m][n] = (f32x4){0.f, 0.f, 0.f, 0.f};
    bf16x8 At[4][2], B0[2][2], B1[2][2];
    const char* cA = (const char*)g.A + (size_t)cur.pm * tstep; const char* cB = (const char*)g.Bt + (size_t)cur.bt * tstep;
    PG8_STAGE(PG8_SB(0, 0), cB, voffB); PG8_STAGE(PG8_SB(0, 1), cB + hstep, voffB); PG8_STAGE(PG8_SA(0, 0), cA, voffA); PG8_STAGE(PG8_SA(0, 1), cA + hstep, voffA);
    if (wr == 1) PG8_BAR;
    PG8_WAIT_V(2); PG8_BAR;
    PG8_STAGE(PG8_SB(1, 0), cB + kstep, voffB); PG8_STAGE(PG8_SA(1, 0), cA + kstep, voffA); PG8_STAGE(PG8_SB(1, 1), cB + hstep + kstep, voffB);
    PG8_WAIT_V(6); PG8_BAR;
    for (;;) {
        const bool has_next = S.next(ui + 1, nxt);
        const char* nA = has_next ? (const char*)g.A + (size_t)nxt.pm * tstep : cA; const char* nB = has_next ? (const char*)g.Bt + (size_t)nxt.bt * tstep : cB;
        for (int t = 0; t < nt; t += 2) {
            const bool last = (t == nt - 2);
            const char* a1 = cA + (size_t)(t + 1) * kstep;
            const char* a2 = last ? nA : cA + (size_t)(t + 2) * kstep; const char* b2 = last ? nB : cB + (size_t)(t + 2) * kstep;
            const char* a3 = a2 + kstep; const char* b3 = b2 + kstep;
            PG8_LDB(B0, 0, 0); PG8_LDB(B1, 0, 1); PG8_SCHED; PG8_LDA(At, 0, 0); PG8_STAGE(PG8_SA(1, 1), a1 + hstep, voffA);
            PG8_WAIT_V(8); PG8_WAIT_L(0); PG8_BAR; PG8_MMA(0, 0, At, B0); PG8_MMA(0, 1, At, B1); PG8_BAR; PG8_SCHED;
            PG8_LDA(At, 0, 1); PG8_STAGE(PG8_SB(0, 0), b2, voffB); PG8_STAGE(PG8_SB(0, 1), b2 + hstep, voffB); PG8_STAGE(PG8_SA(0, 0), a2, voffA);
            PG8_WAIT_V(8); PG8_WAIT_L(0); PG8_BAR; PG8_MMA(1, 0, At, B0); PG8_MMA(1, 1, At, B1); PG8_BAR; PG8_SCHED;
            PG8_LDB(B0, 1, 0); PG8_LDB(B1, 1, 1); PG8_SCHED; PG8_LDA(At, 1, 0); PG8_STAGE(PG8_SA(0, 1), a2 + hstep, voffA);
            PG8_WAIT_V(8); PG8_WAIT_L(0); PG8_BAR; PG8_MMA(0, 0, At, B0); PG8_MMA(0, 1, At, B1); PG8_BAR; PG8_SCHED;
            PG8_LDA(At, 1, 1); PG8_STAGE(PG8_SB(1, 0), b3, voffB); PG8_STAGE(PG8_SB(1, 1), b3 + hstep, voffB); PG8_STAGE(PG8_SA(1, 0), a3, voffA);
            PG8_WAIT_V(8); PG8_WAIT_L(0); PG8_BAR; PG8_MMA(1, 0, At, B0); PG8_MMA(1, 1, At, B1); PG8_BAR; PG8_SCHED;
        }
        if (wr == 0) PG8_BAR;
        E(acc, cur, wr, wc, fr, fq);
        if (!has_next) break;
#pragma unroll
        for (int a = 0; a < 2; ++a)
#pragma unroll
            for (int b = 0; b < 2; ++b)
#pragma unroll
                for (int m = 0; m < 4; ++m)
#pragma unroll
                    for (int n = 0; n < 2; ++n) acc[a][b][m][n] = (f32x4){0.f, 0.f, 0.f, 0.f};
        cur = nxt; cA = nA; cB = nB; ++ui;
        if (wr == 1) PG8_BAR;
    }
    PG8_WAIT_V(0);
    PG8_BAR;
#undef PG8_SA
#undef PG8_SB
#undef PG8_STAGE
#undef PG8_LDA
#undef PG8_LDB
#undef PG8_MMA
#undef PG8_WAIT_V
#undef PG8_WAIT_L
#undef PG8_BAR
#undef PG8_SCHED
}
}

#define XB_TMO      128
#define XB_XCNT(j)  (256  + 64 * (j))
#define XB_XSUB(j)  (1280 + 64 * (j))
#define XB_XGEN(j)  (2304 + 64 * (j))
#define XB_TOP      3328
#define XB_TOPGEN   3392
#define XCD_BAR_WORDS 3456
#define XB_SPIN_CAP (1u << 18)
__device__ __forceinline__ unsigned xb_ld(unsigned* p)              { return __hip_atomic_load(p, __ATOMIC_RELAXED, __HIP_MEMORY_SCOPE_AGENT); }
__device__ __forceinline__ unsigned xb_add(unsigned* p, unsigned v) { return __hip_atomic_fetch_add(p, v, __ATOMIC_RELAXED, __HIP_MEMORY_SCOPE_AGENT); }
__device__ __forceinline__ unsigned xb_xcc_id() { return (unsigned)__builtin_amdgcn_s_getreg((3 << 11) | 20) & 0xFu; }
#define XB_SPIN(cond, bar) do { unsigned _sp = 0; while (cond) { __builtin_amdgcn_s_sleep(1); \
    if ((++_sp & 255u) == 0u) { if (xb_ld(&(bar)[XB_TMO])) break; if (_sp > XB_SPIN_CAP) { atomicAdd(&(bar)[XB_TMO], 1u); break; } } } } while (0)
struct XcdBarrier { unsigned* bar; unsigned x; volatile LAS unsigned* st; };
__device__ __forceinline__ XcdBarrier xcd_barrier_post(unsigned* bar, volatile LAS unsigned* st) {
    XcdBarrier b; b.bar = bar; b.x = xb_xcc_id(); b.st = st;
    if (threadIdx.x == 0) (void)xb_add(&bar[XB_XCNT(b.x)], 1u);
    return b;
}
__device__ __forceinline__ void xcd_barrier_complete(unsigned* bar, unsigned x, unsigned& nloc, unsigned& nx) {
    const unsigned G = gridDim.x * gridDim.y * gridDim.z;
    unsigned sum, cnt, mine, sp = 0u;
    for (;;) {
        sum = 0u; cnt = 0u; mine = 0u;
#pragma unroll
        for (unsigned j = 0; j < 16; ++j) { const unsigned c = xb_ld(&bar[XB_XCNT(j)]); sum += c; cnt += (c > 0u) ? 1u : 0u; mine = (j == x) ? c : mine; }
        if (sum == G) break;
        __builtin_amdgcn_s_sleep(1);
        if ((++sp & 255u) == 0u) { if (xb_ld(&bar[XB_TMO])) break; if (sp > XB_SPIN_CAP) { atomicAdd(&bar[XB_TMO], 1u); break; } }
    }
    nloc = mine > 0u ? mine : 1u; nx = cnt > 0u ? cnt : 1u;
}
__device__ __forceinline__ void xcd_barrier(const XcdBarrier& b) {
    asm volatile("s_waitcnt vmcnt(0)" ::: "memory");
    __syncthreads();
    if (threadIdx.x == 0) {
        unsigned* bar = b.bar;
        __builtin_amdgcn_s_waitcnt(0);
        unsigned nloc = b.st[0], nx = b.st[1];
        if (nloc == 0u) { xcd_barrier_complete(bar, b.x, nloc, nx); b.st[0] = nloc; b.st[1] = nx; }
        const unsigned old = xb_add(&bar[XB_XSUB(b.x)], 1u);
        const unsigned gen = old / nloc;
        if (old + 1u == (gen + 1u) * nloc) {
            __builtin_amdgcn_fence(__ATOMIC_RELEASE, "agent");
            asm volatile("s_waitcnt vmcnt(0)" ::: "memory");
            const unsigned og = xb_add(&bar[XB_TOP], 1u);
            const unsigned tg = og / nx;
            if (og + 1u == (tg + 1u) * nx) xb_add(&bar[XB_TOPGEN], 1u);
            else XB_SPIN(xb_ld(&bar[XB_TOPGEN]) == tg, bar);
            __builtin_amdgcn_fence(__ATOMIC_ACQUIRE, "agent");
            xb_add(&bar[XB_XGEN(b.x)], 1u);
            asm volatile("s_waitcnt vmcnt(0)" ::: "memory");
        } else {
            XB_SPIN(xb_ld(&bar[XB_XGEN(b.x)]) == gen, bar);
            __builtin_amdgcn_fence(__ATOMIC_ACQUIRE, "agent");
            asm volatile("s_waitcnt vmcnt(0)" ::: "memory");
        }
    }
    __syncthreads();
}

struct Args { const float* in[19]; float* out; unsigned char* ws; int ph_lo, ph_hi; };
enum { IN_X = 0, IN_C, IN_CTX, IN_CCTX, IN_WMOD, IN_BMOD, IN_G1, IN_G2, IN_WIN, IN_WOUT, IN_CONVW, IN_CONVB, IN_GATEB, IN_GHEAD, IN_WROUTER, IN_WGATE, IN_WUP, IN_WDOWN, IN_GFINAL };

__device__ __forceinline__ void ph_prologue(const Args& a, LAS unsigned char* lds, int vcu, int G, int tid, int wave, int lane) {
    unsigned char* ws = a.ws;
    bf16* wg = (bf16*)(ws + WS_WG); bf16* wrt = (bf16*)(ws + WS_WR);
    const float* w_in = a.in[IN_WIN]; const float* w_router = a.in[IN_WROUTER];
    for (int i = vcu * 512 + tid; i < 2 * 16 * 1024; i += G * 512) { const int L = i >> 14, j = (i >> 10) & 15, k = i & 1023;
        wg[i] = (bf16)(cvt_pk_bf16(w_in[((size_t)L * 1024 + k) * DPROJ + NU + j], 0.f) & 0xffffu);
        wrt[i] = (bf16)(cvt_pk_bf16(w_router[((size_t)L * 1024 + k) * NE + j], 0.f) & 0xffffu); }
    LAS float* sv = (LAS float*)lds;
    LAS float* red = (LAS float*)(lds + 9 * 1024 * 4);
    const float* c = a.in[IN_C]; const float* cctx = a.in[IN_CCTX];
    for (int i = tid; i < 9 * 1024; i += 512) { const int g = i >> 10, k = i & 1023; const float v = g < 8 ? c[g * 1024 + k] : cctx[k]; sv[i] = v / (1.0f + __expf(-v)); }
    __syncthreads();
    const float* w_mod = a.in[IN_WMOD]; const float* b_mod = a.in[IN_BMOD]; float* modv = (float*)(ws + WS_MODV);
    for (int item = vcu; item < 2 * 96; item += G) {
        const int L = item / 96, cb = item % 96, col = cb * 64 + lane;
        float acc[9];
#pragma unroll
        for (int g = 0; g < 9; ++g) acc[g] = 0.f;
        for (int kk = 0; kk < 128; ++kk) { const int k = wave * 128 + kk; const float wv = w_mod[((size_t)L * 1024 + k) * 6144 + col];
#pragma unroll
            for (int g = 0; g < 9; ++g) acc[g] += sv[g * 1024 + k] * wv; }
#pragma unroll
        for (int g = 0; g < 9; ++g) red[(wave * 9 + g) * 64 + lane] = acc[g];
        __syncthreads();
        for (int o = tid; o < 9 * 64; o += 512) { const int g = o >> 6, l = o & 63; float s = b_mod[L * 6144 + cb * 64 + l];
#pragma unroll
            for (int w = 0; w < 8; ++w) s += red[(w * 9 + g) * 64 + l];
            modv[(size_t)(L * 9 + g) * 6144 + cb * 64 + l] = s; }
        __syncthreads();
    }
}

__device__ __forceinline__ void transpose_item(const float* src, int ld, int k0, int n0, bf16* dst, int dstK, int row0, float scale, LAS float* scr, int lane) {
#pragma unroll 8
    for (int i = 0; i < 32; ++i) { const int kk = 2 * i + (lane >> 5); scr[kk * 33 + (lane & 31)] = src[(size_t)(k0 + kk) * ld + n0 + (lane & 31)] * scale; }
    LDS_WAIT(); asm volatile("" ::: "memory");
    const int c = lane & 7;
#pragma unroll
    for (int j = 0; j < 4; ++j) { const int n = (lane >> 3) + 8 * j; const LAS float* s = scr + (8 * c) * 33 + n;
        u32x4 o; o.x = cvt_pk_bf16(s[0 * 33], s[1 * 33]); o.y = cvt_pk_bf16(s[2 * 33], s[3 * 33]); o.z = cvt_pk_bf16(s[4 * 33], s[5 * 33]); o.w = cvt_pk_bf16(s[6 * 33], s[7 * 33]);
        *(u32x4*)(dst + (size_t)(row0 + n) * dstK + k0 + 8 * c) = o; }
    LDS_WAIT(); asm volatile("" ::: "memory");
}
__device__ __forceinline__ void ph_convert(const Args& a, int L, LAS unsigned char* lds, int vcu, int G, int wave, int lane) {
    unsigned char* ws = a.ws;
    LAS float* scr = (LAS float*)(lds + wave * 16384);
    const int gw = vcu * 8 + wave, NGW = G * 8;
    constexpr int NI_IN = 16 * 112, NI_OUT = 16 * 32, NI_E = 704, NI_GU = NE * 2 * NI_E, NI_DN = NE * NI_E, NITEMS = NI_IN + NI_OUT + NI_GU + NI_DN;
    for (int it = gw; it < NITEMS; it += NGW) {
        int r = it;
        if (r < NI_IN) { const int kb = r / 112, nb = r % 112, n0 = 32 * nb;
            transpose_item(a.in[IN_WIN] + (size_t)L * 1024 * DPROJ, DPROJ, 64 * kb, n0, (bf16*)(ws + WS_WIN), 1024, n0, (n0 >= UC_Q && n0 < UC_K) ? 0.08838834764831845f : 1.0f, scr, lane); continue; }
        r -= NI_IN;
        if (r < NI_OUT) { const int kb = r / 32, nb = r % 32;
            transpose_item(a.in[IN_WOUT] + (size_t)L * 1024 * 1024, 1024, 64 * kb, 32 * nb, (bf16*)(ws + WS_WOUT), 1024, 32 * nb, 1.0f, scr, lane); continue; }
        r -= NI_OUT;
        if (r < NI_GU) { const int e = r / (2 * NI_E), rr = r % (2 * NI_E), which = rr / NI_E, q = rr % NI_E, kb = q / 44, nb = q % 44, n0 = 32 * nb;
            const float* src = (which ? a.in[IN_WUP] : a.in[IN_WGATE]) + ((size_t)L * NE + e) * 1024 * DE;
            transpose_item(src, DE, 64 * kb, n0, (bf16*)(ws + WS_WGU) + (size_t)e * 2816 * 1024, 1024, 256 * (n0 >> 7) + 128 * which + (n0 & 127), 1.0f, scr, lane); continue; }
        r -= NI_GU;
        { const int e = r / NI_E, q = r % NI_E, kb = q / 32, nb = q % 32;
            transpose_item(a.in[IN_WDOWN] + ((size_t)L * NE + e) * DE * 1024, 1024, 64 * kb, 32 * nb, (bf16*)(ws + WS_WD) + (size_t)e * 1024 * DE, DE, 32 * nb, 1.0f, scr, lane); }
    }
}

__device__ __forceinline__ void row_load(const float* p, int lane, f32x4 (&v)[4]) {
#pragma unroll
    for (int j = 0; j < 4; ++j) v[j] = *((const f32x4*)p + lane + 64 * j);
}
__device__ __forceinline__ float row_rstd(const f32x4 (&v)[4]) {
    float s = 0.f;
#pragma unroll
    for (int j = 0; j < 4; ++j) s += (v[j].x * v[j].x + v[j].y * v[j].y) + (v[j].z * v[j].z + v[j].w * v[j].w);
    return __builtin_amdgcn_rsqf(wave_sum(s) * (1.0f / D) + EPS);
}
__device__ __forceinline__ void row_mod_store(const f32x4 (&v)[4], float rstd, const float* gn, const float* shift, const float* scale, bf16* hrow, int lane) {
#pragma unroll
    for (int j = 0; j < 4; ++j) { const int c = 4 * lane + 256 * j; const f32x4 g = *(const f32x4*)(gn + c), sh = *(const f32x4*)(shift + c), sc = *(const f32x4*)(scale + c);
        const f32x4 h = v[j] * rstd * g * (sc + 1.0f) + sh;
        u32x2 w; w.x = cvt_pk_bf16(h.x, h.y); w.y = cvt_pk_bf16(h.z, h.w); *(u32x2*)(hrow + c) = w; }
}
constexpr int WT_STRIDE = 2064;
__device__ __forceinline__ void stage_wt(const bf16* wt, LAS unsigned char* lds, int tid) {
    for (int i = tid; i < 16 * 128; i += 512) { const int r = i >> 7, ch = i & 127; *(LAS u32x4*)(lds + r * WT_STRIDE + ch * 16) = *(const u32x4*)(wt + r * 1024 + ch * 8); }
    __syncthreads();
}
template <bool TOKFIRST>
__device__ __forceinline__ f32x4 skinny16(const bf16* hrows, LAS unsigned char* wl, int lane) {
    const int r = lane & 15, g = lane >> 4;
    f32x4 acc = {0.f, 0.f, 0.f, 0.f};
    const bf16* hp = hrows + (size_t)r * 1024 + 8 * g;
    const LAS unsigned char* wp = wl + r * WT_STRIDE + 16 * g;
#pragma unroll
    for (int kb = 0; kb < 4; ++kb) {
        bf16x8 hf[8];
#pragma unroll
        for (int k = 0; k < 8; ++k) hf[k] = __builtin_nontemporal_load((const bf16x8*)(hp + 32 * (kb * 8 + k)));
#pragma unroll
        for (int k = 0; k < 8; ++k) { const bf16x8 wf = *(const LAS bf16x8*)(wp + 64 * (kb * 8 + k));
            acc = TOKFIRST ? __builtin_amdgcn_mfma_f32_16x16x32_bf16(hf[k], wf, acc, 0, 0, 0) : __builtin_amdgcn_mfma_f32_16x16x32_bf16(wf, hf[k], acc, 0, 0, 0); }
    }
    return acc;
}

__device__ __forceinline__ int row_cond(int row) { return row < NLAT ? (row >> 13) : 8; }

__device__ __forceinline__ void gates_store(const f32x4 acc, const float* gate_b_l, float* gates, int row0, int lane) {
    const int fq = lane >> 4; const f32x4 gb = *(const f32x4*)(gate_b_l + 4 * fq);
    *(f32x4*)(gates + (size_t)(row0 + (lane & 15)) * 16 + 4 * fq) = acc + gb;
}
__device__ __forceinline__ void router_store(const f32x4 acc, float* afft, int row0, int lane) {
    f32x4 mx = acc;
#pragma unroll
    for (int o = 1; o < 16; o <<= 1) { f32x4 t; t.x = __shfl_xor(mx.x, o); t.y = __shfl_xor(mx.y, o); t.z = __shfl_xor(mx.z, o); t.w = __shfl_xor(mx.w, o);
        mx.x = fmaxf(mx.x, t.x); mx.y = fmaxf(mx.y, t.y); mx.z = fmaxf(mx.z, t.z); mx.w = fmaxf(mx.w, t.w); }
    f32x4 ex; ex.x = __expf(acc.x - mx.x); ex.y = __expf(acc.y - mx.y); ex.z = __expf(acc.z - mx.z); ex.w = __expf(acc.w - mx.w);
    f32x4 sm = ex;
#pragma unroll
    for (int o = 1; o < 16; o <<= 1) { f32x4 t; t.x = __shfl_xor(sm.x, o); t.y = __shfl_xor(sm.y, o); t.z = __shfl_xor(sm.z, o); t.w = __shfl_xor(sm.w, o); sm = sm + t; }
    f32x4 o4; o4.x = ex.x / sm.x; o4.y = ex.y / sm.y; o4.z = ex.z / sm.z; o4.w = ex.w / sm.w;
    *(f32x4*)(afft + (size_t)(lane & 15) * NTOK + row0 + 4 * (lane >> 4)) = o4;
}

__device__ __forceinline__ void ph_prepass1_l0(const Args& a, LAS unsigned char* lds, int vcu, int G, int tid, int wave, int lane) {
    unsigned char* ws = a.ws; const int L = 0;
    stage_wt((const bf16*)(ws + WS_WG) + (size_t)L * 16 * 1024, lds + TAB_OFF - 16 * WT_STRIDE, tid);
    LAS unsigned char* wl = lds + TAB_OFF - 16 * WT_STRIDE;
    const float* modv = (const float*)(ws + WS_MODV) + (size_t)L * 9 * 6144; const float* gn = a.in[IN_G1] + L * 1024;
    bf16* H = (bf16*)(ws + WS_H); float* gates = (float*)(ws + WS_GATES);
    for (int grp = vcu * 8 + wave; grp < NTOK / 16; grp += G * 8) {
        const int row0 = grp * 16, g = row_cond(row0);
        const float* src = row0 < NLAT ? a.in[IN_X] + (size_t)row0 * D : a.in[IN_CTX] + (size_t)(row0 - NLAT) * D;
        for (int r = 0; r < 16; ++r) { f32x4 v[4]; row_load(src + (size_t)r * D, lane, v); const float rstd = row_rstd(v);
            row_mod_store(v, rstd, gn, modv + g * 6144 + 0 * 1024, modv + g * 6144 + 1 * 1024, H + (size_t)(row0 + r) * D, lane); }
        VM_WAIT();
        const f32x4 acc = skinny16<false>(H + (size_t)row0 * D, wl, lane);
        gates_store(acc, a.in[IN_GATEB] + L * 16, gates, row0, lane);
    }
}

__device__ __forceinline__ void ph_prepass2(const Args& a, int L, LAS unsigned char* lds, int vcu, int G, int tid, int wave, int lane) {
    unsigned char* ws = a.ws;
    LAS unsigned char* wl = lds;
    stage_wt((const bf16*)(ws + WS_WR) + (size_t)L * 16 * 1024, wl, tid);
    const float* modv = (const float*)(ws + WS_MODV) + (size_t)L * 9 * 6144; const float* gn = a.in[IN_G2] + L * 1024;
    bf16* H = (bf16*)(ws + WS_H); float* afft = (float*)(ws + WS_AFFT);
    const int ngrp = (L == 0 ? NTOK : NLAT) / 16;
    for (int grp = vcu * 8 + wave; grp < ngrp; grp += G * 8) {
        const int row0 = grp * 16, g = row_cond(row0);
        const float* src = row0 < NLAT ? a.out + (size_t)row0 * D : (const float*)(ws + WS_XC) + (size_t)(row0 - NLAT) * D;
        for (int r = 0; r < 16; ++r) { f32x4 v[4]; row_load(src + (size_t)r * D, lane, v); const float rstd = row_rstd(v);
            row_mod_store(v, rstd, gn, modv + g * 6144 + 3 * 1024, modv + g * 6144 + 4 * 1024, H + (size_t)(row0 + r) * D, lane); }
        VM_WAIT();
        const f32x4 acc = skinny16<true>(H + (size_t)row0 * D, wl, lane);
        router_store(acc, afft, row0, lane);
    }
}

__device__ __forceinline__ void ph_combine(const Args& a, int L, LAS unsigned char* lds, int vcu, int G, int tid, int wave, int lane) {
    unsigned char* ws = a.ws; const bool last = (L == DEPTH - 1);
    LAS unsigned char* wl = lds;
    if (!last) stage_wt((const bf16*)(ws + WS_WG) + (size_t)(L + 1) * 16 * 1024, wl, tid);
    const float* modv = (const float*)(ws + WS_MODV) + (size_t)L * 9 * 6144;
    const float* modn = (const float*)(ws + WS_MODV) + (size_t)(L + 1 < DEPTH ? L + 1 : L) * 9 * 6144;
    const float* gn = last ? a.in[IN_GFINAL] : a.in[IN_G1] + (L + 1) * 1024;
    bf16* H = (bf16*)(ws + WS_H); float* gates = (float*)(ws + WS_GATES);
    const bf16* ye = (const bf16*)(ws + WS_XE); const int* inv = (const int*)(ws + WS_INV);
    const int ngrp = (last ? NLAT : NTOK) / 16;
    for (int grp = vcu * 8 + wave; grp < ngrp; grp += G * 8) {
        const int row0 = grp * 16, g = row_cond(row0);
        float* xs = row0 < NLAT ? a.out + (size_t)row0 * D : (float*)(ws + WS_XC) + (size_t)(row0 - NLAT) * D;
        for (int r = 0; r < 16; ++r) {
            f32x4 v[4]; row_load(xs + (size_t)r * D, lane, v);
            const int myinv = inv[(size_t)(row0 + r) * 16 + (lane & 15)];
            f32x4 s[4];
#pragma unroll
            for (int j = 0; j < 4; ++j) s[j] = (f32x4){0.f, 0.f, 0.f, 0.f};
            for (int e = 0; e < NE; ++e) { const int slot = __shfl(myinv, e);
                if (slot >= 0) { const bf16* yr = ye + (size_t)slot * D;
#pragma unroll
                    for (int j = 0; j < 4; ++j) { const u32x2 w = *(const u32x2*)(yr + 4 * lane + 256 * j); s[j].x += bf_lo(w.x); s[j].y += bf_hi(w.x); s[j].z += bf_lo(w.y); s[j].w += bf_hi(w.y); } } }
#pragma unroll
            for (int j = 0; j < 4; ++j) { const f32x4 g2 = *(const f32x4*)(modv + g * 6144 + 5 * 1024 + 4 * lane + 256 * j); v[j] = v[j] + g2 * s[j]; }
            const float rstd = row_rstd(v);
            if (last) {
#pragma unroll
                for (int j = 0; j < 4; ++j) { const f32x4 gf = *(const f32x4*)(gn + 4 * lane + 256 * j); *((f32x4*)(xs + (size_t)r * D) + lane + 64 * j) = v[j] * rstd * gf; }
            } else {
#pragma unroll
                for (int j = 0; j < 4; ++j) *((f32x4*)(xs + (size_t)r * D) + lane + 64 * j) = v[j];
                row_mod_store(v, rstd, gn, modn + g * 6144 + 0 * 1024, modn + g * 6144 + 1 * 1024, H + (size_t)(row0 + r) * D, lane);
            }
        }
        if (!last) { VM_WAIT();
            const f32x4 acc = skinny16<false>(H + (size_t)row0 * D, wl, lane);
            gates_store(acc, a.in[IN_GATEB] + (L + 1) * 16, gates, row0, lane); }
    }
}

__device__ __forceinline__ unsigned img_off(unsigned row, unsigned ch) { return 256u * row + 16u * (ch ^ (((row & 3u) << 2) | ((row >> 2) & 3u))); }
__device__ __forceinline__ bf16x8 frag_row(const LAS unsigned char* img, int lane, int rb, int s) { return *(const LAS bf16x8*)(img + img_off((unsigned)((lane & 15) + 16 * rb), (unsigned)(4 * s + (lane >> 4)))); }
__device__ __forceinline__ bf16x8 frag_tr(const LAS unsigned char* img, int lane, int c, int ks) {
    const unsigned g = (unsigned)lane >> 4, q = ((unsigned)lane & 15u) >> 2, p = (unsigned)lane & 3u;
    const s16x4 lo = __builtin_amdgcn_ds_read_tr16_b64_v4i16((LAS s16x4*)(img + img_off(32u * ks + 8u * g + q, 2u * c + (p >> 1)) + 8u * (p & 1u)));
    const s16x4 hi = __builtin_amdgcn_ds_read_tr16_b64_v4i16((LAS s16x4*)(img + img_off(32u * ks + 8u * g + 4u + q, 2u * c + (p >> 1)) + 8u * (p & 1u)));
    return __builtin_shufflevector(lo, hi, 0, 1, 2, 3, 4, 5, 6, 7);
}
__device__ __forceinline__ int chunk_row0(int b, int c) { return c < NCH_C ? NLAT + b * CTXL + c * 128 : b * SEQ + (c - NCH_C) * 128; }
__device__ __forceinline__ int state_idx(int b, int h, int c, int d) { return ((b * NH + h) * NCH + c) * 2 + d; }

struct GateScan { float b0, b1, g0, g1, cm0, cm1, B, G; };
__device__ __forceinline__ float logsigmoid(float x) { return fminf(x, 0.f) - log1pf(__expf(-fabsf(x))); }
__device__ __forceinline__ GateScan gate_scan(int d, int lane, float i0, float i1, float f0, float f1) {
    GateScan o; const float l0 = logsigmoid(f0), l1 = logsigmoid(f1);
    float inc = l0 + l1;
    if (d == 0) {
#pragma unroll
        for (int s = 1; s < 64; s <<= 1) { const float t = __shfl_up(inc, s); if (lane >= s) inc += t; }
        o.b1 = inc; o.b0 = inc - l1; o.B = __shfl(inc, 63);
    } else {
#pragma unroll
        for (int s = 1; s < 64; s <<= 1) { const float t = __shfl_down(inc, s); if (lane + s < 64) inc += t; }
        o.b0 = inc; o.b1 = inc - l0; o.B = __shfl(inc, 0);
    }
    o.g0 = i0 - o.b0; o.g1 = i1 - o.b1;
    float pm = fmaxf(o.g0, o.g1);
    if (d == 0) {
#pragma unroll
        for (int s = 1; s < 64; s <<= 1) { const float t = __shfl_up(pm, s); if (lane >= s) pm = fmaxf(pm, t); }
        float pe = __shfl_up(pm, 1); if (lane == 0) pe = -INFINITY;
        o.cm0 = fmaxf(pe, o.g0); o.cm1 = fmaxf(o.cm0, o.g1); o.G = __shfl(pm, 63);
    } else {
#pragma unroll
        for (int s = 1; s < 64; s <<= 1) { const float t = __shfl_down(pm, s); if (lane + s < 64) pm = fmaxf(pm, t); }
        float pe = __shfl_down(pm, 1); if (lane == 63) pe = -INFINITY;
        o.cm1 = fmaxf(pe, o.g1); o.cm0 = fmaxf(o.cm1, o.g0); o.G = __shfl(pm, 0);
    }
    return o;
}
__device__ __forceinline__ u32x4 scale_bf8(u32x4 v, float w) {
    u32x4 o; o.x = cvt_pk_bf16(bf_lo(v.x) * w, bf_hi(v.x) * w); o.y = cvt_pk_bf16(bf_lo(v.y) * w, bf_hi(v.y) * w); o.z = cvt_pk_bf16(bf_lo(v.z) * w, bf_hi(v.z) * w); o.w = cvt_pk_bf16(bf_lo(v.w) * w, bf_hi(v.w) * w); return o;
}

__device__ __forceinline__ void ph_mlstm_a(const Args& a, LAS unsigned char* lds, int vcu, int G, int tid, int wave, int lane) {
    unsigned char* ws = a.ws;
    const bf16* U = (const bf16*)(ws + WS_U); const float* gates = (const float*)(ws + WS_GATES);
    bf16* CS = (bf16*)(ws + WS_CS); float* NS = (float*)(ws + WS_NS); float* SCAL = (float*)(ws + WS_SCAL);
    LAS unsigned char* imgV = lds; LAS unsigned char* imgK0 = lds + 32768; LAS unsigned char* imgK1 = lds + 65536;
    LAS float* wtab = (LAS float*)(lds + TAB_OFF);
    const int wr4 = wave >> 1, wc2 = wave & 1, fr = lane & 15, fq = lane >> 4;
    for (int u = vcu; u < NB * NH * NCH; u += G) {
        const int b = u / (NH * NCH), h = (u / NCH) % NH, c = u % NCH, row0 = chunk_row0(b, c);
        u32x4 kreg[4], vreg[4];
#pragma unroll
        for (int i = 0; i < 4; ++i) { const int id = tid + 512 * i, r = id >> 4, ch = id & 15; const bf16* rp = U + (size_t)(row0 + r) * NU + 128 * h + 8 * ch;
            kreg[i] = *(const u32x4*)(rp + UC_K); vreg[i] = *(const u32x4*)(rp + UC_V); }
        if (wave < 2) { const int d = wave, t0 = 2 * lane; const float* gp = gates + (size_t)(row0 + t0) * 16 + h;
            const GateScan gs = gate_scan(d, lane, gp[(2 * d) * 4], gp[16 + (2 * d) * 4], gp[(2 * d + 1) * 4], gp[16 + (2 * d + 1) * 4]);
            wtab[d * 128 + t0] = fexp(gs.g0 - gs.G); wtab[d * 128 + t0 + 1] = fexp(gs.g1 - gs.G);
            if (lane == 0) { float* sc = SCAL + (size_t)state_idx(b, h, c, d) * 4; sc[0] = gs.B; sc[1] = gs.B + gs.G; } }
        __syncthreads();
#pragma unroll
        for (int i = 0; i < 4; ++i) { const int id = tid + 512 * i, r = id >> 4, ch = id & 15; const unsigned o = img_off((unsigned)r, (unsigned)ch);
            *(LAS u32x4*)(imgV + o) = vreg[i]; *(LAS u32x4*)(imgK0 + o) = scale_bf8(kreg[i], wtab[r]); *(LAS u32x4*)(imgK1 + o) = scale_bf8(kreg[i], wtab[128 + r]); }
        __syncthreads();
        f32x4 acc[2][2][4];
#pragma unroll
        for (int d = 0; d < 2; ++d)
#pragma unroll
            for (int mi = 0; mi < 2; ++mi)
#pragma unroll
                for (int ni = 0; ni < 4; ++ni) acc[d][mi][ni] = (f32x4){0.f, 0.f, 0.f, 0.f};
#pragma unroll 1
        for (int ks = 0; ks < 4; ++ks) {
            bf16x8 vf[2];
#pragma unroll
            for (int mi = 0; mi < 2; ++mi) vf[mi] = frag_tr(imgV, lane, 2 * wr4 + mi, ks);
#pragma unroll
            for (int d = 0; d < 2; ++d)
#pragma unroll
                for (int ni = 0; ni < 4; ++ni) { const bf16x8 kf = frag_tr(d ? imgK1 : imgK0, lane, 4 * wc2 + ni, ks);
#pragma unroll
                    for (int mi = 0; mi < 2; ++mi) acc[d][mi][ni] = __builtin_amdgcn_mfma_f32_16x16x32_bf16(kf, vf[mi], acc[d][mi][ni], 0, 0, 0); }
        }
        {
            const int d = tid >> 8, kd = (tid & 255) >> 1, half = tid & 1; const LAS unsigned char* im = d ? imgK1 : imgK0; float s = 0.f;
            for (int t = 0; t < 64; ++t) { const int sr = 64 * half + t; s += __uint_as_float((unsigned)(*(const LAS unsigned short*)(im + img_off((unsigned)sr, (unsigned)(kd >> 3)) + 2 * (kd & 7))) << 16); }
            s += __shfl_xor(s, 1);
            if (half == 0) NS[(size_t)state_idx(b, h, c, d) * 128 + kd] = s;
        }
#pragma unroll
        for (int d = 0; d < 2; ++d) { bf16* cs = CS + (size_t)state_idx(b, h, c, d) * 16384;
#pragma unroll
            for (int mi = 0; mi < 2; ++mi)
#pragma unroll
                for (int ni = 0; ni < 4; ++ni) { const int vd = 32 * wr4 + 16 * mi + fr, kd0 = 64 * wc2 + 16 * ni + 4 * fq; const f32x4 v = acc[d][mi][ni];
                    u32x2 w; w.x = cvt_pk_bf16(v[0], v[1]); w.y = cvt_pk_bf16(v[2], v[3]); *(u32x2*)(cs + vd * 128 + kd0) = w; } }
        __syncthreads();
    }
}

__device__ __forceinline__ int scan_chunk(int d, int p) { return d == 0 ? p : (p < NCH_C ? NCH_C - 1 - p : NCH + NCH_C - 1 - p); }
__device__ __forceinline__ void ph_scan(const Args& a, LAS unsigned char* lds, int vcu, int G, int tid) {
    unsigned char* ws = a.ws;
    bf16* CS = (bf16*)(ws + WS_CS); float* NS = (float*)(ws + WS_NS); float* SCAL = (float*)(ws + WS_SCAL);
    LAS float* coef = (LAS float*)lds;
    for (int w0 = vcu * 512; w0 < NB * NH * 2 * 2048; w0 += G * 512) {
        const int seq = w0 >> 11, d = seq & 1, bh = seq >> 1, chunk = (w0 & 2047) + tid;
        if (tid < 64) {
            float m = 0.f;
            for (int p = 0; p < NCH; ++p) { const int c = scan_chunk(d, p); float* sc = SCAL + (size_t)((bh * NCH + c) * 2 + d) * 4;
                const float B = sc[0], ml = sc[1], mn = fmaxf(B + m, ml);
                if (tid == 0) { coef[2 * p] = fexp(B + m - mn); coef[2 * p + 1] = fexp(ml - mn); if ((w0 & 2047) == 0) sc[2] = m; }
                m = mn; }
        }
        __syncthreads();
        float st[8];
#pragma unroll
        for (int j = 0; j < 8; ++j) st[j] = 0.f;
        u32x4* base = (u32x4*)(CS + (size_t)(bh * NCH) * 2 * 16384) + chunk;
#define SCAN_PTR(p) (base + (size_t)(scan_chunk(d, (p)) * 2 + d) * 2048)
#define SCAN_STEP(reg, p) do { const u32x4 dc = reg; if ((p) + 3 < NCH) reg = *SCAN_PTR((p) + 3); \
            u32x4 o; o.x = cvt_pk_bf16(st[0], st[1]); o.y = cvt_pk_bf16(st[2], st[3]); o.z = cvt_pk_bf16(st[4], st[5]); o.w = cvt_pk_bf16(st[6], st[7]); *SCAN_PTR(p) = o; \
            const float ca = coef[2 * (p)], cb = coef[2 * (p) + 1]; \
            st[0] = ca * st[0] + cb * bf_lo(dc.x); st[1] = ca * st[1] + cb * bf_hi(dc.x); st[2] = ca * st[2] + cb * bf_lo(dc.y); st[3] = ca * st[3] + cb * bf_hi(dc.y); \
            st[4] = ca * st[4] + cb * bf_lo(dc.z); st[5] = ca * st[5] + cb * bf_hi(dc.z); st[6] = ca * st[6] + cb * bf_lo(dc.w); st[7] = ca * st[7] + cb * bf_hi(dc.w); } while (0)
        u32x4 r0 = *SCAN_PTR(0), r1 = *SCAN_PTR(1), r2 = *SCAN_PTR(2);
        for (int p = 0; p < NCH; p += 3) { SCAN_STEP(r0, p); SCAN_STEP(r1, p + 1); SCAN_STEP(r2, p + 2); }
#undef SCAN_STEP
#undef SCAN_PTR
        if ((w0 & 2047) == 0 && tid < 128) {
            float sn = 0.f;
            for (int p = 0; p < NCH; ++p) { float* np = NS + (size_t)((bh * NCH + scan_chunk(d, p)) * 2 + d) * 128 + tid; const float dn = *np; *np = sn; sn = coef[2 * p] * sn + coef[2 * p + 1] * dn; }
        }
        __syncthreads();
    }
}

__device__ __forceinline__ void ph_mlstm_c(const Args& a, int L, LAS unsigned char* lds, int vcu, int G, int tid, int wave, int lane) {
    unsigned char* ws = a.ws;
    const bf16* U = (const bf16*)(ws + WS_U); const float* gates = (const float*)(ws + WS_GATES);
    const bf16* CS = (const bf16*)(ws + WS_CS); const float* NS = (const float*)(ws + WS_NS); const float* SCAL = (const float*)(ws + WS_SCAL);
    bf16* H = (bf16*)(ws + WS_H); const float* ghead = a.in[IN_GHEAD] + L * NH * DH;
    LAS unsigned char* imgQ = lds; LAS unsigned char* imgK = lds + 32768; LAS unsigned char* imgV = lds + 65536; LAS unsigned char* imgC = lds + 98304;
    LAS float* T_GAM = (LAS float*)(lds + TAB_OFF); LAS float* T_M = T_GAM + 256; LAS float* T_WI = T_M + 256; LAS float* T_FL = T_WI + 256; LAS float* T_NP = T_FL + 256; LAS float* T_QN = T_NP + 256;
    LAS float* T_RS = T_QN + 256;
    LAS float* T_SS = T_RS + 512;
    const int wr4 = wave >> 1, wc2 = wave & 1, fr = lane & 15, fq = lane >> 4;
    const int c_lo = (L == DEPTH - 1) ? NCH_C : 0, nc = NCH - c_lo;
    for (int u = vcu; u < NB * NH * nc; u += G) {
        const int b = u / (NH * nc), h = (u / nc) % NH, c = c_lo + u % nc, row0 = chunk_row0(b, c);
        const int si0 = state_idx(b, h, c, 0);
        u32x4 cb4[4];
        {
            u32x4 qr[4], kr[4], vr[4], cr[4];
#pragma unroll
            for (int i = 0; i < 4; ++i) { const int id = tid + 512 * i, r = id >> 4, ch = id & 15; const bf16* rp = U + (size_t)(row0 + r) * NU + 128 * h + 8 * ch;
                qr[i] = *(const u32x4*)(rp + UC_Q); kr[i] = *(const u32x4*)(rp + UC_K); vr[i] = *(const u32x4*)(rp + UC_V);
                cr[i] = *((const u32x4*)(CS + (size_t)si0 * 16384) + id); }
            if (wave < 2) { const int d = wave, t0 = 2 * lane; const float* gp = gates + (size_t)(row0 + t0) * 16 + h;
                const GateScan gs = gate_scan(d, lane, gp[(2 * d) * 4], gp[16 + (2 * d) * 4], gp[(2 * d + 1) * 4], gp[16 + (2 * d + 1) * 4]);
                const float mp = SCAL[(size_t)(si0 + d) * 4 + 2];
                const float M0 = fmaxf(mp, gs.cm0), M1 = fmaxf(mp, gs.cm1);
                T_GAM[d * 128 + t0] = gs.g0 * LOG2E; T_GAM[d * 128 + t0 + 1] = gs.g1 * LOG2E;
                T_M[d * 128 + t0] = M0 * LOG2E; T_M[d * 128 + t0 + 1] = M1 * LOG2E;
                T_WI[d * 128 + t0] = fexp(mp - M0); T_WI[d * 128 + t0 + 1] = fexp(mp - M1);
                T_FL[d * 128 + t0] = fexp(-(gs.b0 + M0)); T_FL[d * 128 + t0 + 1] = fexp(-(gs.b1 + M1)); }
            if (tid < 256) T_NP[tid] = NS[(size_t)(si0 + (tid >> 7)) * 128 + (tid & 127)];
#pragma unroll
            for (int i = 0; i < 4; ++i) { const int id = tid + 512 * i, r = id >> 4, ch = id & 15; const unsigned o = img_off((unsigned)r, (unsigned)ch);
                *(LAS u32x4*)(imgQ + o) = qr[i]; *(LAS u32x4*)(imgK + o) = kr[i]; *(LAS u32x4*)(imgV + o) = vr[i]; *(LAS u32x4*)(imgC + o) = cr[i]; }
        }
        __syncthreads();
        f32x4 S[2][4];
#pragma unroll
        for (int mi = 0; mi < 2; ++mi)
#pragma unroll
            for (int ni = 0; ni < 4; ++ni) S[mi][ni] = (f32x4){0.f, 0.f, 0.f, 0.f};
#pragma unroll 1
        for (int ks = 0; ks < 4; ++ks) { bf16x8 qf[2];
#pragma unroll
            for (int mi = 0; mi < 2; ++mi) qf[mi] = frag_row(imgQ, lane, 2 * wr4 + mi, ks);
#pragma unroll
            for (int ni = 0; ni < 4; ++ni) { const bf16x8 kf = frag_row(imgK, lane, 4 * wc2 + ni, ks);
#pragma unroll
                for (int mi = 0; mi < 2; ++mi) S[mi][ni] = __builtin_amdgcn_mfma_f32_16x16x32_bf16(kf, qf[mi], S[mi][ni], 0, 0, 0); } }
        {
            const int t = tid >> 2, part = tid & 3; float s0 = 0.f, s1 = 0.f;
#pragma unroll
            for (int cc = 0; cc < 4; ++cc) { const int ch = 4 * part + cc; const u32x4 qv = *(const LAS u32x4*)(imgQ + img_off((unsigned)t, (unsigned)ch)); const LAS float* n0 = T_NP + 8 * ch; const LAS float* n1 = T_NP + 128 + 8 * ch;
                const float qe[8] = {bf_lo(qv.x), bf_hi(qv.x), bf_lo(qv.y), bf_hi(qv.y), bf_lo(qv.z), bf_hi(qv.z), bf_lo(qv.w), bf_hi(qv.w)};
#pragma unroll
                for (int e = 0; e < 8; ++e) { s0 += qe[e] * n0[e]; s1 += qe[e] * n1[e]; } }
            s0 += __shfl_xor(s0, 1); s0 += __shfl_xor(s0, 2); s1 += __shfl_xor(s1, 1); s1 += __shfl_xor(s1, 2);
            if (part == 0) { T_QN[t] = s0; T_QN[128 + t] = s1; }
        }
        __syncthreads();
        f32x4 hs[2][4];
#pragma unroll
        for (int mi = 0; mi < 2; ++mi)
#pragma unroll
            for (int ni = 0; ni < 4; ++ni) hs[mi][ni] = (f32x4){0.f, 0.f, 0.f, 0.f};
#pragma unroll
        for (int d = 0; d < 2; ++d) {
            f32x4 acc[2][4];
#pragma unroll
            for (int mi = 0; mi < 2; ++mi)
#pragma unroll
                for (int ni = 0; ni < 4; ++ni) acc[mi][ni] = (f32x4){0.f, 0.f, 0.f, 0.f};
#pragma unroll 1
            for (int ks = 0; ks < 4; ++ks) { bf16x8 qf[2];
#pragma unroll
                for (int mi = 0; mi < 2; ++mi) qf[mi] = frag_row(imgQ, lane, 2 * wr4 + mi, ks);
#pragma unroll
                for (int ni = 0; ni < 4; ++ni) { const bf16x8 cf = frag_row(imgC, lane, 4 * wc2 + ni, ks);
#pragma unroll
                    for (int mi = 0; mi < 2; ++mi) acc[mi][ni] = __builtin_amdgcn_mfma_f32_16x16x32_bf16(cf, qf[mi], acc[mi][ni], 0, 0, 0); } }
#pragma unroll
            for (int mi = 0; mi < 2; ++mi) { const int t = 32 * wr4 + 16 * mi + fr; const float Mt = T_M[d * 128 + t], wi = T_WI[d * 128 + t]; float rs = 0.f;
#pragma unroll
                for (int ni = 0; ni < 4; ++ni) { const int s0 = 64 * wc2 + 16 * ni + 4 * fq; const f32x4 gm = *(const LAS f32x4*)(T_GAM + d * 128 + s0); float sp[4];
#pragma unroll
                    for (int j = 0; j < 4; ++j) { const int s = s0 + j; const bool ok = d == 0 ? (s <= t) : (s >= t); const float w = ok ? fexp2(gm[j] - Mt) : 0.f; sp[j] = S[mi][ni][j] * w; rs += sp[j]; }
                    u32x2 w2; w2.x = cvt_pk_bf16(sp[0], sp[1]); w2.y = cvt_pk_bf16(sp[2], sp[3]);
                    *(LAS u32x2*)(imgK + img_off((unsigned)t, (unsigned)(s0 >> 3)) + 2 * (s0 & 7)) = w2;
                    acc[mi][ni] = acc[mi][ni] * wi; }
                rs += __shfl_xor(rs, 16); rs += __shfl_xor(rs, 32);
                if (fq == 0) T_RS[(d * 128 + t) * 2 + wc2] = rs; }
            __syncthreads();
#pragma unroll 1
            for (int ks = 0; ks < 4; ++ks) { bf16x8 sf[2];
#pragma unroll
                for (int mi = 0; mi < 2; ++mi) sf[mi] = frag_row(imgK, lane, 2 * wr4 + mi, ks);
#pragma unroll
                for (int ni = 0; ni < 4; ++ni) { const bf16x8 vf = frag_tr(imgV, lane, 4 * wc2 + ni, ks);
#pragma unroll
                    for (int mi = 0; mi < 2; ++mi) acc[mi][ni] = __builtin_amdgcn_mfma_f32_16x16x32_bf16(vf, sf[mi], acc[mi][ni], 0, 0, 0); } }
#pragma unroll
            for (int mi = 0; mi < 2; ++mi) { const int t = 32 * wr4 + 16 * mi + fr;
                const float den = T_WI[d * 128 + t] * T_QN[d * 128 + t] + T_RS[(d * 128 + t) * 2] + T_RS[(d * 128 + t) * 2 + 1];
                const float rinv = 1.0f / fmaxf(fabsf(den), T_FL[d * 128 + t]);
#pragma unroll
                for (int ni = 0; ni < 4; ++ni) hs[mi][ni] = hs[mi][ni] + acc[mi][ni] * rinv; }
            if (d == 0) { __syncthreads();
#pragma unroll
                for (int i = 0; i < 4; ++i) { const int id = tid + 512 * i; cb4[i] = *((const u32x4*)(CS + (size_t)(si0 + 1) * 16384) + id); }
#pragma unroll
                for (int i = 0; i < 4; ++i) { const int id = tid + 512 * i; *(LAS u32x4*)(imgC + img_off((unsigned)(id >> 4), (unsigned)(id & 15))) = cb4[i]; }
                __syncthreads(); }
        }
#pragma unroll
        for (int mi = 0; mi < 2; ++mi) { const int t = 32 * wr4 + 16 * mi + fr; float ss = 0.f;
#pragma unroll
            for (int ni = 0; ni < 4; ++ni) { const f32x4 v = hs[mi][ni]; ss += (v[0] * v[0] + v[1] * v[1]) + (v[2] * v[2] + v[3] * v[3]); }
            ss += __shfl_xor(ss, 16); ss += __shfl_xor(ss, 32);
            if (fq == 0) T_SS[t * 2 + wc2] = ss; }
        __syncthreads();
#pragma unroll
        for (int mi = 0; mi < 2; ++mi) { const int t = 32 * wr4 + 16 * mi + fr; const float rstd = __builtin_amdgcn_rsqf((T_SS[t * 2] + T_SS[t * 2 + 1]) * (1.0f / DH) + EPS);
#pragma unroll
            for (int ni = 0; ni < 4; ++ni) { const int vd0 = 64 * wc2 + 16 * ni + 4 * fq; const u32x2 ow = *(const u32x2*)(U + (size_t)(row0 + t) * NU + UC_O + 128 * h + vd0);
                const f32x4 gh = *(const f32x4*)(ghead + h * DH + vd0); const f32x4 v = hs[mi][ni];
                const float o0 = bf_lo(ow.x), o1 = bf_hi(ow.x), o2 = bf_lo(ow.y), o3 = bf_hi(ow.y);
                const float y0 = v[0] * rstd * gh[0] / (1.0f + fexp(-o0)), y1 = v[1] * rstd * gh[1] / (1.0f + fexp(-o1)), y2 = v[2] * rstd * gh[2] / (1.0f + fexp(-o2)), y3 = v[3] * rstd * gh[3] / (1.0f + fexp(-o3));
                u32x2 w; w.x = cvt_pk_bf16(y0, y1); w.y = cvt_pk_bf16(y2, y3);
                *(u32x2*)(H + (size_t)(row0 + t) * D + 512 + 128 * h + vd0) = w; } }
        __syncthreads();
    }
}

__device__ __forceinline__ void ph_conv(const Args& a, int L, int vcu, int G, int wave, int lane) {
    unsigned char* ws = a.ws; const bf16* U = (const bf16*)(ws + WS_U); bf16* H = (bf16*)(ws + WS_H);
    const float* cw = a.in[IN_CONVW] + L * 3 * 512 + 8 * lane; const float* cbp = a.in[IN_CONVB] + L * 512 + 8 * lane;
    float w0[8], w1[8], w2[8], bb[8];
#pragma unroll
    for (int e = 0; e < 8; ++e) { w0[e] = cw[e]; w1[e] = cw[512 + e]; w2[e] = cw[1024 + e]; bb[e] = cbp[e]; }
    const int nrows = (L == DEPTH - 1) ? NLAT : NTOK;
    for (int row = vcu * 8 + wave; row < nrows; row += G * 8) {
        bool lv, rv; if (row < NLAT) { const int t = row & 63; lv = t != 0; rv = t != 63; } else { const int t = (row - NLAT) & 255; lv = t != 0; rv = t != 255; }
        const bf16* rp = U + (size_t)row * NU + 8 * lane;
        const u32x4 zb = {0u, 0u, 0u, 0u};
        const u32x4 bv = *(const u32x4*)(rp + UC_B), c0 = *(const u32x4*)(rp + UC_C), x0 = *(const u32x4*)(rp + UC_X);
        const u32x4 cl = lv ? *(const u32x4*)(rp - NU + UC_C) : zb, xl = lv ? *(const u32x4*)(rp - NU + UC_X) : zb;
        const u32x4 cr = rv ? *(const u32x4*)(rp + NU + UC_C) : zb, xr = rv ? *(const u32x4*)(rp + NU + UC_X) : zb;
        float y[8];
#pragma unroll
        for (int q = 0; q < 4; ++q) {
            const float m0 = bf_lo(c0[q]) * bf_lo(x0[q]), m1 = bf_hi(c0[q]) * bf_hi(x0[q]);
            const float l0 = bf_lo(cl[q]) * bf_lo(xl[q]), l1 = bf_hi(cl[q]) * bf_hi(xl[q]);
            const float r0 = bf_lo(cr[q]) * bf_lo(xr[q]), r1 = bf_hi(cr[q]) * bf_hi(xr[q]);
            y[2 * q] = bf_lo(bv[q]) * (w0[2 * q] * l0 + w1[2 * q] * m0 + w2[2 * q] * r0 + bb[2 * q]);
            y[2 * q + 1] = bf_hi(bv[q]) * (w0[2 * q + 1] * l1 + w1[2 * q + 1] * m1 + w2[2 * q + 1] * r1 + bb[2 * q + 1]); }
        u32x4 o; o.x = cvt_pk_bf16(y[0], y[1]); o.y = cvt_pk_bf16(y[2], y[3]); o.z = cvt_pk_bf16(y[4], y[5]); o.w = cvt_pk_bf16(y[6], y[7]);
        *(u32x4*)(H + (size_t)row * D + 8 * lane) = o;
    }
}

__device__ __forceinline__ int block_sum(int v, LAS int* sh, int& par, int wave, int lane) {
    if (lane == 0) sh[par * 8 + wave] = v;
    __syncthreads();
    int s = 0;
#pragma unroll
    for (int w = 0; w < 8; ++w) s += sh[par * 8 + w];
    par ^= 1;
    return s;
}
__device__ __forceinline__ int block_excl_scan(int v, int& total, LAS int* sh, int& par, int wave, int lane) {
    int inc = v;
#pragma unroll
    for (int s = 1; s < 64; s <<= 1) { const int t = __shfl_up(inc, s); if (lane >= s) inc += t; }
    if (lane == 63) sh[par * 8 + wave] = inc;
    __syncthreads();
    int pre = 0, tot = 0;
#pragma unroll
    for (int w = 0; w < 8; ++w) { const int x = sh[par * 8 + w]; tot += x; if (w < wave) pre += x; }
    par ^= 1; total = tot;
    return pre + inc - v;
}
__device__ __forceinline__ void ph_topk(const Args& a, int L, LAS unsigned char* lds, int vcu, int G, int tid, int wave, int lane) {
    unsigned char* ws = a.ws; const float* afft = (const float*)(ws + WS_AFFT);
    int* idx = (int*)(ws + WS_IDX); float* gsel = (float*)(ws + WS_GSEL); int* inv = (int*)(ws + WS_INV);
    LAS int* sh = (LAS int*)lds; int par = 0;
    const int nitems = (L == 0) ? 256 : 128;
    for (int item = vcu; item < nitems; item += G) {
        const bool lat = item < 128; const int b = (item & 127) >> 4, e = item & 15;
        const int n = lat ? SEQ : CTXL, k = lat ? CAP_L : CAP_C, tok0 = lat ? b * SEQ : NLAT + b * CTXL;
        const int slot0 = lat ? (e * NB + b) * CAP_L : NSLOT_L + (e * NB + b) * CAP_C;
        const float* av = afft + (size_t)e * NTOK + tok0;
        unsigned v[16];
        if (tid * 16 < n) {
#pragma unroll
            for (int q = 0; q < 4; ++q) { const f32x4 x = *(const f32x4*)(av + tid * 16 + 4 * q); v[4 * q] = __float_as_uint(x.x); v[4 * q + 1] = __float_as_uint(x.y); v[4 * q + 2] = __float_as_uint(x.z); v[4 * q + 3] = __float_as_uint(x.w); }
        } else {
#pragma unroll
            for (int j = 0; j < 16; ++j) v[j] = 0u;
        }
        unsigned T = 0u;
        for (int bit = 30; bit >= 0; --bit) { const unsigned cand = T | (1u << bit); int cnt = 0;
#pragma unroll
            for (int j = 0; j < 16; ++j) cnt += (int)__popcll(__ballot(v[j] >= cand));
            if (block_sum(cnt, sh, par, wave, lane) >= k) T = cand; }
        int gtc = 0, eqc = 0;
#pragma unroll
        for (int j = 0; j < 16; ++j) { gtc += (v[j] > T) ? 1 : 0; eqc += (v[j] == T) ? 1 : 0; }
        int tot_gt, tot_eq;
        (void)block_excl_scan(gtc, tot_gt, sh, par, wave, lane);
        int eq_before = block_excl_scan(eqc, tot_eq, sh, par, wave, lane);
        const int need_eq = k - tot_gt;
        unsigned selmask = 0u; int nsel = 0;
#pragma unroll
        for (int j = 0; j < 16; ++j) { bool s = v[j] > T; if (v[j] == T) { s = eq_before < need_eq; ++eq_before; } if (s) { selmask |= 1u << j; ++nsel; } }
        int tot_sel; int pos = block_excl_scan(nsel, tot_sel, sh, par, wave, lane);
        if (tid * 16 < n) {
#pragma unroll
            for (int j = 0; j < 16; ++j) { const int tok = tok0 + tid * 16 + j;
                if (selmask & (1u << j)) { const int slot = slot0 + pos; ++pos; idx[slot] = tok; gsel[slot] = __uint_as_float(v[j]); inv[(size_t)tok * 16 + e] = slot; }
                else inv[(size_t)tok * 16 + e] = -1; }
        }
    }
}
__device__ __forceinline__ void ph_gather(const Args& a, int L, int vcu, int G, int wave, int lane) {
    unsigned char* ws = a.ws; const bf16* H = (const bf16*)(ws + WS_H); bf16* XE = (bf16*)(ws + WS_XE); const int* idx = (const int*)(ws + WS_IDX);
    const int nslot = (L == 0) ? NSLOT : NSLOT_L;
    for (int s = vcu * 8 + wave; s < nslot; s += G * 8) { const int row = idx[s];
        const u32x4 v0 = *((const u32x4*)(H + (size_t)row * D) + lane), v1 = *((const u32x4*)(H + (size_t)row * D) + 64 + lane);
        *((u32x4*)(XE + (size_t)s * D) + lane) = v0; *((u32x4*)(XE + (size_t)s * D) + 64 + lane) = v1; }
}

constexpr int PH_PER_LAYER = 12, N_PHASES = 1 + DEPTH * PH_PER_LAYER;
__global__ void __launch_bounds__(512, 2) mk_fwd(Args args) {
    extern __shared__ __attribute__((aligned(16))) unsigned char lds_raw[];
    LAS unsigned char* lds = (LAS unsigned char*)lds_raw;
    const int tid0 = threadIdx.x;
    const int G = gridDim.x; const int bx = blockIdx.x; const int vcu = (G % 8 == 0) ? (bx % 8) * (G / 8) + bx / 8 : bx;
    volatile LAS unsigned* MISC = (volatile LAS unsigned*)(lds + MISC_OFF);
    if (tid0 < 64) MISC[tid0] = 0u;
    __syncthreads();
    XcdBarrier bar = xcd_barrier_post((unsigned*)(args.ws + WS_CTL) + 4096, MISC + 8);
    const int lo = args.ph_lo, hi = args.ph_hi;
#define CAS __attribute__((address_space(4)))
#define OPQ() const CAS Args* ap_ = (const CAS Args*)__builtin_amdgcn_kernarg_segment_ptr(); asm volatile("" : "+s"(ap_)); Args A; \
    _Pragma("unroll") for (int i_ = 0; i_ < 19; ++i_) A.in[i_] = (const float*)(const GAS float*)(ap_->in[i_]); \
    A.out = (float*)(GAS float*)(ap_->out); A.ws = (unsigned char*)(GAS unsigned char*)(ap_->ws); A.ph_lo = 0; A.ph_hi = 0; unsigned char* ws = A.ws; (void)ws; \
    int tid = tid0; asm volatile("" : "+v"(tid)); const int lane = tid & 63, wave = __builtin_amdgcn_readfirstlane(tid >> 6); (void)lane; (void)wave
#ifndef MK_PHMASK
#define MK_PHMASK 0x1fff
#endif
#define EN(p) (((MK_PHMASK) >> (p)) & 1)
#define IN(k) (lo <= (k) && (k) < hi)
#define SEAM(k) do { if (IN(k) && IN((k) + 1)) xcd_barrier(bar); } while (0)
    if (EN(12) && IN(0)) { OPQ(); ph_prologue(A, lds, vcu, G, tid, wave, lane); }
    SEAM(0);
    for (int L = 0; L < DEPTH; ++L) {
        const int pb = 1 + L * PH_PER_LAYER;
        if (EN(0) && IN(pb + 0)) { OPQ(); ph_convert(A, L, lds, vcu, G, wave, lane); __syncthreads(); if (L == 0) ph_prepass1_l0(A, lds, vcu, G, tid, wave, lane); }
        SEAM(pb + 0);
        if (EN(1) && IN(pb + 1)) { OPQ(); pg8::Gemm g{(const bf16*)(ws + WS_H), (const bf16*)(ws + WS_WIN), 1024}; pg8::Sched S; S.init(NTOK / 256, NU / 256, G, bx, 0);
            pg8::EpiU E{(bf16*)(ws + WS_U), NU}; pg8::gemm_phase<pg8::EpiU>(lds, g, S, E, tid); }
        SEAM(pb + 1);
        if (EN(2) && IN(pb + 2)) { OPQ(); ph_mlstm_a(A, lds, vcu, G, tid, wave, lane); }
        SEAM(pb + 2);
        if (EN(3) && IN(pb + 3)) { OPQ(); ph_scan(A, lds, vcu, G, tid); }
        SEAM(pb + 3);
        if (EN(4) && IN(pb + 4)) { OPQ(); ph_mlstm_c(A, L, lds, vcu, G, tid, wave, lane); ph_conv(A, L, vcu, G, wave, lane); }
        SEAM(pb + 4);
        if (EN(5) && IN(pb + 5)) { OPQ(); pg8::Gemm g{(const bf16*)(ws + WS_H), (const bf16*)(ws + WS_WOUT), 1024}; pg8::Sched S; S.init((L == DEPTH - 1 ? NLAT : NTOK) / 256, 4, G, bx, 0);
            pg8::EpiRes E{L == 0 ? A.in[IN_X] : A.out, L == 0 ? A.in[IN_CTX] : (const float*)(ws + WS_XC), A.out, (float*)(ws + WS_XC), (const float*)(ws + WS_MODV) + (size_t)L * 9 * 6144};
            pg8::gemm_phase<pg8::EpiRes>(lds, g, S, E, tid); }
        SEAM(pb + 5);
        if (EN(6) && IN(pb + 6)) { OPQ(); ph_prepass2(A, L, lds, vcu, G, tid, wave, lane); }
        SEAM(pb + 6);
        if (EN(7) && IN(pb + 7)) { OPQ(); ph_topk(A, L, lds, vcu, G, tid, wave, lane); }
        SEAM(pb + 7);
        if (EN(8) && IN(pb + 8)) { OPQ(); ph_gather(A, L, vcu, G, wave, lane); }
        SEAM(pb + 8);
        if (EN(9) && IN(pb + 9)) { OPQ(); pg8::Gemm g{(const bf16*)(ws + WS_XE), (const bf16*)(ws + WS_WGU), 1024}; pg8::Sched S; S.init((L == 0 ? NSLOT : NSLOT_L) / 256, 11, G, bx, 1);
            pg8::EpiGU E{(bf16*)(ws + WS_HM)}; pg8::gemm_phase<pg8::EpiGU>(lds, g, S, E, tid); }
        SEAM(pb + 9);
        if (EN(10) && IN(pb + 10)) { OPQ(); pg8::Gemm g{(const bf16*)(ws + WS_HM), (const bf16*)(ws + WS_WD), DE}; pg8::Sched S; S.init((L == 0 ? NSLOT : NSLOT_L) / 256, 4, G, bx, 1);
            pg8::EpiD E{(bf16*)(ws + WS_XE), (const float*)(ws + WS_GSEL)}; pg8::gemm_phase<pg8::EpiD>(lds, g, S, E, tid); }
        SEAM(pb + 10);
        if (EN(11) && IN(pb + 11)) { OPQ(); ph_combine(A, L, lds, vcu, G, tid, wave, lane); }
        SEAM(pb + 11);
    }
#undef IN
#undef SEAM
}

extern "C" void kernel_launch(void* const* d_in, const int* in_sizes, int n_in, void* d_out, int out_size, void* d_ws, size_t ws_size, hipStream_t stream) {
    static int grid = 0;
    if (grid == 0) {
        if (n_in != 19 || out_size != NLAT * D || ws_size < WS_END) { fprintf(stderr, "kernel_launch: unexpected problem (n_in %d, out %d, ws %zu < %zu)\n", n_in, out_size, ws_size, (size_t)WS_END); grid = -1; return; }
        int dev = 0, cus = 0, per_cu = 0;
        if (hipGetDevice(&dev) != hipSuccess || hipDeviceGetAttribute(&cus, hipDeviceAttributeMultiprocessorCount, dev) != hipSuccess) { grid = -1; return; }
        if (hipFuncSetAttribute((const void*)mk_fwd, hipFuncAttributeMaxDynamicSharedMemorySize, LDS_BYTES) != hipSuccess) { fprintf(stderr, "kernel_launch: hipFuncSetAttribute failed\n"); grid = -1; return; }
        if (hipOccupancyMaxActiveBlocksPerMultiprocessor(&per_cu, (const void*)mk_fwd, 512, LDS_BYTES) != hipSuccess || per_cu < 1) fprintf(stderr, "kernel_launch: occupancy query says %d\n", per_cu);
        (void)hipGetLastError();
        grid = cus;
    }
    if (grid < 0) return;
    (void)hipMemsetAsync((char*)d_ws + WS_CTL, 0, CTL_ZERO_BYTES, stream);
    Args a{};
    for (int i = 0; i < 19; ++i) a.in[i] = (const float*)d_in[i];
    a.out = (float*)d_out; a.ws = (unsigned char*)d_ws;
#if MK_ONE_LAUNCH
    a.ph_lo = 0; a.ph_hi = N_PHASES;
    hipLaunchKernelGGL(mk_fwd, dim3(grid), dim3(512), LDS_BYTES, stream, a);
#else
    for (int p = 0; p < N_PHASES; ++p) { a.ph_lo = p; a.ph_hi = p + 1; hipLaunchKernelGGL(mk_fwd, dim3(grid), dim3(512), LDS_BYTES, stream, a); }
#endif
}
```

```cpp
#include <hip/hip_runtime.h>
#include <cstdio>
#include <cstdint>

#ifndef MK_ONE_LAUNCH
#define MK_ONE_LAUNCH 1
#endif

#define GAS __attribute__((address_space(1)))
#define LAS __attribute__((address_space(3)))
typedef unsigned short bf16;
typedef short bf16x8 __attribute__((ext_vector_type(8)));
typedef short s16x4 __attribute__((ext_vector_type(4)));
typedef float f32x4 __attribute__((ext_vector_type(4)));
typedef float f32x2 __attribute__((ext_vector_type(2)));
typedef unsigned u32x4 __attribute__((ext_vector_type(4)));
typedef unsigned u32x2 __attribute__((ext_vector_type(2)));

constexpr int D = 1024, NB = 8, SEQ = 8192, CTXL = 256, DEPTH = 2;
constexpr int NLAT = NB * SEQ, NCTX = NB * CTXL, NTOK = NLAT + NCTX;
constexpr int DPROJ = 3600, NU = 3584;
constexpr int NH = 4, DH = 128, NCH_C = 2, NCH_L = 64, NCH = 66;
constexpr int NE = 16, DE = 1408, CAP_L = 1024, CAP_C = 32;
constexpr int NSLOT_L = NB * NE * CAP_L, NSLOT = NSLOT_L + NB * NE * CAP_C;
constexpr int NMOD = 6;
constexpr float EPS = 1e-6f;
constexpr float LOG2E = 1.4426950408889634f;
constexpr int UC_B = 0, UC_C = 512, UC_X = 1024, UC_Q = 1536, UC_K = 2048, UC_V = 2560, UC_O = 3072;

constexpr size_t MiB = 1u << 20;
constexpr size_t WS_CTL = 0, CTL_ZERO_BYTES = 1 * MiB;
constexpr size_t WS_MODV = 1 * MiB;
constexpr size_t WS_WG = 1 * MiB + 512 * 1024;
constexpr size_t WS_WR = WS_WG + 64 * 1024;
constexpr size_t WS_GATES = 2 * MiB;
constexpr size_t WS_AFFT = 7 * MiB;
constexpr size_t WS_INV = 12 * MiB;
constexpr size_t WS_IDX = 17 * MiB;
constexpr size_t WS_GSEL = 18 * MiB;
constexpr size_t WS_SCAL = 19 * MiB;
constexpr size_t WS_NS = 20 * MiB;
constexpr size_t WS_XC = 24 * MiB;
constexpr size_t WS_WIN = 32 * MiB;
constexpr size_t WS_WOUT = 39 * MiB;
constexpr size_t WS_WGU = 41 * MiB;
constexpr size_t WS_WD = 129 * MiB;
constexpr size_t WS_H = 173 * MiB;
constexpr size_t WS_R = 305 * MiB;
constexpr size_t WS_U = WS_R;
constexpr size_t WS_CS = WS_R + 462 * MiB;
constexpr size_t WS_XE = WS_R;
constexpr size_t WS_HM = WS_R + 264 * MiB;
constexpr size_t WS_END = WS_R + 627 * MiB;
static_assert((size_t)NTOK * NU * 2 == 462 * MiB && (size_t)NSLOT * 1024 * 2 == 264 * MiB && (size_t)NSLOT * DE * 2 == 363 * MiB, "sizes");
static_assert(WS_CS + (size_t)NB * NH * NCH * 2 * 32768 <= WS_END, "CS");

constexpr int RING_BYTES = 131072, TAB_OFF = 131072, TAB_BYTES = 16384, MISC_OFF = TAB_OFF + TAB_BYTES, LDS_BYTES = MISC_OFF + 256;

__device__ __forceinline__ unsigned cvt_pk_bf16(float lo, float hi) { unsigned r; asm volatile("v_cvt_pk_bf16_f32 %0, %1, %2" : "=v"(r) : "v"(lo), "v"(hi)); return r; }
__device__ __forceinline__ float bf_lo(unsigned w) { return __uint_as_float(w << 16); }
__device__ __forceinline__ float bf_hi(unsigned w) { return __uint_as_float(w & 0xffff0000u); }
__device__ __forceinline__ float wave_sum(float v) {
#pragma unroll
    for (int o = 1; o < 64; o <<= 1) v += __shfl_xor(v, o);
    return v;
}
__device__ __forceinline__ float fexp2(float x) { return __builtin_amdgcn_exp2f(x); }
__device__ __forceinline__ float fexp(float x) { return __builtin_amdgcn_exp2f(x * LOG2E); }
#define LDS_WAIT() asm volatile("s_waitcnt lgkmcnt(0)" ::: "memory")
#define VM_WAIT() asm volatile("s_waitcnt vmcnt(0)" ::: "memory")

namespace pg8 {
constexpr int BM = 256, BK = 64, HALF = 128, HTB = HALF * BK * 2, STAGE_BYTES = 8 * HTB, NXCD = 8, WGM = 8;
__host__ __device__ __forceinline__ int lds_byte(int r, int c) { const int st = (r >> 4) * 2 + (c >> 5), rr = r & 15, cc = c & 31, ob = rr * 64 + cc * 2; return st * 1024 + (ob ^ (((ob >> 9) & 1) << 5)); }
__host__ __device__ __forceinline__ void stage_rc(int b, int& R, int& C) { const int st = b / 1024, sb = b % 1024, swz = sb ^ (((sb >> 9) & 1) << 5); R = (st >> 1) * 16 + swz / 64; C = (st & 1) * 32 + (swz % 64) / 2; }
__host__ __device__ __forceinline__ int perm32(int rho) { const int n = rho >> 4, i = rho & 15; return 8 * (i >> 2) + 4 * n + (i & 3); }

struct Unit { int pm, pn, bt; };
struct Gemm { const bf16* A; const bf16* Bt; int K; };

struct Sched {
    int nM, nN, nwg, G, c, moe;
    __device__ __forceinline__ void init(int nM_, int nN_, int G_, int c_, int moe_) { nM = nM_; nN = nN_; nwg = nM * nN; G = G_; c = c_; moe = moe_; }
    __device__ __forceinline__ bool next(int i, Unit& u) const {
        const long L = (long)i * G + c; if (L >= nwg) return false;
        int wgid = (int)L; { const int q = nwg / NXCD, r = nwg % NXCD, xcd = wgid % NXCD, off = wgid / NXCD; wgid = (xcd < r ? xcd * (q + 1) : r * (q + 1) + (xcd - r) * q) + off; }
        const int nig = WGM * nN, gid = wgid / nig, fm = gid * WGM, gsz = (nM - fm) < WGM ? (nM - fm) : WGM;
        u.pm = fm + ((wgid % nig) % gsz); u.pn = (wgid % nig) / gsz;
        u.bt = moe ? ((u.pm < 512 ? (u.pm >> 5) : (u.pm - 512)) * nN + u.pn) : u.pn;
        return true;
    }
};

struct EpiU {
    static constexpr bool PERM = true;
    bf16* O; int ldc;
    __device__ __forceinline__ void operator()(const f32x4 (&acc)[2][2][4][2], const Unit& u, int wr, int wc, int fr, int fq) const {
        const int row0 = u.pm * BM + wr * 64 + fr, col0 = u.pn * BM + wc * 32 + 8 * fq;
#pragma unroll
        for (int ai = 0; ai < 2; ++ai)
#pragma unroll
            for (int m = 0; m < 4; ++m) { bf16* rowp = O + (size_t)(row0 + ai * HALF + m * 16) * ldc + col0;
#pragma unroll
                for (int bj = 0; bj < 2; ++bj) { const f32x4 v0 = acc[ai][bj][m][0], v1 = acc[ai][bj][m][1];
                    u32x4 w; w.x = cvt_pk_bf16(v0[0], v0[1]); w.y = cvt_pk_bf16(v0[2], v0[3]); w.z = cvt_pk_bf16(v1[0], v1[1]); w.w = cvt_pk_bf16(v1[2], v1[3]);
                    *(u32x4*)(rowp + bj * HALF) = w; } }
    }
};
struct EpiRes {
    static constexpr bool PERM = false;
    const float* base_lat; const float* base_ctx; float* out_lat; float* out_ctx; const float* modv;
    __device__ __forceinline__ void operator()(const f32x4 (&acc)[2][2][4][2], const Unit& u, int wr, int wc, int fr, int fq) const {
        const bool lat = u.pm < 256; const int g = lat ? (u.pm >> 5) : 8;
        const int rowt = (lat ? u.pm : u.pm - 256) * BM + wr * 64 + fr, col0 = u.pn * BM + wc * 32 + 4 * fq;
        const float* base = lat ? base_lat : base_ctx; float* out = lat ? out_lat : out_ctx;
        f32x4 gv[2][2];
#pragma unroll
        for (int bj = 0; bj < 2; ++bj)
#pragma unroll
            for (int n = 0; n < 2; ++n) gv[bj][n] = *(const f32x4*)(modv + g * 6144 + 2 * 1024 + col0 + bj * HALF + n * 16);
#pragma unroll
        for (int ai = 0; ai < 2; ++ai) {
            f32x4 bs[4][2][2];
#pragma unroll
            for (int m = 0; m < 4; ++m) { const size_t off = (size_t)(rowt + ai * HALF + m * 16) * D + col0;
#pragma unroll
                for (int bj = 0; bj < 2; ++bj)
#pragma unroll
                    for (int n = 0; n < 2; ++n) bs[m][bj][n] = *(const f32x4*)(base + off + bj * HALF + n * 16); }
#pragma unroll
            for (int m = 0; m < 4; ++m) { const size_t off = (size_t)(rowt + ai * HALF + m * 16) * D + col0;
#pragma unroll
                for (int bj = 0; bj < 2; ++bj)
#pragma unroll
                    for (int n = 0; n < 2; ++n) *(f32x4*)(out + off + bj * HALF + n * 16) = bs[m][bj][n] + gv[bj][n] * acc[ai][bj][m][n]; }
            asm volatile("" ::: "memory"); }
    }
};
struct EpiGU {
    static constexpr bool PERM = true;
    bf16* O;
    __device__ __forceinline__ void operator()(const f32x4 (&acc)[2][2][4][2], const Unit& u, int wr, int wc, int fr, int fq) const {
        const int row0 = u.pm * BM + wr * 64 + fr, col0 = u.pn * HALF + wc * 32 + 8 * fq;
#pragma unroll
        for (int ai = 0; ai < 2; ++ai)
#pragma unroll
            for (int m = 0; m < 4; ++m) { bf16* rowp = O + (size_t)(row0 + ai * HALF + m * 16) * DE + col0;
                float r[8];
#pragma unroll
                for (int n = 0; n < 2; ++n)
#pragma unroll
                    for (int j = 0; j < 4; ++j) { const float a = acc[ai][0][m][n][j], b = acc[ai][1][m][n][j]; r[4 * n + j] = a * __builtin_amdgcn_rcpf(1.0f + fexp2(-a * LOG2E)) * b; }
                u32x4 w; w.x = cvt_pk_bf16(r[0], r[1]); w.y = cvt_pk_bf16(r[2], r[3]); w.z = cvt_pk_bf16(r[4], r[5]); w.w = cvt_pk_bf16(r[6], r[7]);
                *(u32x4*)rowp = w; }
    }
};
struct EpiD {
    static constexpr bool PERM = true;
    bf16* O; const float* gsel;
    __device__ __forceinline__ void operator()(const f32x4 (&acc)[2][2][4][2], const Unit& u, int wr, int wc, int fr, int fq) const {
        const int row0 = u.pm * BM + wr * 64 + fr, col0 = u.pn * BM + wc * 32 + 8 * fq;
#pragma unroll
        for (int ai = 0; ai < 2; ++ai)
#pragma unroll
            for (int m = 0; m < 4; ++m) { const int row = row0 + ai * HALF + m * 16; const float gs = gsel[row]; bf16* rowp = O + (size_t)row * D + col0;
#pragma unroll
                for (int bj = 0; bj < 2; ++bj) { const f32x4 v0 = acc[ai][bj][m][0] * gs, v1 = acc[ai][bj][m][1] * gs;
                    u32x4 w; w.x = cvt_pk_bf16(v0[0], v0[1]); w.y = cvt_pk_bf16(v0[2], v0[3]); w.z = cvt_pk_bf16(v1[0], v1[1]); w.w = cvt_pk_bf16(v1[2], v1[3]);
                    *(u32x4*)(rowp + bj * HALF) = w; } }
    }
};

template <class Epi>
__device__ __forceinline__ void gemm_phase(LAS unsigned char* lds, const Gemm g, const Sched& S, const Epi& E, const int tid) {
    const int wid = __builtin_amdgcn_readfirstlane(tid >> 6), lane = tid & 63, wr = wid >> 2, wc = wid & 3, fr = lane & 15, fq = lane >> 4;
    const int K = g.K, nt = K / BK;
    unsigned voffA[2], voffB[2];
#pragma unroll
    for (int i = 0; i < 2; ++i) { int R, C; stage_rc(tid * 16 + i * 8192, R, C); const int Rb = Epi::PERM ? ((R & ~31) + perm32(R & 31)) : R;
        voffA[i] = (unsigned)(R * K + C) * 2u; voffB[i] = (unsigned)(Rb * K + C) * 2u; }
    const size_t kstep = (size_t)(BK * 2);
    const size_t hstep = (size_t)HALF * K * 2;
    const size_t tstep = 2 * hstep;
    const unsigned ldsw = (unsigned)wid * 1024u;
    const int aoff = lds_byte(wr * 64 + fr, fq * 8), boff = lds_byte(wc * 32 + fr, fq * 8);
#define PG8_SA(b, h) (((b) * 2 + (h)) * HTB)
#define PG8_SB(b, h) ((4 + (b) * 2 + (h)) * HTB)
#define PG8_STAGE(bufoff, gbase, voff) do { _Pragma("unroll") for (int _i = 0; _i < 2; ++_i) \
        __builtin_amdgcn_global_load_lds((const unsigned*)((const char*)(gbase) + (voff)[_i]), (LAS unsigned*)(lds + (bufoff) + ldsw + _i * 8192), 16, 0, 0); } while (0)
#define PG8_LDA(dst, b, h) do { _Pragma("unroll") for (int m = 0; m < 4; ++m) _Pragma("unroll") for (int k = 0; k < 2; ++k) dst[m][k] = *(const LAS bf16x8*)(lds + PG8_SA(b, h) + aoff + m * 2048 + k * 1024); } while (0)
#define PG8_LDB(dst, b, h) do { _Pragma("unroll") for (int n = 0; n < 2; ++n) _Pragma("unroll") for (int k = 0; k < 2; ++k) dst[n][k] = *(const LAS bf16x8*)(lds + PG8_SB(b, h) + boff + n * 2048 + k * 1024); } while (0)
#define PG8_MMA(ai, bj, At, Bt) do { __builtin_amdgcn_s_setprio(1); _Pragma("unroll") for (int m = 0; m < 4; ++m) _Pragma("unroll") for (int n = 0; n < 2; ++n) _Pragma("unroll") for (int k = 0; k < 2; ++k) \
        acc[ai][bj][m][n] = __builtin_amdgcn_mfma_f32_16x16x32_bf16(Bt[n][k], At[m][k], acc[ai][bj][m][n], 0, 0, 0); __builtin_amdgcn_s_setprio(0); } while (0)
#define PG8_WAIT_V(n) asm volatile("s_waitcnt vmcnt(" #n ")" ::: "memory")
#define PG8_WAIT_L(n) asm volatile("s_waitcnt lgkmcnt(" #n ")" ::: "memory")
#define PG8_BAR __builtin_amdgcn_s_barrier()
#define PG8_SCHED __builtin_amdgcn_sched_barrier(0)
    Unit cur, nxt; int ui = 0;
    if (!S.next(0, cur)) return;
    f32x4 acc[2][2][4][2];
#pragma unroll
    for (int a = 0; a < 2; ++a)
#pragma unroll
        for (int b = 0; b < 2; ++b)
#pragma unroll
            for (int m = 0; m < 4; ++m)
#pragma unroll
                for (int n = 0; n < 2; ++n) acc[a][b][m][n] = (f32x4){0.f, 0.f, 0.f, 0.f};
    bf16x8 At[4][2], B0[2][2], B1[2][2];
    const char* cA = (const char*)g.A + (size_t)cur.pm * tstep; const char* cB = (const char*)g.Bt + (size_t)cur.bt * tstep;
    PG8_STAGE(PG8_SB(0, 0), cB, voffB); PG8_STAGE(PG8_SB(0, 1), cB + hstep, voffB); PG8_STAGE(PG8_SA(0, 0), cA, voffA); PG8_STAGE(PG8_SA(0, 1), cA + hstep, voffA);
    if (wr == 1) PG8_BAR;
    PG8_WAIT_V(2); PG8_BAR;
    PG8_STAGE(PG8_SB(1, 0), cB + kstep, voffB); PG8_STAGE(PG8_SA(1, 0), cA + kstep, voffA); PG8_STAGE(PG8_SB(1, 1), cB + hstep + kstep, voffB);
    PG8_WAIT_V(6); PG8_BAR;
    for (;;) {
        const bool has_next = S.next(ui + 1, nxt);
        const char* nA = has_next ? (const char*)g.A + (size_t)nxt.pm * tstep : cA; const char* nB = has_next ? (const char*)g.Bt + (size_t)nxt.bt * tstep : cB;
        for (int t = 0; t < nt; t += 2) {
            const bool last = (t == nt - 2);
            const char* a1 = cA + (size_t)(t + 1) * kstep;
            const char* a2 = last ? nA : cA + (size_t)(t + 2) * kstep; const char* b2 = last ? nB : cB + (size_t)(t + 2) * kstep;
            const char* a3 = a2 + kstep; const char* b3 = b2 + kstep;
            PG8_LDB(B0, 0, 0); PG8_LDB(B1, 0, 1); PG8_SCHED; PG8_LDA(At, 0, 0); PG8_STAGE(PG8_SA(1, 1), a1 + hstep, voffA);
            PG8_WAIT_V(8); PG8_WAIT_L(0); PG8_BAR; PG8_MMA(0, 0, At, B0); PG8_MMA(0, 1, At, B1); PG8_BAR; PG8_SCHED;
            PG8_LDA(At, 0, 1); PG8_STAGE(PG8_SB(0, 0), b2, voffB); PG8_STAGE(PG8_SB(0, 1), b2 + hstep, voffB); PG8_STAGE(PG8_SA(0, 0), a2, voffA);
            PG8_WAIT_V(8); PG8_WAIT_L(0); PG8_BAR; PG8_MMA(1, 0, At, B0); PG8_MMA(1, 1, At, B1); PG8_BAR; PG8_SCHED;
            PG8_LDB(B0, 1, 0); PG8_LDB(B1, 1, 1); PG8_SCHED; PG8_LDA(At, 1, 0); PG8_STAGE(PG8_SA(0, 1), a2 + hstep, voffA);
            PG8_WAIT_V(8); PG8_WAIT_L(0); PG8_BAR; PG8_MMA(0, 0, At, B0); PG8_MMA(0, 1, At, B1); PG8_BAR; PG8_SCHED;
            PG8_LDA(At, 1, 1); PG8_STAGE(PG8_SB(1, 0), b3, voffB); PG8_STAGE(PG8_SB(1, 1), b3 + hstep, voffB); PG8_STAGE(PG8_SA(1, 0), a3, voffA);
            PG8_WAIT_V(8); PG8_WAIT_L(0); PG8_BAR; PG8_MMA(1, 0, At, B0); PG8_MMA(1, 1, At, B1); PG8_BAR; PG8_SCHED;
        }
        if (wr == 0) PG8_BAR;
        E(acc, cur, wr, wc, fr, fq);
        if (!has_next) break;
#pragma unroll
        for (int a = 0; a < 2; ++a)
#pragma unroll
            for (int b = 0; b < 2; ++b)
#pragma unroll
                for (int m = 0; m < 4; ++m)
#pragma unroll
                    for (int n = 0; n < 2; ++n) acc[a][b][m][n] = (f32x4){0.f, 0.f, 0.f, 0.f};
        cur = nxt; cA = nA; cB = nB; ++ui;
        if (wr == 1) PG8_BAR;
    }
    PG8_WAIT_V(0);
    PG8_BAR;
#undef PG8_SA
#undef PG8_SB
#undef PG8_STAGE
#undef PG8_LDA
#undef PG8_LDB
#undef PG8_MMA
#undef PG8_WAIT_V
#undef PG8_WAIT_L
#undef PG8_BAR
#undef PG8_SCHED
}
}

#define XB_TMO      128
#define XB_XCNT(j)  (256  + 64 * (j))
#define XB_XSUB(j)  (1280 + 64 * (j))
#define XB_XGEN(j)  (2304 + 64 * (j))
#define XB_TOP      3328
#define XB_TOPGEN   3392
#define XCD_BAR_WORDS 3456
#define XB_SPIN_CAP (1u << 18)
__device__ __forceinline__ unsigned xb_ld(unsigned* p)              { return __hip_atomic_load(p, __ATOMIC_RELAXED, __HIP_MEMORY_SCOPE_AGENT); }
__device__ __forceinline__ unsigned xb_add(unsigned* p, unsigned v) { return __hip_atomic_fetch_add(p, v, __ATOMIC_RELAXED, __HIP_MEMORY_SCOPE_AGENT); }
__device__ __forceinline__ unsigned xb_xcc_id() { return (unsigned)__builtin_amdgcn_s_getreg((3 << 11) | 20) & 0xFu; }
#define XB_SPIN(cond, bar) do { unsigned _sp = 0; while (cond) { __builtin_amdgcn_s_sleep(1); \
    if ((++_sp & 255u) == 0u) { if (xb_ld(&(bar)[XB_TMO])) break; if (_sp > XB_SPIN_CAP) { atomicAdd(&(bar)[XB_TMO], 1u); break; } } } } while (0)
struct XcdBarrier { unsigned* bar; unsigned x; volatile LAS unsigned* st; };
__device__ __forceinline__ XcdBarrier xcd_barrier_post(unsigned* bar, volatile LAS unsigned* st) {
    XcdBarrier b; b.bar = bar; b.x = xb_xcc_id(); b.st = st;
    if (threadIdx.x == 0) (void)xb_add(&bar[XB_XCNT(b.x)], 1u);
    return b;
}
__device__ __forceinline__ void xcd_barrier_complete(unsigned* bar, unsigned x, unsigned& nloc, unsigned& nx) {
    const unsigned G = gridDim.x * gridDim.y * gridDim.z;
    unsigned sum, cnt, mine, sp = 0u;
    for (;;) {
        sum = 0u; cnt = 0u; mine = 0u;
#pragma unroll
        for (unsigned j = 0; j < 16; ++j) { const unsigned c = xb_ld(&bar[XB_XCNT(j)]); sum += c; cnt += (c > 0u) ? 1u : 0u; mine = (j == x) ? c : mine; }
        if (sum == G) break;
        __builtin_amdgcn_s_sleep(1);
        if ((++sp & 255u) == 0u) { if (xb_ld(&bar[XB_TMO])) break; if (sp > XB_SPIN_CAP) { atomicAdd(&bar[XB_TMO], 1u); break; } }
    }
    nloc = mine > 0u ? mine : 1u; nx = cnt > 0u ? cnt : 1u;
}
__device__ __forceinline__ void xcd_barrier(const XcdBarrier& b) {
    asm volatile("s_waitcnt vmcnt(0)" ::: "memory");
    __syncthreads();
    if (threadIdx.x == 0) {
        unsigned* bar = b.bar;
        __builtin_amdgcn_s_waitcnt(0);
        unsigned nloc = b.st[0], nx = b.st[1];
        if (nloc == 0u) { xcd_barrier_complete(bar, b.x, nloc, nx); b.st[0] = nloc; b.st[1] = nx; }
        const unsigned old = xb_add(&bar[XB_XSUB(b.x)], 1u);
        const unsigned gen = old / nloc;
        if (old + 1u == (gen + 1u) * nloc) {
            __builtin_amdgcn_fence(__ATOMIC_RELEASE, "agent");
            asm volatile("s_waitcnt vmcnt(0)" ::: "memory");
            const unsigned og = xb_add(&bar[XB_TOP], 1u);
            const unsigned tg = og / nx;
            if (og + 1u == (tg + 1u) * nx) xb_add(&bar[XB_TOPGEN], 1u);
            else XB_SPIN(xb_ld(&bar[XB_TOPGEN]) == tg, bar);
            __builtin_amdgcn_fence(__ATOMIC_ACQUIRE, "agent");
            xb_add(&bar[XB_XGEN(b.x)], 1u);
            asm volatile("s_waitcnt vmcnt(0)" ::: "memory");
        } else {
            XB_SPIN(xb_ld(&bar[XB_XGEN(b.x)]) == gen, bar);
            __builtin_amdgcn_fence(__ATOMIC_ACQUIRE, "agent");
            asm volatile("s_waitcnt vmcnt(0)" ::: "memory");
        }
    }
    __syncthreads();
}

struct Args { const float* in[19]; float* out; unsigned char* ws; int ph_lo, ph_hi; };
enum { IN_X = 0, IN_C, IN_CTX, IN_CCTX, IN_WMOD, IN_BMOD, IN_G1, IN_G2, IN_WIN, IN_WOUT, IN_CONVW, IN_CONVB, IN_GATEB, IN_GHEAD, IN_WROUTER, IN_WGATE, IN_WUP, IN_WDOWN, IN_GFINAL };

__device__ __forceinline__ void ph_prologue(const Args& a, LAS unsigned char* lds, int vcu, int G, int tid, int wave, int lane) {
    unsigned char* ws = a.ws;
    bf16* wg = (bf16*)(ws + WS_WG); bf16* wrt = (bf16*)(ws + WS_WR);
    const float* w_in = a.in[IN_WIN]; const float* w_router = a.in[IN_WROUTER];
    for (int i = vcu * 512 + tid; i < 2 * 16 * 1024; i += G * 512) { const int L = i >> 14, j = (i >> 10) & 15, k = i & 1023;
        wg[i] = (bf16)(cvt_pk_bf16(w_in[((size_t)L * 1024 + k) * DPROJ + NU + j], 0.f) & 0xffffu);
        wrt[i] = (bf16)(cvt_pk_bf16(w_router[((size_t)L * 1024 + k) * NE + j], 0.f) & 0xffffu); }
    LAS float* sv = (LAS float*)lds;
    LAS float* red = (LAS float*)(lds + 9 * 1024 * 4);
    const float* c = a.in[IN_C]; const float* cctx = a.in[IN_CCTX];
    for (int i = tid; i < 9 * 1024; i += 512) { const int g = i >> 10, k = i & 1023; const float v = g < 8 ? c[g * 1024 + k] : cctx[k]; sv[i] = v / (1.0f + __expf(-v)); }
    __syncthreads();
    const float* w_mod = a.in[IN_WMOD]; const float* b_mod = a.in[IN_BMOD]; float* modv = (float*)(ws + WS_MODV);
    for (int item = vcu; item < 2 * 96; item += G) {
        const int L = item / 96, cb = item % 96, col = cb * 64 + lane;
        float acc[9];
#pragma unroll
        for (int g = 0; g < 9; ++g) acc[g] = 0.f;
        for (int kk = 0; kk < 128; ++kk) { const int k = wave * 128 + kk; const float wv = w_mod[((size_t)L * 1024 + k) * 6144 + col];
#pragma unroll
            for (int g = 0; g < 9; ++g) acc[g] += sv[g * 1024 + k] * wv; }
#pragma unroll
        for (int g = 0; g < 9; ++g) red[(wave * 9 + g) * 64 + lane] = acc[g];
        __syncthreads();
        for (int o = tid; o < 9 * 64; o += 512) { const int g = o >> 6, l = o & 63; float s = b_mod[L * 6144 + cb * 64 + l];
#pragma unroll
            for (int w = 0; w < 8; ++w) s += red[(w * 9 + g) * 64 + l];
            modv[(size_t)(L * 9 + g) * 6144 + cb * 64 + l] = s; }
        __syncthreads();
    }
}

__device__ __forceinline__ void transpose_item(const float* src, int ld, int k0, int n0, bf16* dst, int dstK, int row0, float scale, LAS float* scr, int lane) {
#pragma unroll 8
    for (int i = 0; i < 32; ++i) { const int kk = 2 * i + (lane >> 5); scr[kk * 33 + (lane & 31)] = src[(size_t)(k0 + kk) * ld + n0 + (lane & 31)] * scale; }
    LDS_WAIT(); asm volatile("" ::: "memory");
    const int c = lane & 7;
#pragma unroll
    for (int j = 0; j < 4; ++j) { const int n = (lane >> 3) + 8 * j; const LAS float* s = scr + (8 * c) * 33 + n;
        u32x4 o; o.x = cvt_pk_bf16(s[0 * 33], s[1 * 33]); o.y = cvt_pk_bf16(s[2 * 33], s[3 * 33]); o.z = cvt_pk_bf16(s[4 * 33], s[5 * 33]); o.w = cvt_pk_bf16(s[6 * 33], s[7 * 33]);
        *(u32x4*)(dst + (size_t)(row0 + n) * dstK + k0 + 8 * c) = o; }
    LDS_WAIT(); asm volatile("" ::: "memory");
}
__device__ __forceinline__ void ph_convert(const Args& a, int L, LAS unsigned char* lds, int vcu, int G, int wave, int lane) {
    unsigned char* ws = a.ws;
    LAS float* scr = (LAS float*)(lds + wave * 16384);
    const int gw = vcu * 8 + wave, NGW = G * 8;
    constexpr int NI_IN = 16 * 112, NI_OUT = 16 * 32, NI_E = 704, NI_GU = NE * 2 * NI_E, NI_DN = NE * NI_E, NITEMS = NI_IN + NI_OUT + NI_GU + NI_DN;
    for (int it = gw; it < NITEMS; it += NGW) {
        int r = it;
        if (r < NI_IN) { const int kb = r / 112, nb = r % 112, n0 = 32 * nb;
            transpose_item(a.in[IN_WIN] + (size_t)L * 1024 * DPROJ, DPROJ, 64 * kb, n0, (bf16*)(ws + WS_WIN), 1024, n0, (n0 >= UC_Q && n0 < UC_K) ? 0.08838834764831845f : 1.0f, scr, lane); continue; }
        r -= NI_IN;
        if (r < NI_OUT) { const int kb = r / 32, nb = r % 32;
            transpose_item(a.in[IN_WOUT] + (size_t)L * 1024 * 1024, 1024, 64 * kb, 32 * nb, (bf16*)(ws + WS_WOUT), 1024, 32 * nb, 1.0f, scr, lane); continue; }
        r -= NI_OUT;
        if (r < NI_GU) { const int e = r / (2 * NI_E), rr = r % (2 * NI_E), which = rr / NI_E, q = rr % NI_E, kb = q / 44, nb = q % 44, n0 = 32 * nb;
            const float* src = (which ? a.in[IN_WUP] : a.in[IN_WGATE]) + ((size_t)L * NE + e) * 1024 * DE;
            transpose_item(src, DE, 64 * kb, n0, (bf16*)(ws + WS_WGU) + (size_t)e * 2816 * 1024, 1024, 256 * (n0 >> 7) + 128 * which + (n0 & 127), 1.0f, scr, lane); continue; }
        r -= NI_GU;
        { const int e = r / NI_E, q = r % NI_E, kb = q / 32, nb = q % 32;
            transpose_item(a.in[IN_WDOWN] + ((size_t)L * NE + e) * DE * 1024, 1024, 64 * kb, 32 * nb, (bf16*)(ws + WS_WD) + (size_t)e * 1024 * DE, DE, 32 * nb, 1.0f, scr, lane); }
    }
}

__device__ __forceinline__ void row_load(const float* p, int lane, f32x4 (&v)[4]) {
#pragma unroll
    for (int j = 0; j < 4; ++j) v[j] = *((const f32x4*)p + lane + 64 * j);
}
__device__ __forceinline__ float row_rstd(const f32x4 (&v)[4]) {
    float s = 0.f;
#pragma unroll
    for (int j = 0; j < 4; ++j) s += (v[j].x * v[j].x + v[j].y * v[j].y) + (v[j].z * v[j].z + v[j].w * v[j].w);
    return __builtin_amdgcn_rsqf(wave_sum(s) * (1.0f / D) + EPS);
}
__device__ __forceinline__ void row_mod_store(const f32x4 (&v)[4], float rstd, const float* gn, const float* shift, const float* scale, bf16* hrow, int lane) {
#pragma unroll
    for (int j = 0; j < 4; ++j) { const int c = 4 * lane + 256 * j; const f32x4 g = *(const f32x4*)(gn + c), sh = *(const f32x4*)(shift + c), sc = *(const f32x4*)(scale + c);
        const f32x4 h = v[j] * rstd * g * (sc + 1.0f) + sh;
        u32x2 w; w.x = cvt_pk_bf16(h.x, h.y); w.y = cvt_pk_bf16(h.z, h.w); *(u32x2*)(hrow + c) = w; }
}
constexpr int WT_STRIDE = 2064;
__device__ __forceinline__ void stage_wt(const bf16* wt, LAS unsigned char* lds, int tid) {
    for (int i = tid; i < 16 * 128; i += 512) { const int r = i >> 7, ch = i & 127; *(LAS u32x4*)(lds + r * WT_STRIDE + ch * 16) = *(const u32x4*)(wt + r * 1024 + ch * 8); }
    __syncthreads();
}
template <bool TOKFIRST>
__device__ __forceinline__ f32x4 skinny16(const bf16* hrows, LAS unsigned char* wl, int lane) {
    const int r = lane & 15, g = lane >> 4;
    f32x4 acc = {0.f, 0.f, 0.f, 0.f};
    const bf16* hp = hrows + (size_t)r * 1024 + 8 * g;
    const LAS unsigned char* wp = wl + r * WT_STRIDE + 16 * g;
#pragma unroll
    for (int kb = 0; kb < 2; ++kb) {
        bf16x8 hf[16];
#pragma unroll
        for (int k = 0; k < 16; ++k) hf[k] = __builtin_nontemporal_load((const bf16x8*)(hp + 32 * (kb * 16 + k)));
#pragma unroll
        for (int k = 0; k < 16; ++k) { const bf16x8 wf = *(const LAS bf16x8*)(wp + 64 * (kb * 16 + k));
            acc = TOKFIRST ? __builtin_amdgcn_mfma_f32_16x16x32_bf16(hf[k], wf, acc, 0, 0, 0) : __builtin_amdgcn_mfma_f32_16x16x32_bf16(wf, hf[k], acc, 0, 0, 0); }
    }
    return acc;
}

__device__ __forceinline__ int row_cond(int row) { return row < NLAT ? (row >> 13) : 8; }

__device__ __forceinline__ void gates_store(const f32x4 acc, const float* gate_b_l, float* gates, int row0, int lane) {
    const int fq = lane >> 4; const f32x4 gb = *(const f32x4*)(gate_b_l + 4 * fq);
    *(f32x4*)(gates + (size_t)(row0 + (lane & 15)) * 16 + 4 * fq) = acc + gb;
}
__device__ __forceinline__ void router_store(const f32x4 acc, float* afft, int row0, int lane) {
    f32x4 mx = acc;
#pragma unroll
    for (int o = 1; o < 16; o <<= 1) { f32x4 t; t.x = __shfl_xor(mx.x, o); t.y = __shfl_xor(mx.y, o); t.z = __shfl_xor(mx.z, o); t.w = __shfl_xor(mx.w, o);
        mx.x = fmaxf(mx.x, t.x); mx.y = fmaxf(mx.y, t.y); mx.z = fmaxf(mx.z, t.z); mx.w = fmaxf(mx.w, t.w); }
    f32x4 ex; ex.x = __expf(acc.x - mx.x); ex.y = __expf(acc.y - mx.y); ex.z = __expf(acc.z - mx.z); ex.w = __expf(acc.w - mx.w);
    f32x4 sm = ex;
#pragma unroll
    for (int o = 1; o < 16; o <<= 1) { f32x4 t; t.x = __shfl_xor(sm.x, o); t.y = __shfl_xor(sm.y, o); t.z = __shfl_xor(sm.z, o); t.w = __shfl_xor(sm.w, o); sm = sm + t; }
    f32x4 o4; o4.x = ex.x / sm.x; o4.y = ex.y / sm.y; o4.z = ex.z / sm.z; o4.w = ex.w / sm.w;
    *(f32x4*)(afft + (size_t)(lane & 15) * NTOK + row0 + 4 * (lane >> 4)) = o4;
}

struct ModRegs { f32x4 gs[4], sh[4]; };
__device__ __forceinline__ ModRegs mod_load(const float* gn, const float* shift, const float* scale, int lane) {
    ModRegs m;
#pragma unroll
    for (int j = 0; j < 4; ++j) { const int c = 4 * lane + 256 * j; m.gs[j] = *(const f32x4*)(gn + c) * (*(const f32x4*)(scale + c) + 1.0f); m.sh[j] = *(const f32x4*)(shift + c); }
    return m;
}
__device__ __forceinline__ void row_mod_store2(const f32x4 (&v)[4], float rstd, const ModRegs& m, bf16* hrow, int lane) {
#pragma unroll
    for (int j = 0; j < 4; ++j) { const f32x4 h = v[j] * rstd * m.gs[j] + m.sh[j];
        u32x2 w; w.x = cvt_pk_bf16(h.x, h.y); w.y = cvt_pk_bf16(h.z, h.w); *(u32x2*)(hrow + 4 * lane + 256 * j) = w; }
}
__device__ __forceinline__ void rows16_norm(const float* src, bf16* hdst, const ModRegs& m, int lane) {
#pragma unroll 1
    for (int r = 0; r < 16; r += 4) {
        f32x4 v[4][4];
#pragma unroll
        for (int q = 0; q < 4; ++q) row_load(src + (size_t)(r + q) * D, lane, v[q]);
#pragma unroll
        for (int q = 0; q < 4; ++q) { const float rstd = row_rstd(v[q]); row_mod_store2(v[q], rstd, m, hdst + (size_t)(r + q) * D, lane); }
    }
}

__device__ __forceinline__ void ph_prepass1_l0(const Args& a, LAS unsigned char* lds, int vcu, int G, int tid, int wave, int lane) {
    unsigned char* ws = a.ws; const int L = 0;
    LAS unsigned char* wl = lds;
    stage_wt((const bf16*)(ws + WS_WG) + (size_t)L * 16 * 1024, wl, tid);
    const float* modv = (const float*)(ws + WS_MODV) + (size_t)L * 9 * 6144; const float* gn = a.in[IN_G1] + L * 1024;
    bf16* H = (bf16*)(ws + WS_H); float* gates = (float*)(ws + WS_GATES);
    for (int grp = vcu * 8 + wave; grp < NTOK / 16; grp += G * 8) {
        const int row0 = grp * 16, g = row_cond(row0);
        const float* src = row0 < NLAT ? a.in[IN_X] + (size_t)row0 * D : a.in[IN_CTX] + (size_t)(row0 - NLAT) * D;
        const ModRegs m = mod_load(gn, modv + g * 6144 + 0 * 1024, modv + g * 6144 + 1 * 1024, lane);
        rows16_norm(src, H + (size_t)row0 * D, m, lane);
        VM_WAIT();
        const f32x4 acc = skinny16<false>(H + (size_t)row0 * D, wl, lane);
        gates_store(acc, a.in[IN_GATEB] + L * 16, gates, row0, lane);
    }
}

__device__ __forceinline__ void ph_prepass2(const Args& a, int L, LAS unsigned char* lds, int vcu, int G, int tid, int wave, int lane) {
    unsigned char* ws = a.ws;
    LAS unsigned char* wl = lds;
    stage_wt((const bf16*)(ws + WS_WR) + (size_t)L * 16 * 1024, wl, tid);
    const float* modv = (const float*)(ws + WS_MODV) + (size_t)L * 9 * 6144; const float* gn = a.in[IN_G2] + L * 1024;
    bf16* H = (bf16*)(ws + WS_H); float* afft = (float*)(ws + WS_AFFT);
    const int ngrp = (L == 0 ? NTOK : NLAT) / 16;
    for (int grp = vcu * 8 + wave; grp < ngrp; grp += G * 8) {
        const int row0 = grp * 16, g = row_cond(row0);
        const float* src = row0 < NLAT ? a.out + (size_t)row0 * D : (const float*)(ws + WS_XC) + (size_t)(row0 - NLAT) * D;
        const ModRegs m = mod_load(gn, modv + g * 6144 + 3 * 1024, modv + g * 6144 + 4 * 1024, lane);
        rows16_norm(src, H + (size_t)row0 * D, m, lane);
        VM_WAIT();
        const f32x4 acc = skinny16<true>(H + (size_t)row0 * D, wl, lane);
        router_store(acc, afft, row0, lane);
    }
}

__device__ __forceinline__ void ph_combine(const Args& a, int L, LAS unsigned char* lds, int vcu, int G, int tid, int wave, int lane) {
    unsigned char* ws = a.ws; const bool last = (L == DEPTH - 1);
    LAS unsigned char* wl = lds;
    if (!last) stage_wt((const bf16*)(ws + WS_WG) + (size_t)(L + 1) * 16 * 1024, wl, tid);
    const float* modv = (const float*)(ws + WS_MODV) + (size_t)L * 9 * 6144;
    const float* modn = (const float*)(ws + WS_MODV) + (size_t)(L + 1 < DEPTH ? L + 1 : L) * 9 * 6144;
    const float* gn = last ? a.in[IN_GFINAL] : a.in[IN_G1] + (L + 1) * 1024;
    bf16* H = (bf16*)(ws + WS_H); float* gates = (float*)(ws + WS_GATES);
    const bf16* ye = (const bf16*)(ws + WS_XE); const int* inv = (const int*)(ws + WS_INV);
    const int ngrp = (last ? NLAT : NTOK) / 16;
    for (int grp = vcu * 8 + wave; grp < ngrp; grp += G * 8) {
        const int row0 = grp * 16, g = row_cond(row0);
        float* xs = row0 < NLAT ? a.out + (size_t)row0 * D : (float*)(ws + WS_XC) + (size_t)(row0 - NLAT) * D;
        const int4 iv = *(const int4*)(inv + (size_t)row0 * 16 + 4 * lane);
        ModRegs m; f32x4 g2[4];
#pragma unroll
        for (int j = 0; j < 4; ++j) g2[j] = *(const f32x4*)(modv + g * 6144 + 5 * 1024 + 4 * lane + 256 * j);
        if (last) {
#pragma unroll
            for (int j = 0; j < 4; ++j) { m.gs[j] = *(const f32x4*)(gn + 4 * lane + 256 * j); m.sh[j] = (f32x4){0.f, 0.f, 0.f, 0.f}; }
        } else m = mod_load(gn, modn + g * 6144 + 0 * 1024, modn + g * 6144 + 1 * 1024, lane);
        const unsigned long long sel = __ballot(iv.x >= 0) ;
        const unsigned long long sel1 = __ballot(iv.y >= 0), sel2 = __ballot(iv.z >= 0), sel3 = __ballot(iv.w >= 0);
#pragma unroll 1
        for (int r = 0; r < 16; r += 2) {
            f32x4 v[2][4];
#pragma unroll
            for (int q = 0; q < 2; ++q) row_load(xs + (size_t)(r + q) * D, lane, v[q]);
            unsigned em[2];
#pragma unroll
            for (int q = 0; q < 2; ++q) { const int rr = r + q; unsigned mk = 0u;
#pragma unroll
                for (int c = 0; c < 4; ++c) { const int ln = 4 * rr + c;
                    mk |= (unsigned)((sel >> ln) & 1ull) << (4 * c) | (unsigned)((sel1 >> ln) & 1ull) << (4 * c + 1) | (unsigned)((sel2 >> ln) & 1ull) << (4 * c + 2) | (unsigned)((sel3 >> ln) & 1ull) << (4 * c + 3); }
                em[q] = mk; }
            f32x4 s[2][4];
#pragma unroll
            for (int q = 0; q < 2; ++q)
#pragma unroll
                for (int j = 0; j < 4; ++j) s[q][j] = (f32x4){0.f, 0.f, 0.f, 0.f};
            while (em[0] | em[1]) {
                u32x2 w[2][4]; float wt[2];
#pragma unroll
                for (int q = 0; q < 2; ++q) { const int rr = r + q; int e = em[q] ? (int)__builtin_ctz(em[q]) : 0; wt[q] = em[q] ? 1.0f : 0.0f; em[q] &= em[q] - 1u;
                    const int ln = 4 * rr + (e >> 2), k = e & 3;
                    const int cand = k == 0 ? iv.x : (k == 1 ? iv.y : (k == 2 ? iv.z : iv.w));
                    int slot = __shfl(cand, ln); slot = slot < 0 ? 0 : slot;
                    const bf16* yr = ye + (size_t)slot * D;
#pragma unroll
                    for (int j = 0; j < 4; ++j) w[q][j] = *(const u32x2*)(yr + 4 * lane + 256 * j); }
#pragma unroll
                for (int q = 0; q < 2; ++q)
#pragma unroll
                    for (int j = 0; j < 4; ++j) { s[q][j].x += wt[q] * bf_lo(w[q][j].x); s[q][j].y += wt[q] * bf_hi(w[q][j].x); s[q][j].z += wt[q] * bf_lo(w[q][j].y); s[q][j].w += wt[q] * bf_hi(w[q][j].y); }
            }
#pragma unroll
            for (int q = 0; q < 2; ++q) {
#pragma unroll
                for (int j = 0; j < 4; ++j) v[q][j] = v[q][j] + g2[j] * s[q][j];
                const float rstd = row_rstd(v[q]); float* xr = xs + (size_t)(r + q) * D;
                if (last) {
#pragma unroll
                    for (int j = 0; j < 4; ++j) *((f32x4*)xr + lane + 64 * j) = v[q][j] * rstd * m.gs[j];
                } else {
#pragma unroll
                    for (int j = 0; j < 4; ++j) *((f32x4*)xr + lane + 64 * j) = v[q][j];
                    row_mod_store2(v[q], rstd, m, H + (size_t)(row0 + r + q) * D, lane);
                }
            }
        }
        if (!last) { VM_WAIT();
            const f32x4 acc = skinny16<false>(H + (size_t)row0 * D, wl, lane);
            gates_store(acc, a.in[IN_GATEB] + (L + 1) * 16, gates, row0, lane); }
    }
}

__device__ __forceinline__ unsigned img_off(unsigned row, unsigned ch) { return 256u * row + 16u * (ch ^ (((row & 3u) << 2) | ((row >> 2) & 3u))); }
__device__ __forceinline__ bf16x8 frag_row(const LAS unsigned char* img, int lane, int rb, int s) { return *(const LAS bf16x8*)(img + img_off((unsigned)((lane & 15) + 16 * rb), (unsigned)(4 * s + (lane >> 4)))); }
__device__ __forceinline__ bf16x8 frag_tr(const LAS unsigned char* img, int lane, int c, int ks) {
    const unsigned g = (unsigned)lane >> 4, q = ((unsigned)lane & 15u) >> 2, p = (unsigned)lane & 3u;
    const s16x4 lo = __builtin_amdgcn_ds_read_tr16_b64_v4i16((LAS s16x4*)(img + img_off(32u * ks + 8u * g + q, 2u * c + (p >> 1)) + 8u * (p & 1u)));
    const s16x4 hi = __builtin_amdgcn_ds_read_tr16_b64_v4i16((LAS s16x4*)(img + img_off(32u * ks + 8u * g + 4u + q, 2u * c + (p >> 1)) + 8u * (p & 1u)));
    return __builtin_shufflevector(lo, hi, 0, 1, 2, 3, 4, 5, 6, 7);
}
__device__ __forceinline__ int chunk_row0(int b, int c) { return c < NCH_C ? NLAT + b * CTXL + c * 128 : b * SEQ + (c - NCH_C) * 128; }
__device__ __forceinline__ int state_idx(int b, int h, int c, int d) { return ((b * NH + h) * NCH + c) * 2 + d; }

struct GateScan { float b0, b1, g0, g1, cm0, cm1, B, G; };
__device__ __forceinline__ float logsigmoid(float x) { return fminf(x, 0.f) - log1pf(__expf(-fabsf(x))); }
__device__ __forceinline__ GateScan gate_scan(int d, int lane, float i0, float i1, float f0, float f1) {
    GateScan o; const float l0 = logsigmoid(f0), l1 = logsigmoid(f1);
    float inc = l0 + l1;
    if (d == 0) {
#pragma unroll
        for (int s = 1; s < 64; s <<= 1) { const float t = __shfl_up(inc, s); if (lane >= s) inc += t; }
        o.b1 = inc; o.b0 = inc - l1; o.B = __shfl(inc, 63);
    } else {
#pragma unroll
        for (int s = 1; s < 64; s <<= 1) { const float t = __shfl_down(inc, s); if (lane + s < 64) inc += t; }
        o.b0 = inc; o.b1 = inc - l0; o.B = __shfl(inc, 0);
    }
    o.g0 = i0 - o.b0; o.g1 = i1 - o.b1;
    float pm = fmaxf(o.g0, o.g1);
    if (d == 0) {
#pragma unroll
        for (int s = 1; s < 64; s <<= 1) { const float t = __shfl_up(pm, s); if (lane >= s) pm = fmaxf(pm, t); }
        float pe = __shfl_up(pm, 1); if (lane == 0) pe = -INFINITY;
        o.cm0 = fmaxf(pe, o.g0); o.cm1 = fmaxf(o.cm0, o.g1); o.G = __shfl(pm, 63);
    } else {
#pragma unroll
        for (int s = 1; s < 64; s <<= 1) { const float t = __shfl_down(pm, s); if (lane + s < 64) pm = fmaxf(pm, t); }
        float pe = __shfl_down(pm, 1); if (lane == 63) pe = -INFINITY;
        o.cm1 = fmaxf(pe, o.g1); o.cm0 = fmaxf(o.cm1, o.g0); o.G = __shfl(pm, 0);
    }
    return o;
}
__device__ __forceinline__ u32x4 scale_bf8(u32x4 v, float w) {
    u32x4 o; o.x = cvt_pk_bf16(bf_lo(v.x) * w, bf_hi(v.x) * w); o.y = cvt_pk_bf16(bf_lo(v.y) * w, bf_hi(v.y) * w); o.z = cvt_pk_bf16(bf_lo(v.z) * w, bf_hi(v.z) * w); o.w = cvt_pk_bf16(bf_lo(v.w) * w, bf_hi(v.w) * w); return o;
}

__device__ __forceinline__ void ph_mlstm_a(const Args& a, LAS unsigned char* lds, int vcu, int G, int tid, int wave, int lane) {
    unsigned char* ws = a.ws;
    const bf16* U = (const bf16*)(ws + WS_U); const float* gates = (const float*)(ws + WS_GATES);
    bf16* CS = (bf16*)(ws + WS_CS); float* NS = (float*)(ws + WS_NS); float* SCAL = (float*)(ws + WS_SCAL);
    LAS unsigned char* imgV = lds; LAS unsigned char* imgK0 = lds + 32768; LAS unsigned char* imgK1 = lds + 65536;
    LAS float* wtab = (LAS float*)(lds + TAB_OFF);
    const int wr4 = wave >> 1, wc2 = wave & 1, fr = lane & 15, fq = lane >> 4;
    for (int u = vcu; u < NB * NH * NCH; u += G) {
        const int b = u / (NH * NCH), h = (u / NCH) % NH, c = u % NCH, row0 = chunk_row0(b, c);
        u32x4 kreg[4], vreg[4];
#pragma unroll
        for (int i = 0; i < 4; ++i) { const int id = tid + 512 * i, r = id >> 4, ch = id & 15; const bf16* rp = U + (size_t)(row0 + r) * NU + 128 * h + 8 * ch;
            kreg[i] = *(const u32x4*)(rp + UC_K); vreg[i] = *(const u32x4*)(rp + UC_V); }
        if (wave < 2) { const int d = wave, t0 = 2 * lane; const float* gp = gates + (size_t)(row0 + t0) * 16 + h;
            const GateScan gs = gate_scan(d, lane, gp[(2 * d) * 4], gp[16 + (2 * d) * 4], gp[(2 * d + 1) * 4], gp[16 + (2 * d + 1) * 4]);
            wtab[d * 128 + t0] = fexp(gs.g0 - gs.G); wtab[d * 128 + t0 + 1] = fexp(gs.g1 - gs.G);
            if (lane == 0) { float* sc = SCAL + (size_t)state_idx(b, h, c, d) * 4; sc[0] = gs.B; sc[1] = gs.B + gs.G; } }
        __syncthreads();
#pragma unroll
        for (int i = 0; i < 4; ++i) { const int id = tid + 512 * i, r = id >> 4, ch = id & 15; const unsigned o = img_off((unsigned)r, (unsigned)ch);
            *(LAS u32x4*)(imgV + o) = vreg[i]; *(LAS u32x4*)(imgK0 + o) = scale_bf8(kreg[i], wtab[r]); *(LAS u32x4*)(imgK1 + o) = scale_bf8(kreg[i], wtab[128 + r]); }
        __syncthreads();
        f32x4 acc[2][2][4];
#pragma unroll
        for (int d = 0; d < 2; ++d)
#pragma unroll
            for (int mi = 0; mi < 2; ++mi)
#pragma unroll
                for (int ni = 0; ni < 4; ++ni) acc[d][mi][ni] = (f32x4){0.f, 0.f, 0.f, 0.f};
#pragma unroll 1
        for (int ks = 0; ks < 4; ++ks) {
            bf16x8 vf[2];
#pragma unroll
            for (int mi = 0; mi < 2; ++mi) vf[mi] = frag_tr(imgV, lane, 2 * wr4 + mi, ks);
#pragma unroll
            for (int d = 0; d < 2; ++d)
#pragma unroll
                for (int ni = 0; ni < 4; ++ni) { const bf16x8 kf = frag_tr(d ? imgK1 : imgK0, lane, 4 * wc2 + ni, ks);
#pragma unroll
                    for (int mi = 0; mi < 2; ++mi) acc[d][mi][ni] = __builtin_amdgcn_mfma_f32_16x16x32_bf16(kf, vf[mi], acc[d][mi][ni], 0, 0, 0); }
        }
        {
            const int d = tid >> 8, kd = (tid & 255) >> 1, half = tid & 1; const LAS unsigned char* im = d ? imgK1 : imgK0; float s = 0.f;
            for (int t = 0; t < 64; ++t) { const int sr = 64 * half + t; s += __uint_as_float((unsigned)(*(const LAS unsigned short*)(im + img_off((unsigned)sr, (unsigned)(kd >> 3)) + 2 * (kd & 7))) << 16); }
            s += __shfl_xor(s, 1);
            if (half == 0) NS[(size_t)state_idx(b, h, c, d) * 128 + kd] = s;
        }
#pragma unroll
        for (int d = 0; d < 2; ++d) { bf16* cs = CS + (size_t)state_idx(b, h, c, d) * 16384;
#pragma unroll
            for (int mi = 0; mi < 2; ++mi)
#pragma unroll
                for (int ni = 0; ni < 4; ++ni) { const int vd = 32 * wr4 + 16 * mi + fr, kd0 = 64 * wc2 + 16 * ni + 4 * fq; const f32x4 v = acc[d][mi][ni];
                    u32x2 w; w.x = cvt_pk_bf16(v[0], v[1]); w.y = cvt_pk_bf16(v[2], v[3]); *(u32x2*)(cs + vd * 128 + kd0) = w; } }
        __syncthreads();
    }
}

__device__ __forceinline__ int scan_chunk(int d, int p) { return d == 0 ? p : (p < NCH_C ? NCH_C - 1 - p : NCH + NCH_C - 1 - p); }
__device__ __forceinline__ void ph_scan(const Args& a, LAS unsigned char* lds, int vcu, int G, int tid) {
    unsigned char* ws = a.ws;
    bf16* CS = (bf16*)(ws + WS_CS); float* NS = (float*)(ws + WS_NS); float* SCAL = (float*)(ws + WS_SCAL);
    LAS float* coef = (LAS float*)lds;
    const int lane = tid & 63;
    for (int w0 = vcu * 512; w0 < NB * NH * 2 * 2048; w0 += G * 512) {
        const int seq = w0 >> 11, d = seq & 1, bh = seq >> 1, chunk = (w0 & 2047) + tid;
        if (tid < 64) {
            const int p1 = lane + 64; const bool has1 = p1 < NCH;
            float* sc0 = SCAL + (size_t)((bh * NCH + scan_chunk(d, lane)) * 2 + d) * 4;
            float* sc1 = SCAL + (size_t)((bh * NCH + scan_chunk(d, has1 ? p1 : 0)) * 2 + d) * 4;
            const float B0 = sc0[0], ml0 = sc0[1], B1 = sc1[0], ml1 = sc1[1];
            float m = 0.f, ca0 = 0.f, cb0 = 0.f, mp0 = 0.f, ca1 = 0.f, cb1 = 0.f, mp1 = 0.f;
            for (int p = 0; p < NCH; ++p) { const float B = p < 64 ? __shfl(B0, p) : __shfl(B1, p - 64), ml = p < 64 ? __shfl(ml0, p) : __shfl(ml1, p - 64);
                const float mn = fmaxf(B + m, ml), ca = fexp(B + m - mn), cb = fexp(ml - mn);
                if (lane == (p & 63)) { if (p < 64) { ca0 = ca; cb0 = cb; mp0 = m; } else { ca1 = ca; cb1 = cb; mp1 = m; } }
                m = mn; }
            coef[2 * lane] = ca0; coef[2 * lane + 1] = cb0; if (has1) { coef[2 * p1] = ca1; coef[2 * p1 + 1] = cb1; }
            if ((w0 & 2047) == 0) { sc0[2] = mp0; if (has1) sc1[2] = mp1; }
        }
        __syncthreads();
        float st[8];
#pragma unroll
        for (int j = 0; j < 8; ++j) st[j] = 0.f;
        u32x4* base = (u32x4*)(CS + (size_t)(bh * NCH) * 2 * 16384) + chunk;
#define SCAN_PTR(p) (base + (size_t)(scan_chunk(d, (p)) * 2 + d) * 2048)
#define SCAN_STEP(reg, p) do { const u32x4 dc = reg; if ((p) + 6 < NCH) reg = *SCAN_PTR((p) + 6); \
            u32x4 o; o.x = cvt_pk_bf16(st[0], st[1]); o.y = cvt_pk_bf16(st[2], st[3]); o.z = cvt_pk_bf16(st[4], st[5]); o.w = cvt_pk_bf16(st[6], st[7]); *SCAN_PTR(p) = o; \
            const float ca = coef[2 * (p)], cb = coef[2 * (p) + 1]; \
            st[0] = ca * st[0] + cb * bf_lo(dc.x); st[1] = ca * st[1] + cb * bf_hi(dc.x); st[2] = ca * st[2] + cb * bf_lo(dc.y); st[3] = ca * st[3] + cb * bf_hi(dc.y); \
            st[4] = ca * st[4] + cb * bf_lo(dc.z); st[5] = ca * st[5] + cb * bf_hi(dc.z); st[6] = ca * st[6] + cb * bf_lo(dc.w); st[7] = ca * st[7] + cb * bf_hi(dc.w); } while (0)
        u32x4 r0 = *SCAN_PTR(0), r1 = *SCAN_PTR(1), r2 = *SCAN_PTR(2), r3 = *SCAN_PTR(3), r4 = *SCAN_PTR(4), r5 = *SCAN_PTR(5);
        for (int p = 0; p < NCH; p += 6) { SCAN_STEP(r0, p); SCAN_STEP(r1, p + 1); SCAN_STEP(r2, p + 2); SCAN_STEP(r3, p + 3); SCAN_STEP(r4, p + 4); SCAN_STEP(r5, p + 5); }
#undef SCAN_STEP
#undef SCAN_PTR
        if ((w0 & 2047) == 0 && tid < 128) {
            float* nb = NS + (size_t)(bh * NCH) * 2 * 128 + tid;
#define NPTR(p) (nb + (size_t)(scan_chunk(d, (p)) * 2 + d) * 128)
#define NSTEP(reg, p) do { const float dn = reg; if ((p) + 6 < NCH) reg = *NPTR((p) + 6); *NPTR(p) = sn; sn = coef[2 * (p)] * sn + coef[2 * (p) + 1] * dn; } while (0)
            float sn = 0.f, n0 = *NPTR(0), n1 = *NPTR(1), n2 = *NPTR(2), n3 = *NPTR(3), n4 = *NPTR(4), n5 = *NPTR(5);
            for (int p = 0; p < NCH; p += 6) { NSTEP(n0, p); NSTEP(n1, p + 1); NSTEP(n2, p + 2); NSTEP(n3, p + 3); NSTEP(n4, p + 4); NSTEP(n5, p + 5); }
#undef NSTEP
#undef NPTR
        }
        __syncthreads();
    }
}

__device__ __forceinline__ void ph_mlstm_c(const Args& a, int L, LAS unsigned char* lds, int vcu, int G, int tid, int wave, int lane) {
    unsigned char* ws = a.ws;
    const bf16* U = (const bf16*)(ws + WS_U); const float* gates = (const float*)(ws + WS_GATES);
    const bf16* CS = (const bf16*)(ws + WS_CS); const float* NS = (const float*)(ws + WS_NS); const float* SCAL = (const float*)(ws + WS_SCAL);
    bf16* H = (bf16*)(ws + WS_H); const float* ghead = a.in[IN_GHEAD] + L * NH * DH;
    LAS unsigned char* imgQ = lds; LAS unsigned char* imgK = lds + 32768; LAS unsigned char* imgV = lds + 65536; LAS unsigned char* imgC = lds + 98304;
    LAS float* T_GAM = (LAS float*)(lds + TAB_OFF); LAS float* T_M = T_GAM + 256; LAS float* T_WI = T_M + 256; LAS float* T_FL = T_WI + 256; LAS float* T_NP = T_FL + 256; LAS float* T_QN = T_NP + 256;
    LAS float* T_RS = T_QN + 256;
    LAS float* T_SS = T_RS + 512;
    const int wr4 = wave >> 1, wc2 = wave & 1, fr = lane & 15, fq = lane >> 4;
    const int c_lo = (L == DEPTH - 1) ? NCH_C : 0, nc = NCH - c_lo;
    for (int u = vcu; u < NB * NH * nc; u += G) {
        const int b = u / (NH * nc), h = (u / nc) % NH, c = c_lo + u % nc, row0 = chunk_row0(b, c);
        const int si0 = state_idx(b, h, c, 0);
        u32x4 cb4[4];
        {
            u32x4 qr[4], kr[4], vr[4], cr[4];
#pragma unroll
            for (int i = 0; i < 4; ++i) { const int id = tid + 512 * i, r = id >> 4, ch = id & 15; const bf16* rp = U + (size_t)(row0 + r) * NU + 128 * h + 8 * ch;
                qr[i] = *(const u32x4*)(rp + UC_Q); kr[i] = *(const u32x4*)(rp + UC_K); vr[i] = *(const u32x4*)(rp + UC_V);
                cr[i] = *((const u32x4*)(CS + (size_t)si0 * 16384) + id); }
            if (wave < 2) { const int d = wave, t0 = 2 * lane; const float* gp = gates + (size_t)(row0 + t0) * 16 + h;
                const GateScan gs = gate_scan(d, lane, gp[(2 * d) * 4], gp[16 + (2 * d) * 4], gp[(2 * d + 1) * 4], gp[16 + (2 * d + 1) * 4]);
                const float mp = SCAL[(size_t)(si0 + d) * 4 + 2];
                const float M0 = fmaxf(mp, gs.cm0), M1 = fmaxf(mp, gs.cm1);
                T_GAM[d * 128 + t0] = gs.g0 * LOG2E; T_GAM[d * 128 + t0 + 1] = gs.g1 * LOG2E;
                T_M[d * 128 + t0] = M0 * LOG2E; T_M[d * 128 + t0 + 1] = M1 * LOG2E;
                T_WI[d * 128 + t0] = fexp(mp - M0); T_WI[d * 128 + t0 + 1] = fexp(mp - M1);
                T_FL[d * 128 + t0] = fexp(-(gs.b0 + M0)); T_FL[d * 128 + t0 + 1] = fexp(-(gs.b1 + M1)); }
            if (tid < 256) T_NP[tid] = NS[(size_t)(si0 + (tid >> 7)) * 128 + (tid & 127)];
#pragma unroll
            for (int i = 0; i < 4; ++i) { const int id = tid + 512 * i, r = id >> 4, ch = id & 15; const unsigned o = img_off((unsigned)r, (unsigned)ch);
                *(LAS u32x4*)(imgQ + o) = qr[i]; *(LAS u32x4*)(imgK + o) = kr[i]; *(LAS u32x4*)(imgV + o) = vr[i]; *(LAS u32x4*)(imgC + o) = cr[i]; }
        }
        __syncthreads();
        f32x4 S[2][4];
#pragma unroll
        for (int mi = 0; mi < 2; ++mi)
#pragma unroll
            for (int ni = 0; ni < 4; ++ni) S[mi][ni] = (f32x4){0.f, 0.f, 0.f, 0.f};
#pragma unroll 1
        for (int ks = 0; ks < 4; ++ks) { bf16x8 qf[2];
#pragma unroll
            for (int mi = 0; mi < 2; ++mi) qf[mi] = frag_row(imgQ, lane, 2 * wr4 + mi, ks);
#pragma unroll
            for (int ni = 0; ni < 4; ++ni) { const bf16x8 kf = frag_row(imgK, lane, 4 * wc2 + ni, ks);
#pragma unroll
                for (int mi = 0; mi < 2; ++mi) S[mi][ni] = __builtin_amdgcn_mfma_f32_16x16x32_bf16(kf, qf[mi], S[mi][ni], 0, 0, 0); } }
        {
            const int t = tid >> 2, part = tid & 3; float s0 = 0.f, s1 = 0.f;
#pragma unroll
            for (int cc = 0; cc < 4; ++cc) { const int ch = 4 * part + cc; const u32x4 qv = *(const LAS u32x4*)(imgQ + img_off((unsigned)t, (unsigned)ch)); const LAS float* n0 = T_NP + 8 * ch; const LAS float* n1 = T_NP + 128 + 8 * ch;
                const float qe[8] = {bf_lo(qv.x), bf_hi(qv.x), bf_lo(qv.y), bf_hi(qv.y), bf_lo(qv.z), bf_hi(qv.z), bf_lo(qv.w), bf_hi(qv.w)};
#pragma unroll
                for (int e = 0; e < 8; ++e) { s0 += qe[e] * n0[e]; s1 += qe[e] * n1[e]; } }
            s0 += __shfl_xor(s0, 1); s0 += __shfl_xor(s0, 2); s1 += __shfl_xor(s1, 1); s1 += __shfl_xor(s1, 2);
            if (part == 0) { T_QN[t] = s0; T_QN[128 + t] = s1; }
        }
        __syncthreads();
        f32x4 hs[2][4];
#pragma unroll
        for (int mi = 0; mi < 2; ++mi)
#pragma unroll
            for (int ni = 0; ni < 4; ++ni) hs[mi][ni] = (f32x4){0.f, 0.f, 0.f, 0.f};
#pragma unroll
        for (int d = 0; d < 2; ++d) {
            f32x4 acc[2][4];
#pragma unroll
            for (int mi = 0; mi < 2; ++mi)
#pragma unroll
                for (int ni = 0; ni < 4; ++ni) acc[mi][ni] = (f32x4){0.f, 0.f, 0.f, 0.f};
#pragma unroll 1
            for (int ks = 0; ks < 4; ++ks) { bf16x8 qf[2];
#pragma unroll
                for (int mi = 0; mi < 2; ++mi) qf[mi] = frag_row(imgQ, lane, 2 * wr4 + mi, ks);
#pragma unroll
                for (int ni = 0; ni < 4; ++ni) { const bf16x8 cf = frag_row(imgC, lane, 4 * wc2 + ni, ks);
#pragma unroll
                    for (int mi = 0; mi < 2; ++mi) acc[mi][ni] = __builtin_amdgcn_mfma_f32_16x16x32_bf16(cf, qf[mi], acc[mi][ni], 0, 0, 0); } }
#pragma unroll
            for (int mi = 0; mi < 2; ++mi) { const int t = 32 * wr4 + 16 * mi + fr; const float Mt = T_M[d * 128 + t], wi = T_WI[d * 128 + t]; float rs = 0.f;
#pragma unroll
                for (int ni = 0; ni < 4; ++ni) { const int s0 = 64 * wc2 + 16 * ni + 4 * fq; const f32x4 gm = *(const LAS f32x4*)(T_GAM + d * 128 + s0); float sp[4];
#pragma unroll
                    for (int j = 0; j < 4; ++j) { const int s = s0 + j; const bool ok = d == 0 ? (s <= t) : (s >= t); const float w = ok ? fexp2(gm[j] - Mt) : 0.f; sp[j] = S[mi][ni][j] * w; rs += sp[j]; }
                    u32x2 w2; w2.x = cvt_pk_bf16(sp[0], sp[1]); w2.y = cvt_pk_bf16(sp[2], sp[3]);
                    *(LAS u32x2*)(imgK + img_off((unsigned)t, (unsigned)(s0 >> 3)) + 2 * (s0 & 7)) = w2;
                    acc[mi][ni] = acc[mi][ni] * wi; }
                rs += __shfl_xor(rs, 16); rs += __shfl_xor(rs, 32);
                if (fq == 0) T_RS[(d * 128 + t) * 2 + wc2] = rs; }
            __syncthreads();
#pragma unroll 1
            for (int ks = 0; ks < 4; ++ks) { bf16x8 sf[2];
#pragma unroll
                for (int mi = 0; mi < 2; ++mi) sf[mi] = frag_row(imgK, lane, 2 * wr4 + mi, ks);
#pragma unroll
                for (int ni = 0; ni < 4; ++ni) { const bf16x8 vf = frag_tr(imgV, lane, 4 * wc2 + ni, ks);
#pragma unroll
                    for (int mi = 0; mi < 2; ++mi) acc[mi][ni] = __builtin_amdgcn_mfma_f32_16x16x32_bf16(vf, sf[mi], acc[mi][ni], 0, 0, 0); } }
#pragma unroll
            for (int mi = 0; mi < 2; ++mi) { const int t = 32 * wr4 + 16 * mi + fr;
                const float den = T_WI[d * 128 + t] * T_QN[d * 128 + t] + T_RS[(d * 128 + t) * 2] + T_RS[(d * 128 + t) * 2 + 1];
                const float rinv = 1.0f / fmaxf(fabsf(den), T_FL[d * 128 + t]);
#pragma unroll
                for (int ni = 0; ni < 4; ++ni) hs[mi][ni] = hs[mi][ni] + acc[mi][ni] * rinv; }
            if (d == 0) { __syncthreads();
#pragma unroll
                for (int i = 0; i < 4; ++i) { const int id = tid + 512 * i; cb4[i] = *((const u32x4*)(CS + (size_t)(si0 + 1) * 16384) + id); }
#pragma unroll
                for (int i = 0; i < 4; ++i) { const int id = tid + 512 * i; *(LAS u32x4*)(imgC + img_off((unsigned)(id >> 4), (unsigned)(id & 15))) = cb4[i]; }
                __syncthreads(); }
        }
#pragma unroll
        for (int mi = 0; mi < 2; ++mi) { const int t = 32 * wr4 + 16 * mi + fr; float ss = 0.f;
#pragma unroll
            for (int ni = 0; ni < 4; ++ni) { const f32x4 v = hs[mi][ni]; ss += (v[0] * v[0] + v[1] * v[1]) + (v[2] * v[2] + v[3] * v[3]); }
            ss += __shfl_xor(ss, 16); ss += __shfl_xor(ss, 32);
            if (fq == 0) T_SS[t * 2 + wc2] = ss; }
        __syncthreads();
#pragma unroll
        for (int mi = 0; mi < 2; ++mi) { const int t = 32 * wr4 + 16 * mi + fr; const float rstd = __builtin_amdgcn_rsqf((T_SS[t * 2] + T_SS[t * 2 + 1]) * (1.0f / DH) + EPS);
#pragma unroll
            for (int ni = 0; ni < 4; ++ni) { const int vd0 = 64 * wc2 + 16 * ni + 4 * fq; const u32x2 ow = *(const u32x2*)(U + (size_t)(row0 + t) * NU + UC_O + 128 * h + vd0);
                const f32x4 gh = *(const f32x4*)(ghead + h * DH + vd0); const f32x4 v = hs[mi][ni];
                const float o0 = bf_lo(ow.x), o1 = bf_hi(ow.x), o2 = bf_lo(ow.y), o3 = bf_hi(ow.y);
                const float y0 = v[0] * rstd * gh[0] / (1.0f + fexp(-o0)), y1 = v[1] * rstd * gh[1] / (1.0f + fexp(-o1)), y2 = v[2] * rstd * gh[2] / (1.0f + fexp(-o2)), y3 = v[3] * rstd * gh[3] / (1.0f + fexp(-o3));
                u32x2 w; w.x = cvt_pk_bf16(y0, y1); w.y = cvt_pk_bf16(y2, y3);
                *(u32x2*)(H + (size_t)(row0 + t) * D + 512 + 128 * h + vd0) = w; } }
        __syncthreads();
    }
}

__device__ __forceinline__ void ph_conv(const Args& a, int L, int vcu, int G, int wave, int lane) {
    unsigned char* ws = a.ws; const bf16* U = (const bf16*)(ws + WS_U); bf16* H = (bf16*)(ws + WS_H);
    const float* cw = a.in[IN_CONVW] + L * 3 * 512 + 8 * lane; const float* cbp = a.in[IN_CONVB] + L * 512 + 8 * lane;
    float w0[8], w1[8], w2[8], bb[8];
#pragma unroll
    for (int e = 0; e < 8; ++e) { w0[e] = cw[e]; w1[e] = cw[512 + e]; w2[e] = cw[1024 + e]; bb[e] = cbp[e]; }
    const int nrows = (L == DEPTH - 1) ? NLAT : NTOK;
    for (int row = vcu * 8 + wave; row < nrows; row += G * 8) {
        bool lv, rv; if (row < NLAT) { const int t = row & 63; lv = t != 0; rv = t != 63; } else { const int t = (row - NLAT) & 255; lv = t != 0; rv = t != 255; }
        const bf16* rp = U + (size_t)row * NU + 8 * lane;
        const u32x4 zb = {0u, 0u, 0u, 0u};
        const u32x4 bv = *(const u32x4*)(rp + UC_B), c0 = *(const u32x4*)(rp + UC_C), x0 = *(const u32x4*)(rp + UC_X);
        const u32x4 cl = lv ? *(const u32x4*)(rp - NU + UC_C) : zb, xl = lv ? *(const u32x4*)(rp - NU + UC_X) : zb;
        const u32x4 cr = rv ? *(const u32x4*)(rp + NU + UC_C) : zb, xr = rv ? *(const u32x4*)(rp + NU + UC_X) : zb;
        float y[8];
#pragma unroll
        for (int q = 0; q < 4; ++q) {
            const float m0 = bf_lo(c0[q]) * bf_lo(x0[q]), m1 = bf_hi(c0[q]) * bf_hi(x0[q]);
            const float l0 = bf_lo(cl[q]) * bf_lo(xl[q]), l1 = bf_hi(cl[q]) * bf_hi(xl[q]);
            const float r0 = bf_lo(cr[q]) * bf_lo(xr[q]), r1 = bf_hi(cr[q]) * bf_hi(xr[q]);
            y[2 * q] = bf_lo(bv[q]) * (w0[2 * q] * l0 + w1[2 * q] * m0 + w2[2 * q] * r0 + bb[2 * q]);
            y[2 * q + 1] = bf_hi(bv[q]) * (w0[2 * q + 1] * l1 + w1[2 * q + 1] * m1 + w2[2 * q + 1] * r1 + bb[2 * q + 1]); }
        u32x4 o; o.x = cvt_pk_bf16(y[0], y[1]); o.y = cvt_pk_bf16(y[2], y[3]); o.z = cvt_pk_bf16(y[4], y[5]); o.w = cvt_pk_bf16(y[6], y[7]);
        *(u32x4*)(H + (size_t)row * D + 8 * lane) = o;
    }
}

__device__ __forceinline__ int block_sum(int v, LAS int* sh, int& par, int wave, int lane) {
    if (lane == 0) sh[par * 8 + wave] = v;
    __syncthreads();
    int s = 0;
#pragma unroll
    for (int w = 0; w < 8; ++w) s += sh[par * 8 + w];
    par ^= 1;
    return s;
}
__device__ __forceinline__ int block_excl_scan(int v, int& total, LAS int* sh, int& par, int wave, int lane) {
    int inc = v;
#pragma unroll
    for (int s = 1; s < 64; s <<= 1) { const int t = __shfl_up(inc, s); if (lane >= s) inc += t; }
    if (lane == 63) sh[par * 8 + wave] = inc;
    __syncthreads();
    int pre = 0, tot = 0;
#pragma unroll
    for (int w = 0; w < 8; ++w) { const int x = sh[par * 8 + w]; tot += x; if (w < wave) pre += x; }
    par ^= 1; total = tot;
    return pre + inc - v;
}
__device__ __forceinline__ void ph_topk(const Args& a, int L, LAS unsigned char* lds, int vcu, int G, int tid, int wave, int lane) {
    unsigned char* ws = a.ws; const float* afft = (const float*)(ws + WS_AFFT);
    int* idx = (int*)(ws + WS_IDX); float* gsel = (float*)(ws + WS_GSEL); int* inv = (int*)(ws + WS_INV);
    LAS int* sh = (LAS int*)lds; int par = 0;
    const int nitems = (L == 0) ? 256 : 128;
    for (int item = vcu; item < nitems; item += G) {
        const bool lat = item < 128; const int b = (item & 127) >> 4, e = item & 15;
        const int n = lat ? SEQ : CTXL, k = lat ? CAP_L : CAP_C, tok0 = lat ? b * SEQ : NLAT + b * CTXL;
        const int slot0 = lat ? (e * NB + b) * CAP_L : NSLOT_L + (e * NB + b) * CAP_C;
        const float* av = afft + (size_t)e * NTOK + tok0;
        unsigned v[16];
        if (tid * 16 < n) {
#pragma unroll
            for (int q = 0; q < 4; ++q) { const f32x4 x = *(const f32x4*)(av + tid * 16 + 4 * q); v[4 * q] = __float_as_uint(x.x); v[4 * q + 1] = __float_as_uint(x.y); v[4 * q + 2] = __float_as_uint(x.z); v[4 * q + 3] = __float_as_uint(x.w); }
        } else {
#pragma unroll
            for (int j = 0; j < 16; ++j) v[j] = 0u;
        }
        unsigned T = 0u;
        for (int bit = 30; bit >= 0; --bit) { const unsigned cand = T | (1u << bit); int cnt = 0;
#pragma unroll
            for (int j = 0; j < 16; ++j) cnt += (int)__popcll(__ballot(v[j] >= cand));
            if (block_sum(cnt, sh, par, wave, lane) >= k) T = cand; }
        int gtc = 0, eqc = 0;
#pragma unroll
        for (int j = 0; j < 16; ++j) { gtc += (v[j] > T) ? 1 : 0; eqc += (v[j] == T) ? 1 : 0; }
        int tot_gt, tot_eq;
        (void)block_excl_scan(gtc, tot_gt, sh, par, wave, lane);
        int eq_before = block_excl_scan(eqc, tot_eq, sh, par, wave, lane);
        const int need_eq = k - tot_gt;
        unsigned selmask = 0u; int nsel = 0;
#pragma unroll
        for (int j = 0; j < 16; ++j) { bool s = v[j] > T; if (v[j] == T) { s = eq_before < need_eq; ++eq_before; } if (s) { selmask |= 1u << j; ++nsel; } }
        int tot_sel; int pos = block_excl_scan(nsel, tot_sel, sh, par, wave, lane);
        if (tid * 16 < n) {
#pragma unroll
            for (int j = 0; j < 16; ++j) { const int tok = tok0 + tid * 16 + j;
                if (selmask & (1u << j)) { const int slot = slot0 + pos; ++pos; idx[slot] = tok; gsel[slot] = __uint_as_float(v[j]); inv[(size_t)tok * 16 + e] = slot; }
                else inv[(size_t)tok * 16 + e] = -1; }
        }
    }
}
__device__ __forceinline__ void ph_gather(const Args& a, int L, int vcu, int G, int wave, int lane) {
    unsigned char* ws = a.ws; const bf16* H = (const bf16*)(ws + WS_H); bf16* XE = (bf16*)(ws + WS_XE); const int* idx = (const int*)(ws + WS_IDX);
    const int nslot = (L == 0) ? NSLOT : NSLOT_L;
    for (int s = vcu * 8 + wave; s < nslot; s += G * 8) { const int row = idx[s];
        const u32x4 v0 = *((const u32x4*)(H + (size_t)row * D) + lane), v1 = *((const u32x4*)(H + (size_t)row * D) + 64 + lane);
        *((u32x4*)(XE + (size_t)s * D) + lane) = v0; *((u32x4*)(XE + (size_t)s * D) + 64 + lane) = v1; }
}

constexpr int PH_PER_LAYER = 12, N_PHASES = 1 + DEPTH * PH_PER_LAYER;
__global__ void __launch_bounds__(512, 2) mk_fwd(Args args) {
    extern __shared__ __attribute__((aligned(16))) unsigned char lds_raw[];
    LAS unsigned char* lds = (LAS unsigned char*)lds_raw;
    const int tid0 = threadIdx.x;
    const int G = gridDim.x; const int bx = blockIdx.x; const int vcu = (G % 8 == 0) ? (bx % 8) * (G / 8) + bx / 8 : bx;
    volatile LAS unsigned* MISC = (volatile LAS unsigned*)(lds + MISC_OFF);
    if (tid0 < 64) MISC[tid0] = 0u;
    __syncthreads();
    XcdBarrier bar = xcd_barrier_post((unsigned*)(args.ws + WS_CTL) + 4096, MISC + 8);
    const int lo = args.ph_lo, hi = args.ph_hi;
#define CAS __attribute__((address_space(4)))
#define OPQ() const CAS Args* ap_ = (const CAS Args*)__builtin_amdgcn_kernarg_segment_ptr(); asm volatile("" : "+s"(ap_)); Args A; \
    _Pragma("unroll") for (int i_ = 0; i_ < 19; ++i_) A.in[i_] = (const float*)(const GAS float*)(ap_->in[i_]); \
    A.out = (float*)(GAS float*)(ap_->out); A.ws = (unsigned char*)(GAS unsigned char*)(ap_->ws); A.ph_lo = 0; A.ph_hi = 0; unsigned char* ws = A.ws; (void)ws; \
    int tid = tid0; asm volatile("" : "+v"(tid)); const int lane = tid & 63, wave = __builtin_amdgcn_readfirstlane(tid >> 6); (void)lane; (void)wave
#ifndef MK_PHMASK
#define MK_PHMASK 0x1fff
#endif
#define EN(p) (((MK_PHMASK) >> (p)) & 1)
#ifndef MK_REPMASK
#define MK_REPMASK 0
#endif
#define REP(p) for (int rep_ = 0; rep_ <= (((MK_REPMASK) >> (p)) & 1); ++rep_, __syncthreads())
#define IN(k) (lo <= (k) && (k) < hi)
#define SEAM(k) do { if (IN(k) && IN((k) + 1)) { xcd_barrier(bar); if (((MK_REPMASK) >> 14) & 1) xcd_barrier(bar); } } while (0)
    if (EN(12) && IN(0)) REP(12) { OPQ(); ph_prologue(A, lds, vcu, G, tid, wave, lane); }
    SEAM(0);
    for (int L = 0; L < DEPTH; ++L) {
        const int pb = 1 + L * PH_PER_LAYER;
        if (EN(0) && IN(pb + 0)) REP(0) { OPQ(); ph_convert(A, L, lds, vcu, G, wave, lane); __syncthreads(); if (L == 0) ph_prepass1_l0(A, lds, vcu, G, tid, wave, lane); }
        SEAM(pb + 0);
        if (EN(1) && IN(pb + 1)) REP(1) { OPQ(); pg8::Gemm g{(const bf16*)(ws + WS_H), (const bf16*)(ws + WS_WIN), 1024}; pg8::Sched S; S.init(NTOK / 256, NU / 256, G, bx, 0);
            pg8::EpiU E{(bf16*)(ws + WS_U), NU}; pg8::gemm_phase<pg8::EpiU>(lds, g, S, E, tid); }
        SEAM(pb + 1);
        if (EN(2) && IN(pb + 2)) REP(2) { OPQ(); ph_mlstm_a(A, lds, vcu, G, tid, wave, lane); }
        SEAM(pb + 2);
        if (EN(3) && IN(pb + 3)) REP(3) { OPQ(); ph_scan(A, lds, vcu, G, tid); }
        SEAM(pb + 3);
        if (EN(4) && IN(pb + 4)) REP(4) { OPQ(); ph_mlstm_c(A, L, lds, vcu, G, tid, wave, lane); ph_conv(A, L, vcu, G, wave, lane); }
        SEAM(pb + 4);
        if (EN(5) && IN(pb + 5)) for (int rep_ = 0; rep_ <= ((((MK_REPMASK) >> 13) & 1) && L == 0 ? 1 : 0); ++rep_, __syncthreads()) { OPQ(); pg8::Gemm g{(const bf16*)(ws + WS_H), (const bf16*)(ws + WS_WOUT), 1024}; pg8::Sched S; S.init((L == DEPTH - 1 ? NLAT : NTOK) / 256, 4, G, bx, 0);
            pg8::EpiRes E{L == 0 ? A.in[IN_X] : A.out, L == 0 ? A.in[IN_CTX] : (const float*)(ws + WS_XC), A.out, (float*)(ws + WS_XC), (const float*)(ws + WS_MODV) + (size_t)L * 9 * 6144};
            pg8::gemm_phase<pg8::EpiRes>(lds, g, S, E, tid); }
        SEAM(pb + 5);
        if (EN(6) && IN(pb + 6)) REP(6) { OPQ(); ph_prepass2(A, L, lds, vcu, G, tid, wave, lane); }
        SEAM(pb + 6);
        if (EN(7) && IN(pb + 7)) REP(7) { OPQ(); ph_topk(A, L, lds, vcu, G, tid, wave, lane); }
        SEAM(pb + 7);
        if (EN(8) && IN(pb + 8)) REP(8) { OPQ(); ph_gather(A, L, vcu, G, wave, lane); }
        SEAM(pb + 8);
        if (EN(9) && IN(pb + 9)) REP(9) { OPQ(); pg8::Gemm g{(const bf16*)(ws + WS_XE), (const bf16*)(ws + WS_WGU), 1024}; pg8::Sched S; S.init((L == 0 ? NSLOT : NSLOT_L) / 256, 11, G, bx, 1);
            pg8::EpiGU E{(bf16*)(ws + WS_HM)}; pg8::gemm_phase<pg8::EpiGU>(lds, g, S, E, tid); }
        SEAM(pb + 9);
        if (EN(10) && IN(pb + 10)) REP(10) { OPQ(); pg8::Gemm g{(const bf16*)(ws + WS_HM), (const bf16*)(ws + WS_WD), DE}; pg8::Sched S; S.init((L == 0 ? NSLOT : NSLOT_L) / 256, 4, G, bx, 1);
            pg8::EpiD E{(bf16*)(ws + WS_XE), (const float*)(ws + WS_GSEL)}; pg8::gemm_phase<pg8::EpiD>(lds, g, S, E, tid); }
        SEAM(pb + 10);
        if (EN(11) && IN(pb + 11)) REP(11) { OPQ(); ph_combine(A, L, lds, vcu, G, tid, wave, lane); }
        SEAM(pb + 11);
    }
#undef IN
#undef SEAM
}

extern "C" void kernel_launch(void* const* d_in, const int* in_sizes, int n_in, void* d_out, int out_size, void* d_ws, size_t ws_size, hipStream_t stream) {
    static int grid = 0;
    if (grid == 0) {
        if (n_in != 19 || out_size != NLAT * D || ws_size < WS_END) { fprintf(stderr, "kernel_launch: unexpected problem (n_in %d, out %d, ws %zu < %zu)\n", n_in, out_size, ws_size, (size_t)WS_END); grid = -1; return; }
        int dev = 0, cus = 0, per_cu = 0;
        if (hipGetDevice(&dev) != hipSuccess || hipDeviceGetAttribute(&cus, hipDeviceAttributeMultiprocessorCount, dev) != hipSuccess) { grid = -1; return; }
        if (hipFuncSetAttribute((const void*)mk_fwd, hipFuncAttributeMaxDynamicSharedMemorySize, LDS_BYTES) != hipSuccess) { fprintf(stderr, "kernel_launch: hipFuncSetAttribute failed\n"); grid = -1; return; }
        if (hipOccupancyMaxActiveBlocksPerMultiprocessor(&per_cu, (const void*)mk_fwd, 512, LDS_BYTES) != hipSuccess || per_cu < 1) fprintf(stderr, "kernel_launch: occupancy query says %d\n", per_cu);
        (void)hipGetLastError();
        grid = cus;
    }
    if (grid < 0) return;
    (void)hipMemsetAsync((char*)d_ws + WS_CTL, 0, CTL_ZERO_BYTES, stream);
    Args a{};
    for (int i = 0; i < 19; ++i) a.in[i] = (const float*)d_in[i];
    a.out = (float*)d_out; a.ws = (unsigned char*)d_ws;
#if MK_ONE_LAUNCH
    a.ph_lo = 0; a.ph_hi = N_PHASES;
    hipLaunchKernelGGL(mk_fwd, dim3(grid), dim3(512), LDS_BYTES, stream, a);
#else
    for (int p = 0; p < N_PHASES; ++p) { a.ph_lo = p; a.ph_hi = p + 1; hipLaunchKernelGGL(mk_fwd, dim3(grid), dim3(512), LDS_BYTES, stream, a); }
#endif
}
```

```cpp
#include <hip/hip_runtime.h>
#include <cstdio>
#include <cstdint>

#ifndef MK_ONE_LAUNCH
#define MK_ONE_LAUNCH 1
#endif

#define GAS __attribute__((address_space(1)))
#define LAS __attribute__((address_space(3)))
typedef unsigned short bf16;
typedef short bf16x8 __attribute__((ext_vector_type(8)));
typedef short s16x4 __attribute__((ext_vector_type(4)));
typedef float f32x4 __attribute__((ext_vector_type(4)));
typedef float f32x2 __attribute__((ext_vector_type(2)));
typedef unsigned u32x4 __attribute__((ext_vector_type(4)));
typedef unsigned u32x2 __attribute__((ext_vector_type(2)));
typedef int i32x4 __attribute__((ext_vector_type(4)));
typedef int i32x8 __attribute__((ext_vector_type(8)));

constexpr int D = 1024, NB = 8, SEQ = 8192, CTXL = 256, DEPTH = 2;
constexpr int NLAT = NB * SEQ, NCTX = NB * CTXL, NTOK = NLAT + NCTX;
constexpr int DPROJ = 3600, NG = 3584, NU = 3072;
constexpr int NH = 4, DH = 128, NCH_C = 2, NCH_L = 64, NCH = 66;
constexpr int NE = 16, DE = 1408, CAP_L = 1024, CAP_C = 32;
constexpr int NSLOT_L = NB * NE * CAP_L, NSLOT = NSLOT_L + NB * NE * CAP_C;
constexpr int NMOD = 6;
constexpr int DEP = 1536;
constexpr float F8_H = 16.0f, F8_HM = 8.0f, F8_W = 256.0f, F8_YE = 32.0f, F8_MAX = 448.0f;
constexpr float EPS = 1e-6f;
constexpr float LOG2E = 1.4426950408889634f;
constexpr int UC_B = 0, UC_CX = 512, UC_Q = 1024, UC_K = 1536, UC_V = 2048, UC_O = 2560;
constexpr int SC_C = 512, SC_X = 1024, SC_Q = 1536, SC_K = 2048;

constexpr size_t MiB = 1u << 20;
constexpr size_t WS_CTL = 0, CTL_ZERO_BYTES = 32 * 1024;
constexpr size_t WS_MODV = 1 * MiB;
constexpr size_t WS_WG = 1 * MiB + 512 * 1024;
constexpr size_t WS_WR = WS_WG + 64 * 1024;
constexpr size_t WS_GATES = 2 * MiB;
constexpr size_t WS_AFFT = 7 * MiB;
constexpr size_t WS_INV = 12 * MiB;
constexpr size_t WS_IDX = 17 * MiB;
constexpr size_t WS_GSEL = 18 * MiB;
constexpr size_t WS_SCAL = 19 * MiB;
constexpr size_t WS_NS = 20 * MiB;
constexpr size_t WS_XC = 24 * MiB;
constexpr size_t WS_WIN = 32 * MiB;
constexpr size_t WS_WOUT = 39 * MiB;
constexpr size_t WS_WGU = 41 * MiB;
constexpr size_t WS_WD = 129 * MiB;
constexpr size_t WS_XB = 173 * MiB;
constexpr size_t WS_R = 305 * MiB;
constexpr size_t WS_U = WS_R;
constexpr size_t WS_CS = WS_R + 462 * MiB;
constexpr size_t WS_XE = WS_R;
constexpr size_t WS_HM = WS_R + 264 * MiB;
constexpr size_t WS_END = WS_R + 627 * MiB;
constexpr size_t OUT_H8 = 160 * MiB;
static_assert((size_t)NTOK * NG * 2 == 462 * MiB && (size_t)NSLOT * 1024 * 2 == 264 * MiB && (size_t)NSLOT * DE * 2 == 363 * MiB, "sizes");
static_assert(WS_CS + (size_t)NB * NH * NCH * 2 * 32768 <= WS_END, "CS");

constexpr int RING_BYTES = 131072, TAB_OFF = 131072, TAB_BYTES = 16384, MISC_OFF = TAB_OFF + TAB_BYTES, LDS_BYTES = MISC_OFF + 256;

__device__ __forceinline__ unsigned cvt_pk_bf16(float lo, float hi) { unsigned r; asm volatile("v_cvt_pk_bf16_f32 %0, %1, %2" : "=v"(r) : "v"(lo), "v"(hi)); return r; }
__device__ __forceinline__ unsigned cvt4_fp8(float a, float b, float c, float d) {
    a = fmaxf(a, -F8_MAX); b = fmaxf(b, -F8_MAX); c = fmaxf(c, -F8_MAX); d = fmaxf(d, -F8_MAX); asm volatile("" : "+v"(a), "+v"(b), "+v"(c), "+v"(d));
    a = fminf(a, F8_MAX); b = fminf(b, F8_MAX); c = fminf(c, F8_MAX); d = fminf(d, F8_MAX);
    unsigned w = (unsigned)__builtin_amdgcn_cvt_pk_fp8_f32(a, b, 0, false); w = (unsigned)__builtin_amdgcn_cvt_pk_fp8_f32(c, d, (int)w, true); return w; }
__device__ __forceinline__ f32x4 zero4() { float a, b, c, d; asm volatile("v_mov_b32 %0, 0\n\tv_mov_b32 %1, 0\n\tv_mov_b32 %2, 0\n\tv_mov_b32 %3, 0" : "=v"(a), "=v"(b), "=v"(c), "=v"(d)); return (f32x4){a, b, c, d}; }
__device__ __forceinline__ u32x4 zero4u() { unsigned a, b, c, d; asm volatile("v_mov_b32 %0, 0\n\tv_mov_b32 %1, 0\n\tv_mov_b32 %2, 0\n\tv_mov_b32 %3, 0" : "=v"(a), "=v"(b), "=v"(c), "=v"(d)); return (u32x4){a, b, c, d}; }
__device__ __forceinline__ u32x2 zero2u() { unsigned a, b; asm volatile("v_mov_b32 %0, 0\n\tv_mov_b32 %1, 0" : "=v"(a), "=v"(b)); return (u32x2){a, b}; }
__device__ __forceinline__ float bf_lo(unsigned w) { return __uint_as_float(w << 16); }
__device__ __forceinline__ float bf_hi(unsigned w) { return __uint_as_float(w & 0xffff0000u); }
__device__ __forceinline__ float shf(float v, int src) { return __int_as_float(__builtin_amdgcn_ds_bpermute(src << 2, __float_as_int(v))); }
__device__ __forceinline__ float rdl(float v, int k) { return __int_as_float(__builtin_amdgcn_readlane(__float_as_int(v), k)); }
__device__ __forceinline__ int shi(int v, int src) { return __builtin_amdgcn_ds_bpermute(src << 2, v); }
__device__ __forceinline__ float shx(float v, int m, int lane) { return shf(v, lane ^ m); }
__device__ __forceinline__ float shup(float v, int s, int lane) { return shf(v, lane >= s ? lane - s : lane); }
__device__ __forceinline__ float shdn(float v, int s, int lane) { return shf(v, lane + s < 64 ? lane + s : lane); }
__device__ __forceinline__ float wave_sum(float v, int lane) {
#pragma unroll
    for (int o = 1; o < 64; o <<= 1) v += shx(v, o, lane);
    return v;
}
__device__ __forceinline__ float fexp2(float x) { return __builtin_amdgcn_exp2f(x); }
__device__ __forceinline__ float fexp(float x) { return __builtin_amdgcn_exp2f(x * LOG2E); }
#define LDS_WAIT() asm volatile("s_waitcnt lgkmcnt(0)" ::: "memory")
#define VM_WAIT() asm volatile("s_waitcnt vmcnt(0)" ::: "memory")

namespace pg8 {
constexpr int BM = 256, BK = 64, HALF = 128, HTB = HALF * BK * 2, STAGE_BYTES = 8 * HTB, NXCD = 8, WGM = 8;
__host__ __device__ __forceinline__ int lds_byte(int r, int c) { const int st = (r >> 4) * 2 + (c >> 5), rr = r & 15, cc = c & 31, ob = rr * 64 + cc * 2; return st * 1024 + (ob ^ (((ob >> 9) & 1) << 5)); }
__host__ __device__ __forceinline__ void stage_rc(int b, int& R, int& C) { const int st = b / 1024, sb = b % 1024, swz = sb ^ (((sb >> 9) & 1) << 5); R = (st >> 1) * 16 + swz / 64; C = (st & 1) * 32 + (swz % 64) / 2; }
__host__ __device__ __forceinline__ int perm32(int rho) { const int n = rho >> 4, i = rho & 15; return 8 * (i >> 2) + 4 * n + (i & 3); }

__device__ __forceinline__ const char* uni_ptr(const char* p) { const unsigned long long v = (unsigned long long)p;
    const unsigned lo = (unsigned)__builtin_amdgcn_readfirstlane((int)(unsigned)v), hi = (unsigned)__builtin_amdgcn_readfirstlane((int)(unsigned)(v >> 32)); return (const char*)(((unsigned long long)hi << 32) | lo); }
struct Unit { int pm, pn, bt; };
struct Gemm { const bf16* A; const bf16* Bt; int K; };

struct Sched {
    int nM, nN, nwg, G, c, moe, rev;
    __device__ __forceinline__ void init(int nM_, int nN_, int G_, int c_, int moe_, int rev_ = 0) { nM = nM_; nN = nN_; nwg = nM * nN; G = G_; c = c_; moe = moe_; rev = rev_; }
    __device__ __forceinline__ bool next(int i, Unit& u) const {
        const long L = (long)i * G + c; if (L >= nwg) return false;
        int wgid = (int)L; { const int q = nwg / NXCD, r = nwg % NXCD, xcd = wgid % NXCD, off = wgid / NXCD; wgid = (xcd < r ? xcd * (q + 1) : r * (q + 1) + (xcd - r) * q) + off; }
        const int nig = WGM * nN, gid = wgid / nig, fm = gid * WGM, gsz = (nM - fm) < WGM ? (nM - fm) : WGM;
        u.pm = fm + ((wgid % nig) % gsz); u.pn = (wgid % nig) / gsz;
        if (rev) u.pm = nM - 1 - u.pm;
        u.bt = moe ? ((u.pm < 512 ? (u.pm >> 5) : (u.pm - 512)) * nN + u.pn) : u.pn;
        return true;
    }
};

struct EpiU {
    static constexpr bool PERM = true;
    bf16* O; int ldc;
    __device__ __forceinline__ void operator()(const f32x4 (&acc)[2][2][4][2], const Unit& u, int wr, int wc, int fr, int fq) const {
        const int row0 = u.pm * BM + wr * 64 + fr;
        if (u.pn >= 2 && u.pn < 6) {
            const int col0 = 512 + (u.pn - 2) * HALF + wc * 32 + 8 * fq;
#pragma unroll
            for (int ai = 0; ai < 2; ++ai)
#pragma unroll
                for (int m = 0; m < 4; ++m) { const f32x4 v0 = acc[ai][0][m][0] * acc[ai][1][m][0], v1 = acc[ai][0][m][1] * acc[ai][1][m][1];
                    u32x4 w; w.x = cvt_pk_bf16(v0[0], v0[1]); w.y = cvt_pk_bf16(v0[2], v0[3]); w.z = cvt_pk_bf16(v1[0], v1[1]); w.w = cvt_pk_bf16(v1[2], v1[3]);
                    *(u32x4*)(O + (size_t)(row0 + ai * HALF + m * 16) * ldc + col0) = w; }
        } else {
            const int col0 = (u.pn < 2 ? u.pn * BM : u.pn * BM - 512) + wc * 32 + 8 * fq;
#pragma unroll
            for (int ai = 0; ai < 2; ++ai)
#pragma unroll
                for (int m = 0; m < 4; ++m) { bf16* rowp = O + (size_t)(row0 + ai * HALF + m * 16) * ldc + col0;
#pragma unroll
                    for (int bj = 0; bj < 2; ++bj) { const f32x4 v0 = acc[ai][bj][m][0], v1 = acc[ai][bj][m][1];
                        u32x4 w; w.x = cvt_pk_bf16(v0[0], v0[1]); w.y = cvt_pk_bf16(v0[2], v0[3]); w.z = cvt_pk_bf16(v1[0], v1[1]); w.w = cvt_pk_bf16(v1[2], v1[3]);
                        *(u32x4*)(rowp + bj * HALF) = w; } }
        }
    }
};
struct EpiRes {
    static constexpr bool PERM = true;
    bf16* x_lat; bf16* x_ctx; const float* modv;
    __device__ __forceinline__ void operator()(const f32x4 (&acc)[2][2][4][2], const Unit& u, int wr, int wc, int fr, int fq) const {
        const bool lat = u.pm < 256; const int g = lat ? (u.pm >> 5) : 8;
        const int rowt = (lat ? u.pm : u.pm - 256) * BM + wr * 64 + fr, col0 = u.pn * BM + wc * 32 + 8 * fq;
        bf16* x = lat ? x_lat : x_ctx;
        f32x4 gv[2][2];
#pragma unroll
        for (int bj = 0; bj < 2; ++bj)
#pragma unroll
            for (int n = 0; n < 2; ++n) gv[bj][n] = *(const f32x4*)(modv + g * 6144 + 2 * 1024 + col0 + bj * HALF + 4 * n);
#pragma unroll
        for (int ai = 0; ai < 2; ++ai) {
            u32x4 bs[4][2];
#pragma unroll
            for (int m = 0; m < 4; ++m)
#pragma unroll
                for (int bj = 0; bj < 2; ++bj) bs[m][bj] = *(const u32x4*)(x + (size_t)(rowt + ai * HALF + m * 16) * D + col0 + bj * HALF);
#pragma unroll
            for (int m = 0; m < 4; ++m)
#pragma unroll
                for (int bj = 0; bj < 2; ++bj) { const u32x4 b = bs[m][bj]; const f32x4 a0 = acc[ai][bj][m][0] * gv[bj][0], a1 = acc[ai][bj][m][1] * gv[bj][1];
                    u32x4 w; w.x = cvt_pk_bf16(bf_lo(b.x) + a0[0], bf_hi(b.x) + a0[1]); w.y = cvt_pk_bf16(bf_lo(b.y) + a0[2], bf_hi(b.y) + a0[3]);
                    w.z = cvt_pk_bf16(bf_lo(b.z) + a1[0], bf_hi(b.z) + a1[1]); w.w = cvt_pk_bf16(bf_lo(b.w) + a1[2], bf_hi(b.w) + a1[3]);
                    *(u32x4*)(x + (size_t)(rowt + ai * HALF + m * 16) * D + col0 + bj * HALF) = w; }
            asm volatile("" ::: "memory"); }
    }
};
struct EpiGU8 {
    static constexpr bool PERM = true;
    unsigned char* O;
    __device__ __forceinline__ void operator()(const f32x4 (&acc)[2][2][4][2], const Unit& u, int wr, int wc, int fr, int fq) const {
        const int row0 = u.pm * BM + wr * 64 + fr, col0 = u.pn * HALF + wc * 32 + 8 * fq;
        constexpr float SA = 1.0f / (F8_H * F8_W), SB = F8_HM / (F8_H * F8_W);
#pragma unroll
        for (int ai = 0; ai < 2; ++ai)
#pragma unroll
            for (int m = 0; m < 4; ++m) { unsigned char* rowp = O + (size_t)(row0 + ai * HALF + m * 16) * DEP + col0;
                float r[8];
#pragma unroll
                for (int n = 0; n < 2; ++n)
#pragma unroll
                    for (int j = 0; j < 4; ++j) { const float x = acc[ai][0][m][n][j], y = acc[ai][1][m][n][j]; r[4 * n + j] = (x * __builtin_amdgcn_rcpf(1.0f + fexp2(x * (-SA * LOG2E)))) * (y * (SA * SB)); }
                u32x2 w; w.x = cvt4_fp8(r[0], r[1], r[2], r[3]); w.y = cvt4_fp8(r[4], r[5], r[6], r[7]);
                *(u32x2*)rowp = w;
                if (u.pn == 10) *(u32x2*)(rowp + HALF) = zero2u(); }
    }
};
struct EpiD {
    static constexpr bool PERM = true;
    unsigned char* O;
    __device__ __forceinline__ void operator()(const f32x4 (&acc)[2][2][4][2], const Unit& u, int wr, int wc, int fr, int fq) const {
        const int row0 = u.pm * BM + wr * 64 + fr, col0 = u.pn * BM + wc * 32 + 8 * fq;
#pragma unroll
        for (int ai = 0; ai < 2; ++ai)
#pragma unroll
            for (int m = 0; m < 4; ++m) { const int row = row0 + ai * HALF + m * 16; constexpr float gs = F8_YE / (F8_HM * F8_W); unsigned char* rowp = O + (size_t)row * D + col0;
#pragma unroll
                for (int bj = 0; bj < 2; ++bj) { const f32x4 v0 = acc[ai][bj][m][0] * gs, v1 = acc[ai][bj][m][1] * gs;
                    u32x2 w; w.x = cvt4_fp8(v0[0], v0[1], v0[2], v0[3]); w.y = cvt4_fp8(v1[0], v1[1], v1[2], v1[3]);
                    *(u32x2*)(rowp + bj * HALF) = w; } }
    }
};

template <class Epi, bool GATHER = false, bool F8 = false>
__device__ __forceinline__ void gemm_phase(LAS unsigned char* lds, const Gemm g, const Sched& S, const Epi& E, const int tid, const int* gidx = nullptr) {
    const int wid = __builtin_amdgcn_readfirstlane(tid >> 6), lane = tid & 63, wr = wid >> 2, wc = wid & 3, fr = lane & 15, fq = lane >> 4;
    const int K = g.K, nt = K / BK;
    unsigned voffA[2], voffB[2]; int rowA[2], colA[2];
#pragma unroll
    for (int i = 0; i < 2; ++i) { int R, C; stage_rc(tid * 16 + i * 8192, R, C); const int Rb = Epi::PERM ? ((R & ~31) + perm32(R & 31)) : R;
        voffA[i] = (unsigned)(R * K + C) * 2u; voffB[i] = (unsigned)(Rb * K + C) * 2u; rowA[i] = R; colA[i] = C; }
    const size_t kstep = (size_t)(BK * 2);
    const size_t hstep = (size_t)HALF * K * 2;
    const size_t tstep = 2 * hstep;
    const unsigned ldsw = (unsigned)wid * 1024u;
    const int aoff = lds_byte(wr * 64 + fr, fq * 8), boff = lds_byte(wc * 32 + fr, fq * 8);
#define PG8_SA(b, h) (((b) * 2 + (h)) * HTB)
#define PG8_SB(b, h) ((4 + (b) * 2 + (h)) * HTB)
#define PG8_STAGE(bufoff, gbase, voff) do { const char* gb_ = uni_ptr((const char*)(gbase)); _Pragma("unroll") for (int _i = 0; _i < 2; ++_i) { unsigned vo_ = (voff)[_i]; asm volatile("" : "+v"(vo_)); \
        __builtin_amdgcn_global_load_lds((const unsigned*)(gb_ + vo_), (LAS unsigned*)(lds + (bufoff) + ldsw + _i * 8192), 16, 0, 0); } } while (0)
#define PG8_GI(nx, h) do { if constexpr (GATHER) { const int tb_ = ((nx) ? nbuf : cbuf) * 1024 + (h) * 512; gix[0] = *(const LAS unsigned*)(gtab + tb_ + gt_rd); gix[1] = *(const LAS unsigned*)(gtab + tb_ + 256 + gt_rd); } } while (0)
#define PG8_STAGE_A(bufoff, nx, h, kb) do { if constexpr (GATHER) { const char* ga_ = uni_ptr((const char*)g.A + (kb)); _Pragma("unroll") for (int _i = 0; _i < 2; ++_i) \
        __builtin_amdgcn_global_load_lds((const unsigned*)(ga_ + (gix[_i] * (unsigned)(K * 2) + colA2)), (LAS unsigned*)(lds + (bufoff) + ldsw + _i * 8192), 16, 0, 0); } \
        else PG8_STAGE(bufoff, ((nx) ? nA : cA) + (h) * hstep + (kb), voffA); } while (0)
#define PG8_GIDX_DMA(pm_, b_) do { if (wid < 4) { const char* gp_ = uni_ptr((const char*)(gidx + (pm_) * BM + wid * 64)); unsigned lo_; asm volatile("v_mbcnt_lo_u32_b32 %0, -1, 0\n\tv_mbcnt_hi_u32_b32 %0, -1, %0\n\tv_lshlrev_b32 %0, 2, %0" : "=v"(lo_)); \
        __builtin_amdgcn_global_load_lds((const unsigned*)(gp_ + lo_), (LAS unsigned*)(gtab + (b_) * 1024 + wid * 256), 4, 0, 0); } } while (0)
#define PG8_LD8(p) __builtin_shufflevector(*(const LAS i32x4*)(p), *(const LAS i32x4*)((p) + 1024), 0, 1, 2, 3, 4, 5, 6, 7)
#define PG8_LDA(dst, b, h) do { _Pragma("unroll") for (int m = 0; m < 4; ++m) { if constexpr (F8) dst##8[m] = PG8_LD8(lds + PG8_SA(b, h) + aoff + m * 2048); else { _Pragma("unroll") for (int k = 0; k < 2; ++k) dst[m][k] = *(const LAS bf16x8*)(lds + PG8_SA(b, h) + aoff + m * 2048 + k * 1024); } } } while (0)
#define PG8_LDB(dst, b, h) do { _Pragma("unroll") for (int n = 0; n < 2; ++n) { if constexpr (F8) dst##8[n] = PG8_LD8(lds + PG8_SB(b, h) + boff + n * 2048); else { _Pragma("unroll") for (int k = 0; k < 2; ++k) dst[n][k] = *(const LAS bf16x8*)(lds + PG8_SB(b, h) + boff + n * 2048 + k * 1024); } } } while (0)
#define PG8_MMA(ai, bj, At, Bt) do { __builtin_amdgcn_s_setprio(1); _Pragma("unroll") for (int m = 0; m < 4; ++m) _Pragma("unroll") for (int n = 0; n < 2; ++n) { \
        if constexpr (F8) acc[ai][bj][m][n] = __builtin_amdgcn_mfma_scale_f32_16x16x128_f8f6f4(Bt##8[n], At##8[m], acc[ai][bj][m][n], 0, 0, 0, 0, 0, 0); \
        else { _Pragma("unroll") for (int k = 0; k < 2; ++k) acc[ai][bj][m][n] = __builtin_amdgcn_mfma_f32_16x16x32_bf16(Bt[n][k], At[m][k], acc[ai][bj][m][n], 0, 0, 0); } } __builtin_amdgcn_s_setprio(0); } while (0)
#define PG8_WAIT_V(n) asm volatile("s_waitcnt vmcnt(" #n ")" ::: "memory")
#define PG8_WAIT_L(n) asm volatile("s_waitcnt lgkmcnt(" #n ")" ::: "memory")
#define PG8_BAR __builtin_amdgcn_s_barrier()
#define PG8_SCHED __builtin_amdgcn_sched_barrier(0)
    Unit cur, nxt; int ui = 0;
    if (!S.next(0, cur)) return;
    f32x4 acc[2][2][4][2];
#pragma unroll
    for (int a = 0; a < 2; ++a)
#pragma unroll
        for (int b = 0; b < 2; ++b)
#pragma unroll
            for (int m = 0; m < 4; ++m)
#pragma unroll
                for (int n = 0; n < 2; ++n) acc[a][b][m][n] = (f32x4){0.f, 0.f, 0.f, 0.f};
    bf16x8 At[4][2], B0[2][2], B1[2][2]; i32x8 At8[4], B08[2], B18[2];
    const char* cA = uni_ptr((const char*)g.A + (size_t)cur.pm * tstep); const char* cB = uni_ptr((const char*)g.Bt + (size_t)cur.bt * tstep);
    const char* nA = cA;
    LAS unsigned char* const gtab = lds + TAB_OFF; const int gt_rd = rowA[0] * 4; const unsigned colA2 = (unsigned)colA[0] * 2u; unsigned gix[2] = {0u, 0u}; int cbuf = 0, nbuf = 0;
    (void)gtab; (void)gt_rd; (void)colA2; (void)gix; (void)cbuf; (void)nbuf;
    if constexpr (GATHER) { PG8_GIDX_DMA(cur.pm, 0); PG8_WAIT_V(0); PG8_BAR; }
    PG8_STAGE(PG8_SB(0, 0), cB, voffB); PG8_STAGE(PG8_SB(0, 1), cB + hstep, voffB); PG8_GI(false, 0); PG8_STAGE_A(PG8_SA(0, 0), false, 0, 0); PG8_GI(false, 1); PG8_STAGE_A(PG8_SA(0, 1), false, 1, 0);
    if (wr == 1) PG8_BAR;
    PG8_WAIT_V(2); PG8_BAR;
    PG8_STAGE(PG8_SB(1, 0), cB + kstep, voffB); PG8_GI(false, 0); PG8_STAGE_A(PG8_SA(1, 0), false, 0, kstep); PG8_STAGE(PG8_SB(1, 1), cB + hstep + kstep, voffB);
    PG8_WAIT_V(6); PG8_BAR;
    for (;;) {
        const bool has_next = S.next(ui + 1, nxt);
        nA = uni_ptr(has_next ? (const char*)g.A + (size_t)nxt.pm * tstep : cA); const char* nB = uni_ptr(has_next ? (const char*)g.Bt + (size_t)nxt.bt * tstep : cB);
        if constexpr (GATHER) { nbuf = has_next ? (cbuf ^ 1) : cbuf; if (has_next) PG8_GIDX_DMA(nxt.pm, nbuf); }
#pragma unroll 1
        for (int t = 0; t < nt; t += 2) {
            const bool last = (t == nt - 2);
            const size_t kb1 = (size_t)(t + 1) * kstep, kb2 = last ? 0 : (size_t)(t + 2) * kstep;
            const char* b2 = last ? nB : cB + (size_t)(t + 2) * kstep; const char* b3 = b2 + kstep;
            PG8_GI(false, 1); PG8_LDB(B0, 0, 0); PG8_LDB(B1, 0, 1); PG8_SCHED; PG8_LDA(At, 0, 0); PG8_STAGE_A(PG8_SA(1, 1), false, 1, kb1);
            PG8_WAIT_V(8); PG8_WAIT_L(0); PG8_BAR; PG8_MMA(0, 0, At, B0); PG8_MMA(0, 1, At, B1); PG8_BAR; PG8_SCHED;
            PG8_GI(last, 0); PG8_LDA(At, 0, 1); PG8_STAGE(PG8_SB(0, 0), b2, voffB); PG8_STAGE(PG8_SB(0, 1), b2 + hstep, voffB); PG8_STAGE_A(PG8_SA(0, 0), last, 0, kb2);
            PG8_WAIT_V(8); PG8_WAIT_L(0); PG8_BAR; PG8_MMA(1, 0, At, B0); PG8_MMA(1, 1, At, B1); PG8_BAR; PG8_SCHED;
            PG8_GI(last, 1); PG8_LDB(B0, 1, 0); PG8_LDB(B1, 1, 1); PG8_SCHED; PG8_LDA(At, 1, 0); PG8_STAGE_A(PG8_SA(0, 1), last, 1, kb2);
            PG8_WAIT_V(8); PG8_WAIT_L(0); PG8_BAR; PG8_MMA(0, 0, At, B0); PG8_MMA(0, 1, At, B1); PG8_BAR; PG8_SCHED;
            PG8_GI(last, 0); PG8_LDA(At, 1, 1); PG8_STAGE(PG8_SB(1, 0), b3, voffB); PG8_STAGE(PG8_SB(1, 1), b3 + hstep, voffB); PG8_STAGE_A(PG8_SA(1, 0), last, 0, kb2 + kstep);
            PG8_WAIT_V(8); PG8_WAIT_L(0); PG8_BAR; PG8_MMA(1, 0, At, B0); PG8_MMA(1, 1, At, B1); PG8_BAR; PG8_SCHED;
        }
        if (wr == 0) PG8_BAR;
        { int le_; asm volatile("v_mbcnt_lo_u32_b32 %0, -1, 0\n\tv_mbcnt_hi_u32_b32 %0, -1, %0" : "=v"(le_));
          E(acc, cur, wr, wc, le_ & 15, le_ >> 4); }
        if (!has_next) break;
#pragma unroll
        for (int a = 0; a < 2; ++a)
#pragma unroll
            for (int b = 0; b < 2; ++b)
#pragma unroll
                for (int m = 0; m < 4; ++m)
#pragma unroll
                    for (int n = 0; n < 2; ++n) acc[a][b][m][n] = (f32x4){0.f, 0.f, 0.f, 0.f};
        cur = nxt; cA = nA; cB = nB; ++ui;
        if constexpr (GATHER) cbuf = nbuf;
        if (wr == 1) PG8_BAR;
    }
    PG8_WAIT_V(0);
    PG8_BAR;
#undef PG8_SA
#undef PG8_SB
#undef PG8_STAGE
#undef PG8_STAGE_A
#undef PG8_GI
#undef PG8_GIDX_DMA
#undef PG8_LDA
#undef PG8_LDB
#undef PG8_MMA
#undef PG8_LD8
#undef PG8_WAIT_V
#undef PG8_WAIT_L
#undef PG8_BAR
#undef PG8_SCHED
}
}

#define XB_TMO      128
#define XB_XCNT(j)  (256  + 64 * (j))
#define XB_XSUB(j)  (1280 + 64 * (j))
#define XB_XGEN(j)  (2304 + 64 * (j))
#define XB_TOP      3328
#define XB_TOPGEN   3392
#define XCD_BAR_WORDS 3456
#define XB_SPIN_CAP (1u << 18)
__device__ __forceinline__ unsigned xb_ld(unsigned* p)              { return __hip_atomic_load(p, __ATOMIC_RELAXED, __HIP_MEMORY_SCOPE_AGENT); }
__device__ __forceinline__ unsigned xb_add(unsigned* p, unsigned v) { return __hip_atomic_fetch_add(p, v, __ATOMIC_RELAXED, __HIP_MEMORY_SCOPE_AGENT); }
__device__ __forceinline__ unsigned xb_xcc_id() { return (unsigned)__builtin_amdgcn_s_getreg((3 << 11) | 20) & 0xFu; }
#define XB_SPIN(cond, bar) do { unsigned _sp = 0; while (cond) { __builtin_amdgcn_s_sleep(1); \
    if ((++_sp & 255u) == 0u) { if (xb_ld(&(bar)[XB_TMO])) break; if (_sp > XB_SPIN_CAP) { atomicAdd(&(bar)[XB_TMO], 1u); break; } } } } while (0)
struct XcdBarrier { unsigned* bar; unsigned x; volatile LAS unsigned* st; };
__device__ __forceinline__ XcdBarrier xcd_barrier_post(unsigned* bar, volatile LAS unsigned* st, bool t0) {
    XcdBarrier b; b.bar = bar; b.x = xb_xcc_id(); b.st = st;
    if (t0) (void)xb_add(&bar[XB_XCNT(b.x)], 1u);
    return b;
}
__device__ __forceinline__ void xcd_barrier_complete(unsigned* bar, unsigned x, unsigned& nloc, unsigned& nx) {
    const unsigned G = gridDim.x * gridDim.y * gridDim.z;
    unsigned sum, cnt, mine, sp = 0u;
    for (;;) {
        sum = 0u; cnt = 0u; mine = 0u;
#pragma unroll
        for (unsigned j = 0; j < 16; ++j) { const unsigned c = xb_ld(&bar[XB_XCNT(j)]); sum += c; cnt += (c > 0u) ? 1u : 0u; mine = (j == x) ? c : mine; }
        if (sum == G) break;
        __builtin_amdgcn_s_sleep(1);
        if ((++sp & 255u) == 0u) { if (xb_ld(&bar[XB_TMO])) break; if (sp > XB_SPIN_CAP) { atomicAdd(&bar[XB_TMO], 1u); break; } }
    }
    nloc = mine > 0u ? mine : 1u; nx = cnt > 0u ? cnt : 1u;
}
__device__ __forceinline__ void xcd_barrier(const XcdBarrier& b, bool t0) {
    asm volatile("s_waitcnt vmcnt(0)" ::: "memory");
    __syncthreads();
    if (t0) {
        unsigned* bar = b.bar;
        __builtin_amdgcn_s_waitcnt(0);
        unsigned nloc = b.st[0], nx = b.st[1];
        if (nloc == 0u) { xcd_barrier_complete(bar, b.x, nloc, nx); b.st[0] = nloc; b.st[1] = nx; }
        const unsigned old = xb_add(&bar[XB_XSUB(b.x)], 1u);
        const unsigned gen = old / nloc;
        if (old + 1u == (gen + 1u) * nloc) {
            __builtin_amdgcn_fence(__ATOMIC_RELEASE, "agent");
            asm volatile("s_waitcnt vmcnt(0)" ::: "memory");
            const unsigned og = xb_add(&bar[XB_TOP], 1u);
            const unsigned tg = og / nx;
            if (og + 1u == (tg + 1u) * nx) xb_add(&bar[XB_TOPGEN], 1u);
            else XB_SPIN(xb_ld(&bar[XB_TOPGEN]) == tg, bar);
            __builtin_amdgcn_fence(__ATOMIC_ACQUIRE, "agent");
            xb_add(&bar[XB_XGEN(b.x)], 1u);
            asm volatile("s_waitcnt vmcnt(0)" ::: "memory");
        } else {
            XB_SPIN(xb_ld(&bar[XB_XGEN(b.x)]) == gen, bar);
            __builtin_amdgcn_fence(__ATOMIC_ACQUIRE, "agent");
            asm volatile("s_waitcnt vmcnt(0)" ::: "memory");
        }
    }
    __syncthreads();
}

struct Args { const float* in[19]; float* out; unsigned char* ws; int ph_lo, ph_hi; };
enum { IN_X = 0, IN_C, IN_CTX, IN_CCTX, IN_WMOD, IN_BMOD, IN_G1, IN_G2, IN_WIN, IN_WOUT, IN_CONVW, IN_CONVB, IN_GATEB, IN_GHEAD, IN_WROUTER, IN_WGATE, IN_WUP, IN_WDOWN, IN_GFINAL };

__device__ __forceinline__ void ph_prologue(const Args& a, LAS unsigned char* lds, int vcu, int G, int tid, int wave, int lane) {
    unsigned char* ws = a.ws;
    bf16* wg = (bf16*)(ws + WS_WG); bf16* wrt = (bf16*)(ws + WS_WR);
    const float* w_in = a.in[IN_WIN]; const float* w_router = a.in[IN_WROUTER];
    for (int i = vcu * 512 + tid; i < 2 * 16 * 1024; i += G * 512) { const int L = i >> 14, j = (i >> 10) & 15, k = i & 1023;
        wg[i] = (bf16)(cvt_pk_bf16(w_in[((size_t)L * 1024 + k) * DPROJ + NG + j], 0.f) & 0xffffu);
        wrt[i] = (bf16)(cvt_pk_bf16(w_router[((size_t)L * 1024 + k) * NE + j], 0.f) & 0xffffu); }
    LAS float* sv = (LAS float*)lds;
    LAS float* red = (LAS float*)(lds + 9 * 1024 * 4);
    const float* c = a.in[IN_C]; const float* cctx = a.in[IN_CCTX];
    for (int i = tid; i < 9 * 1024; i += 512) { const int g = i >> 10, k = i & 1023; const float v = g < 8 ? c[g * 1024 + k] : cctx[k]; sv[i] = v / (1.0f + __expf(-v)); }
    __syncthreads();
    const float* w_mod = a.in[IN_WMOD]; const float* b_mod = a.in[IN_BMOD]; float* modv = (float*)(ws + WS_MODV);
    for (int item = vcu; item < 2 * 96; item += G) {
        const int L = item / 96, cb = item % 96, col = cb * 64 + lane;
        float acc[9];
#pragma unroll
        for (int g = 0; g < 9; ++g) acc[g] = 0.f;
        for (int k0 = 0; k0 < 128; k0 += 32) { float wv[32];
#pragma unroll
            for (int kk = 0; kk < 32; ++kk) wv[kk] = w_mod[((size_t)L * 1024 + wave * 128 + k0 + kk) * 6144 + col];
#pragma unroll
            for (int kk = 0; kk < 32; ++kk) { const int k = wave * 128 + k0 + kk;
#pragma unroll
                for (int g = 0; g < 9; ++g) acc[g] += sv[g * 1024 + k] * wv[kk]; } }
#pragma unroll
        for (int g = 0; g < 9; ++g) red[(wave * 9 + g) * 64 + lane] = acc[g];
        __syncthreads();
        for (int o = tid; o < 9 * 64; o += 512) { const int g = o >> 6, l = o & 63; float s = b_mod[L * 6144 + cb * 64 + l];
#pragma unroll
            for (int w = 0; w < 8; ++w) s += red[(w * 9 + g) * 64 + l];
            modv[(size_t)(L * 9 + g) * 6144 + cb * 64 + l] = s; }
        __syncthreads();
    }
}

__device__ __forceinline__ void transpose_item(const float* src, int ld, int k0, int n0, bf16* dst, int dstK, int row0, float scale, LAS float* scr, int lane) {
    float ld32[32];
#pragma unroll
    for (int i = 0; i < 32; ++i) { const int kk = 2 * i + (lane >> 5); ld32[i] = __builtin_nontemporal_load(src + (size_t)(k0 + kk) * ld + n0 + (lane & 31)); }
#pragma unroll
    for (int i = 0; i < 32; ++i) { const int kk = 2 * i + (lane >> 5); scr[kk * 33 + (lane & 31)] = ld32[i] * scale; }
    LDS_WAIT(); asm volatile("" ::: "memory");
    const int c = lane & 7;
#pragma unroll
    for (int j = 0; j < 4; ++j) { const int n = (lane >> 3) + 8 * j; const LAS float* s = scr + (8 * c) * 33 + n;
        u32x4 o; o.x = cvt_pk_bf16(s[0 * 33], s[1 * 33]); o.y = cvt_pk_bf16(s[2 * 33], s[3 * 33]); o.z = cvt_pk_bf16(s[4 * 33], s[5 * 33]); o.w = cvt_pk_bf16(s[6 * 33], s[7 * 33]);
        *(u32x4*)(dst + (size_t)(row0 + n) * dstK + k0 + 8 * c) = o; }
    LDS_WAIT(); asm volatile("" ::: "memory");
}
__device__ __forceinline__ void transpose_item_f8(const float* src, int ld, int k0, int n0, unsigned char* dst, int dstK, int row0, float scale, LAS float* scr, int lane) {
    float ld32[32];
#pragma unroll
    for (int i = 0; i < 32; ++i) { const int kk = 2 * i + (lane >> 5); ld32[i] = __builtin_nontemporal_load(src + (size_t)(k0 + kk) * ld + n0 + (lane & 31)); }
#pragma unroll
    for (int i = 0; i < 32; ++i) { const int kk = 2 * i + (lane >> 5); scr[kk * 33 + (lane & 31)] = ld32[i] * scale; }
    LDS_WAIT(); asm volatile("" ::: "memory");
    const int c = lane & 3;
#pragma unroll
    for (int j = 0; j < 2; ++j) { const int n = (lane >> 2) + 16 * j; const LAS float* s = scr + (16 * c) * 33 + n;
        u32x4 o; o.x = cvt4_fp8(s[0 * 33], s[1 * 33], s[2 * 33], s[3 * 33]); o.y = cvt4_fp8(s[4 * 33], s[5 * 33], s[6 * 33], s[7 * 33]);
        o.z = cvt4_fp8(s[8 * 33], s[9 * 33], s[10 * 33], s[11 * 33]); o.w = cvt4_fp8(s[12 * 33], s[13 * 33], s[14 * 33], s[15 * 33]);
        *(u32x4*)(dst + (size_t)(row0 + n) * dstK + k0 + 16 * c) = o; }
    LDS_WAIT(); asm volatile("" ::: "memory");
}
__device__ __forceinline__ void ph_convert(const Args& a, int L, LAS unsigned char* lds, int vcu, int G, int wave, int lane) {
    unsigned char* ws = a.ws;
    LAS float* scr = (LAS float*)(lds + wave * 16384);
    const int gw = vcu * 8 + wave, NGW = G * 8;
    constexpr int NI_IN = 16 * 112, NI_OUT = 16 * 32, NI_E = 704, NI_GU = NE * 2 * NI_E, NI_DN = NE * NI_E, NITEMS = NI_IN + NI_OUT + NI_GU + NI_DN;
    for (int it = gw; it < NITEMS; it += NGW) {
        int r = it;
        if (r < NI_IN) { const int kb = r / 112, nb = r % 112, n0 = 32 * nb;
            const int drow = (n0 >= SC_C && n0 < SC_X) ? 512 + 256 * ((n0 - SC_C) >> 7) + ((n0 - SC_C) & 127) : ((n0 >= SC_X && n0 < SC_Q) ? 512 + 256 * ((n0 - SC_X) >> 7) + 128 + ((n0 - SC_X) & 127) : n0);
            transpose_item(a.in[IN_WIN] + (size_t)L * 1024 * DPROJ, DPROJ, 64 * kb, n0, (bf16*)(ws + WS_WIN), 1024, drow, (n0 >= SC_Q && n0 < SC_K) ? 0.08838834764831845f : 1.0f, scr, lane); continue; }
        r -= NI_IN;
        if (r < NI_OUT) { const int kb = r / 32, nb = r % 32;
            transpose_item(a.in[IN_WOUT] + (size_t)L * 1024 * 1024, 1024, 64 * kb, 32 * nb, (bf16*)(ws + WS_WOUT), 1024, 32 * nb, 1.0f, scr, lane); continue; }
        r -= NI_OUT;
        if (r < NI_GU) { const int e = r / (2 * NI_E), rr = r % (2 * NI_E), which = rr / NI_E, q = rr % NI_E, kb = q / 44, nb = q % 44, n0 = 32 * nb;
            const float* src = (which ? a.in[IN_WUP] : a.in[IN_WGATE]) + ((size_t)L * NE + e) * 1024 * DE;
            transpose_item_f8(src, DE, 64 * kb, n0, ws + WS_WGU + (size_t)e * 2816 * 1024, 1024, 256 * (n0 >> 7) + 128 * which + (n0 & 127), F8_W, scr, lane); continue; }
        r -= NI_GU;
        { const int e = r / NI_E, q = r % NI_E, kb = q / 32, nb = q % 32;
            transpose_item_f8(a.in[IN_WDOWN] + ((size_t)L * NE + e) * DE * 1024, 1024, 64 * kb, 32 * nb, ws + WS_WD + (size_t)e * 1024 * DEP, DEP, 32 * nb, F8_W, scr, lane); }
    }
    for (int i = gw * 64 + lane; i < NE * 1024 * 8; i += NGW * 64)
        *(u32x4*)(ws + WS_WD + (size_t)(i >> 3) * DEP + DE + 16 * (i & 7)) = zero4u();
}

__device__ __forceinline__ void row_load(const float* p, int lane, f32x4 (&v)[4]) {
#pragma unroll
    for (int j = 0; j < 4; ++j) v[j] = __builtin_nontemporal_load((const f32x4*)p + lane + 64 * j);
}
__device__ __forceinline__ void row_load_bf(const bf16* p, int lane, f32x4 (&v)[4]) {
#pragma unroll
    for (int j = 0; j < 4; ++j) { const u32x2 w = __builtin_nontemporal_load((const u32x2*)p + lane + 64 * j); v[j] = (f32x4){bf_lo(w.x), bf_hi(w.x), bf_lo(w.y), bf_hi(w.y)}; }
}
__device__ __forceinline__ void row_store_bf(bf16* p, int lane, const f32x4 (&v)[4]) {
#pragma unroll
    for (int j = 0; j < 4; ++j) { u32x2 w; w.x = cvt_pk_bf16(v[j].x, v[j].y); w.y = cvt_pk_bf16(v[j].z, v[j].w); __builtin_nontemporal_store(w, (u32x2*)p + lane + 64 * j); }
}
__device__ __forceinline__ float row_rstd(const f32x4 (&v)[4], int lane) {
    float s = 0.f;
#pragma unroll
    for (int j = 0; j < 4; ++j) s += (v[j].x * v[j].x + v[j].y * v[j].y) + (v[j].z * v[j].z + v[j].w * v[j].w);
    return __builtin_amdgcn_rsqf(wave_sum(s, lane) * (1.0f / D) + EPS);
}
__device__ __forceinline__ void row_mod_store(const f32x4 (&v)[4], float rstd, const float* gn, const float* shift, const float* scale, bf16* hrow, int lane) {
#pragma unroll
    for (int j = 0; j < 4; ++j) { const int c = 4 * lane + 256 * j; const f32x4 g = *(const f32x4*)(gn + c), sh = *(const f32x4*)(shift + c), sc = *(const f32x4*)(scale + c);
        const f32x4 h = v[j] * rstd * g * (sc + 1.0f) + sh;
        u32x2 w; w.x = cvt_pk_bf16(h.x, h.y); w.y = cvt_pk_bf16(h.z, h.w); *(u32x2*)(hrow + c) = w; }
}
constexpr int WT_STRIDE = 2064;
__device__ __forceinline__ void stage_wt(const bf16* wt, LAS unsigned char* lds, int tid) {
    for (int i = tid; i < 16 * 128; i += 512) { const int r = i >> 7, ch = i & 127; *(LAS u32x4*)(lds + r * WT_STRIDE + ch * 16) = *(const u32x4*)(wt + r * 1024 + ch * 8); }
    __syncthreads();
}
template <bool TOKFIRST, bool ROWS8 = false>
__device__ __forceinline__ f32x4 skinny16(const bf16* hrows, LAS unsigned char* wl, int lane) {
    const int r = lane & 15, g = lane >> 4;
    f32x4 acc = (f32x4){0.f, 0.f, 0.f, 0.f};
    const bf16* hp = hrows + (size_t)(ROWS8 ? (r & 7) : r) * 1024 + 8 * g;
    const LAS unsigned char* wp = wl + r * WT_STRIDE + 16 * g;
#pragma unroll
    for (int kb = 0; kb < 2; ++kb) {
        bf16x8 hf[16];
#pragma unroll
        for (int k = 0; k < 16; ++k) hf[k] = __builtin_nontemporal_load((const bf16x8*)(hp + 32 * (kb * 16 + k)));
#pragma unroll
        for (int k = 0; k < 16; ++k) { const bf16x8 wf = *(const LAS bf16x8*)(wp + 64 * (kb * 16 + k));
            acc = TOKFIRST ? __builtin_amdgcn_mfma_f32_16x16x32_bf16(hf[k], wf, acc, 0, 0, 0) : __builtin_amdgcn_mfma_f32_16x16x32_bf16(wf, hf[k], acc, 0, 0, 0); }
    }
    return acc;
}

__device__ __forceinline__ int row_cond(int row) { return row < NLAT ? (row >> 13) : 8; }

__device__ __forceinline__ void gates_store(const f32x4 acc, const float* gate_b_l, float* gates, int row0, int lane, int nrows = 16) {
    const int fq = lane >> 4; const f32x4 gb = *(const f32x4*)(gate_b_l + 4 * fq);
    if ((lane & 15) < nrows) *(f32x4*)(gates + (size_t)(row0 + (lane & 15)) * 16 + 4 * fq) = acc + gb;
}
__device__ __forceinline__ void router_store(const f32x4 acc, float* afft, int row0, int lane, int nrows = 16) {
    f32x4 mx = acc;
#pragma unroll
    for (int o = 1; o < 16; o <<= 1) { f32x4 t; t.x = shx(mx.x, o, lane); t.y = shx(mx.y, o, lane); t.z = shx(mx.z, o, lane); t.w = shx(mx.w, o, lane);
        mx.x = fmaxf(mx.x, t.x); mx.y = fmaxf(mx.y, t.y); mx.z = fmaxf(mx.z, t.z); mx.w = fmaxf(mx.w, t.w); }
    f32x4 ex; ex.x = __expf(acc.x - mx.x); ex.y = __expf(acc.y - mx.y); ex.z = __expf(acc.z - mx.z); ex.w = __expf(acc.w - mx.w);
    f32x4 sm = ex;
#pragma unroll
    for (int o = 1; o < 16; o <<= 1) { f32x4 t; t.x = shx(sm.x, o, lane); t.y = shx(sm.y, o, lane); t.z = shx(sm.z, o, lane); t.w = shx(sm.w, o, lane); sm = sm + t; }
    f32x4 o4; o4.x = ex.x / sm.x; o4.y = ex.y / sm.y; o4.z = ex.z / sm.z; o4.w = ex.w / sm.w;
    if (4 * (lane >> 4) < nrows) *(f32x4*)(afft + (size_t)(lane & 15) * NTOK + row0 + 4 * (lane >> 4)) = o4;
}

struct ModRegs { f32x4 gs[4], sh[4]; };
__device__ __forceinline__ ModRegs mod_load(const float* gn, const float* shift, const float* scale, int lane) {
    ModRegs m;
#pragma unroll
    for (int j = 0; j < 4; ++j) { const int c = 4 * lane + 256 * j; m.gs[j] = *(const f32x4*)(gn + c) * (*(const f32x4*)(scale + c) + 1.0f); m.sh[j] = *(const f32x4*)(shift + c); }
    return m;
}
template <bool F8 = false, bool LROW = false>
__device__ __forceinline__ void row_mod_store2(const f32x4 (&v)[4], float rstd, const ModRegs& m, bf16* hrow, int lane, unsigned char* h8row = nullptr, LAS unsigned char* lrow = nullptr) {
#pragma unroll
    for (int j = 0; j < 4; ++j) { const f32x4 h = v[j] * rstd * m.gs[j] + m.sh[j];
        u32x2 w; w.x = cvt_pk_bf16(h.x, h.y); w.y = cvt_pk_bf16(h.z, h.w); *(u32x2*)(hrow + 4 * lane + 256 * j) = w;
        if (LROW) *(LAS u32x2*)(lrow + 8 * lane + 512 * j) = w;
        if (F8) { const f32x4 hs = h * F8_H; *(unsigned*)(h8row + 4 * lane + 256 * j) = cvt4_fp8(hs.x, hs.y, hs.z, hs.w); } }
}
template <bool SRC_BF, bool F8 = false>
__device__ __forceinline__ void rows16_norm(const void* src, bf16* hdst, bf16* xcopy, const ModRegs& m, int lane, unsigned char* h8dst = nullptr) {
    f32x4 va[4][4], vb[4][4];
#define R16_LOAD(dst, r0) do { _Pragma("unroll") for (int q = 0; q < 4; ++q) { if (SRC_BF) row_load_bf((const bf16*)src + (size_t)((r0) + q) * D, lane, dst[q]); else row_load((const float*)src + (size_t)((r0) + q) * D, lane, dst[q]); } } while (0)
#define R16_PROC(vv, r0) do { _Pragma("unroll") for (int q = 0; q < 4; ++q) { if (!SRC_BF) row_store_bf(xcopy + (size_t)((r0) + q) * D, lane, vv[q]); \
        const float rstd = row_rstd(vv[q], lane); row_mod_store2<F8>(vv[q], rstd, m, hdst + (size_t)((r0) + q) * D, lane, F8 ? h8dst + (size_t)((r0) + q) * D : nullptr); } } while (0)
    R16_LOAD(va, 0); R16_LOAD(vb, 4); R16_PROC(va, 0); R16_LOAD(va, 8); R16_PROC(vb, 4); R16_LOAD(vb, 12); R16_PROC(va, 8); R16_PROC(vb, 12);
#undef R16_LOAD
#undef R16_PROC
}

constexpr int RB_STRIDE = 2112;
template <bool TOKFIRST>
__device__ __forceinline__ f32x4 skinny4_lds(const LAS unsigned char* rb, const LAS unsigned char* wl, int lane) {
    const LAS unsigned char* hp = rb + (lane & 3) * RB_STRIDE + 16 * (lane >> 4); const LAS unsigned char* wp = wl + (lane & 15) * WT_STRIDE + 16 * (lane >> 4);
    f32x4 ab = {0.f, 0.f, 0.f, 0.f};
#pragma unroll 1
    for (int kb = 0; kb < 4; ++kb) { bf16x8 hf[8], wf[8];
#pragma unroll
        for (int k = 0; k < 8; ++k) { hf[k] = *(const LAS bf16x8*)(hp + 512 * kb + 64 * k); wf[k] = *(const LAS bf16x8*)(wp + 512 * kb + 64 * k); }
#pragma unroll
        for (int k = 0; k < 8; ++k) ab = TOKFIRST ? __builtin_amdgcn_mfma_f32_16x16x32_bf16(hf[k], wf[k], ab, 0, 0, 0) : __builtin_amdgcn_mfma_f32_16x16x32_bf16(wf[k], hf[k], ab, 0, 0, 0); }
    return ab;
}
__device__ __forceinline__ f32x4 rows16_norm_router(const bf16* src, unsigned char* h8dst, const ModRegs& m, LAS unsigned char* rb, LAS unsigned char* wl, int lane) {
    f32x4 va[4][4], vb[4][4]; f32x4 acc = {0.f, 0.f, 0.f, 0.f};
#define R16_LOAD(dst, r0) do { _Pragma("unroll") for (int q = 0; q < 4; ++q) row_load_bf(src + (size_t)((r0) + q) * D, lane, dst[q]); } while (0)
#define R16_PROC(vv, r0, b) do { _Pragma("unroll") for (int q = 0; q < 4; ++q) { const float rstd = row_rstd(vv[q], lane); \
        _Pragma("unroll") for (int j = 0; j < 4; ++j) { const f32x4 h = vv[q][j] * rstd * m.gs[j] + m.sh[j]; u32x2 w; w.x = cvt_pk_bf16(h.x, h.y); w.y = cvt_pk_bf16(h.z, h.w); \
            *(LAS u32x2*)(rb + q * RB_STRIDE + 8 * lane + 512 * j) = w; const f32x4 hs = h * F8_H; *(unsigned*)(h8dst + (size_t)((r0) + q) * D + 4 * lane + 256 * j) = cvt4_fp8(hs.x, hs.y, hs.z, hs.w); } } \
        LDS_WAIT(); const f32x4 ab = skinny4_lds<true>(rb, wl, lane); if ((lane >> 4) == (b)) acc = ab; LDS_WAIT(); } while (0)
    R16_LOAD(va, 0); R16_LOAD(vb, 4); R16_PROC(va, 0, 0); R16_LOAD(va, 8); R16_PROC(vb, 4, 1); R16_LOAD(vb, 12); R16_PROC(va, 8, 2); R16_PROC(vb, 12, 3);
#undef R16_LOAD
#undef R16_PROC
    return acc;
}
__device__ __forceinline__ f32x4 rows16_norm_gates(const float* src, bf16* hdst, bf16* xcopy, const ModRegs& m, LAS unsigned char* rb, LAS unsigned char* wl, int lane) {
    f32x4 va[4][4], vb[4][4]; f32x4 acc = {0.f, 0.f, 0.f, 0.f};
#define R16_LOAD(dst, r0) do { _Pragma("unroll") for (int q = 0; q < 4; ++q) row_load(src + (size_t)((r0) + q) * D, lane, dst[q]); } while (0)
#define R16_PROC(vv, r0, b) do { _Pragma("unroll") for (int q = 0; q < 4; ++q) { row_store_bf(xcopy + (size_t)((r0) + q) * D, lane, vv[q]); const float rstd = row_rstd(vv[q], lane); \
        _Pragma("unroll") for (int j = 0; j < 4; ++j) { const f32x4 h = vv[q][j] * rstd * m.gs[j] + m.sh[j]; u32x2 w; w.x = cvt_pk_bf16(h.x, h.y); w.y = cvt_pk_bf16(h.z, h.w); \
            *(LAS u32x2*)(rb + q * RB_STRIDE + 8 * lane + 512 * j) = w; *(u32x2*)(hdst + (size_t)((r0) + q) * D + 4 * lane + 256 * j) = w; } } \
        LDS_WAIT(); const f32x4 ab = skinny4_lds<false>(rb, wl, lane); if (((lane & 15) >> 2) == (b)) acc = ab; LDS_WAIT(); } while (0)
    R16_LOAD(va, 0); R16_LOAD(vb, 4); R16_PROC(va, 0, 0); R16_LOAD(va, 8); R16_PROC(vb, 4, 1); R16_LOAD(vb, 12); R16_PROC(va, 8, 2); R16_PROC(vb, 12, 3);
#undef R16_LOAD
#undef R16_PROC
    return acc;
}

template <bool SRC_BF, bool F8 = false>
__device__ __forceinline__ void row1_norm(const void* src, bf16* hdst, bf16* xcopy, const ModRegs& m, int lane, unsigned char* h8dst = nullptr) {
    f32x4 v[4];
    if (SRC_BF) row_load_bf((const bf16*)src, lane, v); else { row_load((const float*)src, lane, v); row_store_bf(xcopy, lane, v); }
    const float rstd = row_rstd(v, lane); row_mod_store2<F8>(v, rstd, m, hdst, lane, h8dst);
}

__device__ __forceinline__ void ph_prepass1_l0(const Args& a, LAS unsigned char* lds, int vcu, int G, int tid, int wave, int lane) {
    unsigned char* ws = a.ws; const int L = 0;
    LAS unsigned char* wl = lds;
    stage_wt((const bf16*)(ws + WS_WG) + (size_t)L * 16 * 1024, wl, tid);
    const float* modv = (const float*)(ws + WS_MODV) + (size_t)L * 9 * 6144; const float* gn = a.in[IN_G1] + L * 1024;
    bf16* H = (bf16*)a.out; float* gates = (float*)(ws + WS_GATES);
    for (int grp = vcu * 8 + wave; grp < NLAT / 16; grp += G * 8) {
        const int row0 = grp * 16, g = row_cond(row0);
        const float* src = a.in[IN_X] + (size_t)row0 * D;
        const ModRegs m = mod_load(gn, modv + g * 6144 + 0 * 1024, modv + g * 6144 + 1 * 1024, lane);
        const f32x4 acc = rows16_norm_gates(src, H + (size_t)row0 * D, (bf16*)(ws + WS_XB) + (size_t)row0 * D, m, lds + 34816 + wave * (4 * RB_STRIDE), wl, lane);
        gates_store(acc, a.in[IN_GATEB] + L * 16, gates, row0, lane);
    }
    for (int blk = vcu; blk < NCTX / 8; blk += G) {
        const int row0 = NLAT + 8 * blk, row = row0 + wave;
        const ModRegs m = mod_load(gn, modv + 8 * 6144 + 0 * 1024, modv + 8 * 6144 + 1 * 1024, lane);
        row1_norm<false>(a.in[IN_CTX] + (size_t)(row - NLAT) * D, H + (size_t)row * D, (bf16*)(ws + WS_XC) + (size_t)(row - NLAT) * D, m, lane);
        VM_WAIT(); __syncthreads();
        if (wave == 0) { const f32x4 acc = skinny16<false, true>(H + (size_t)row0 * D, wl, lane); gates_store(acc, a.in[IN_GATEB] + L * 16, gates, row0, lane, 8); }
    }
}

__device__ __forceinline__ void ph_prepass2(const Args& a, int L, LAS unsigned char* lds, int vcu, int G, int tid, int wave, int lane) {
    unsigned char* ws = a.ws;
    LAS unsigned char* wl = lds;
    stage_wt((const bf16*)(ws + WS_WR) + (size_t)L * 16 * 1024, wl, tid);
    const float* modv = (const float*)(ws + WS_MODV) + (size_t)L * 9 * 6144; const float* gn = a.in[IN_G2] + L * 1024;
    bf16* H = (bf16*)a.out; unsigned char* H8 = (unsigned char*)a.out + OUT_H8; float* afft = (float*)(ws + WS_AFFT);
    for (int grp = vcu * 8 + wave; grp < NLAT / 16; grp += G * 8) {
        const int row0 = grp * 16, g = row_cond(row0);
        const bf16* src = (const bf16*)(ws + WS_XB) + (size_t)row0 * D;
        const ModRegs m = mod_load(gn, modv + g * 6144 + 3 * 1024, modv + g * 6144 + 4 * 1024, lane);
        const f32x4 acc = rows16_norm_router(src, H8 + (size_t)row0 * D, m, lds + 34816 + wave * (4 * RB_STRIDE), wl, lane);
        router_store(acc, afft, row0, lane);
    }
    if (L == 0) for (int blk = vcu; blk < NCTX / 8; blk += G) {
        const int row0 = NLAT + 8 * blk, row = row0 + wave;
        const ModRegs m = mod_load(gn, modv + 8 * 6144 + 3 * 1024, modv + 8 * 6144 + 4 * 1024, lane);
        row1_norm<true, true>((const bf16*)(ws + WS_XC) + (size_t)(row - NLAT) * D, H + (size_t)row * D, nullptr, m, lane, H8 + (size_t)row * D);
        VM_WAIT(); __syncthreads();
        if (wave == 0) { const f32x4 acc = skinny16<true, true>(H + (size_t)row0 * D, wl, lane); router_store(acc, afft, row0, lane, 8); }
    }
}

template <int NR, bool LROW = false>
__device__ __forceinline__ void combine_rows(bf16* xs, bf16* hrows, float* orows, bool last, const int4 iv, int rbase, unsigned long long sel, unsigned long long sel1, unsigned long long sel2, unsigned long long sel3,
                                             const unsigned char* ye, const float* gsel, const f32x4 (&g2)[4], const ModRegs& m, int lane, LAS unsigned char* lrows = nullptr) {
    f32x4 v[NR][4];
#pragma unroll
    for (int q = 0; q < NR; ++q) row_load_bf(xs + (size_t)q * D, lane, v[q]);
    unsigned em[NR];
#pragma unroll
    for (int q = 0; q < NR; ++q) { const int rr = rbase + q; unsigned mk = 0u;
#pragma unroll
        for (int c = 0; c < 4; ++c) { const int ln = 4 * rr + c;
            mk |= (unsigned)((sel >> ln) & 1ull) << (4 * c) | (unsigned)((sel1 >> ln) & 1ull) << (4 * c + 1) | (unsigned)((sel2 >> ln) & 1ull) << (4 * c + 2) | (unsigned)((sel3 >> ln) & 1ull) << (4 * c + 3); }
        em[q] = mk; }
    f32x4 s[NR][4];
#pragma unroll
    for (int q = 0; q < NR; ++q)
#pragma unroll
        for (int j = 0; j < 4; ++j) s[q][j] = (f32x4){0.f, 0.f, 0.f, 0.f};
    {
        unsigned w[NR][4][4]; float gw[NR][4]; int nq[NR];
#pragma unroll
        for (int q = 0; q < NR; ++q) { const int rr = rbase + q; nq[q] = (int)__builtin_popcount(em[q]);
#pragma unroll
            for (int k4 = 0; k4 < 4; ++k4) if (k4 < nq[q]) { const int e = (int)__builtin_ctz(em[q]); em[q] &= em[q] - 1u;
                const int ln = 4 * rr + (e >> 2), k = e & 3;
                const int cand = k == 0 ? iv.x : (k == 1 ? iv.y : (k == 2 ? iv.z : iv.w));
                const int slot = shi(cand, ln);
                const unsigned char* yr = ye + (size_t)slot * D; gw[q][k4] = gsel[slot];
#pragma unroll
                for (int j = 0; j < 4; ++j) w[q][k4][j] = __builtin_nontemporal_load((const unsigned*)(yr + 4 * lane + 256 * j)); } }
#pragma unroll
        for (int q = 0; q < NR; ++q)
#pragma unroll
            for (int k4 = 0; k4 < 4; ++k4) if (k4 < nq[q]) {
#pragma unroll
                for (int j = 0; j < 4; ++j) { const f32x2 lo = __builtin_amdgcn_cvt_pk_f32_fp8((int)w[q][k4][j], false), hi = __builtin_amdgcn_cvt_pk_f32_fp8((int)w[q][k4][j], true);
                    s[q][j].x += gw[q][k4] * lo.x; s[q][j].y += gw[q][k4] * lo.y; s[q][j].z += gw[q][k4] * hi.x; s[q][j].w += gw[q][k4] * hi.y; } }
    }
    unsigned any = 0u;
#pragma unroll
    for (int q = 0; q < NR; ++q) any |= em[q];
    while (any) {
        unsigned w[NR][4]; float wt[NR];
#pragma unroll
        for (int q = 0; q < NR; ++q) { const int rr = rbase + q; int e = em[q] ? (int)__builtin_ctz(em[q]) : 0; wt[q] = em[q] ? 1.0f : 0.0f; em[q] &= em[q] - 1u;
            const int ln = 4 * rr + (e >> 2), k = e & 3;
            const int cand = k == 0 ? iv.x : (k == 1 ? iv.y : (k == 2 ? iv.z : iv.w));
            int slot = shi(cand, ln); slot = slot < 0 ? 0 : slot; wt[q] *= gsel[slot];
            const unsigned char* yr = ye + (size_t)slot * D;
#pragma unroll
            for (int j = 0; j < 4; ++j) w[q][j] = *(const unsigned*)(yr + 4 * lane + 256 * j); }
#pragma unroll
        for (int q = 0; q < NR; ++q)
#pragma unroll
            for (int j = 0; j < 4; ++j) { const f32x2 lo = __builtin_amdgcn_cvt_pk_f32_fp8((int)w[q][j], false), hi = __builtin_amdgcn_cvt_pk_f32_fp8((int)w[q][j], true);
                s[q][j].x += wt[q] * lo.x; s[q][j].y += wt[q] * lo.y; s[q][j].z += wt[q] * hi.x; s[q][j].w += wt[q] * hi.y; }
        any = 0u;
#pragma unroll
        for (int q = 0; q < NR; ++q) any |= em[q];
    }
#pragma unroll
    for (int q = 0; q < NR; ++q) {
#pragma unroll
        for (int j = 0; j < 4; ++j) v[q][j] = v[q][j] + g2[j] * s[q][j];
        const float rstd = row_rstd(v[q], lane);
        if (last) { float* orow = orows + (size_t)q * D;
#pragma unroll
            for (int j = 0; j < 4; ++j) __builtin_nontemporal_store(v[q][j] * rstd * m.gs[j], (f32x4*)orow + lane + 64 * j);
        } else {
            row_store_bf(xs + (size_t)q * D, lane, v[q]);
            row_mod_store2<false, LROW>(v[q], rstd, m, hrows + (size_t)q * D, lane, nullptr, LROW ? lrows + q * RB_STRIDE : nullptr);
        }
    }
}
__device__ __forceinline__ void ph_combine(const Args& a, int L, LAS unsigned char* lds, int vcu, int G, int tid, int wave, int lane) {
    unsigned char* ws = a.ws; const bool last = (L == DEPTH - 1);
    LAS unsigned char* wl = lds;
    if (!last) stage_wt((const bf16*)(ws + WS_WG) + (size_t)(L + 1) * 16 * 1024, wl, tid);
    const float* modv = (const float*)(ws + WS_MODV) + (size_t)L * 9 * 6144;
    const float* modn = (const float*)(ws + WS_MODV) + (size_t)(L + 1 < DEPTH ? L + 1 : L) * 9 * 6144;
    const float* gn = last ? a.in[IN_GFINAL] : a.in[IN_G1] + (L + 1) * 1024;
    bf16* H = (bf16*)a.out; float* gates = (float*)(ws + WS_GATES);
    const unsigned char* ye = ws + WS_XE; const float* gsel = (const float*)(ws + WS_GSEL); const int* inv = (const int*)(ws + WS_INV);
    for (int grp = vcu * 8 + wave; grp < NLAT / 16; grp += G * 8) {
        const int row0 = grp * 16, g = row_cond(row0);
        bf16* xs = (bf16*)(ws + WS_XB) + (size_t)row0 * D;
        const int4 iv = *(const int4*)(inv + (size_t)row0 * 16 + 4 * lane);
        ModRegs m; f32x4 g2[4];
#pragma unroll
        for (int j = 0; j < 4; ++j) g2[j] = *(const f32x4*)(modv + g * 6144 + 5 * 1024 + 4 * lane + 256 * j) * (1.0f / F8_YE);
        if (last) {
#pragma unroll
            for (int j = 0; j < 4; ++j) { m.gs[j] = *(const f32x4*)(gn + 4 * lane + 256 * j); m.sh[j] = (f32x4){0.f, 0.f, 0.f, 0.f}; }
        } else m = mod_load(gn, modn + g * 6144 + 0 * 1024, modn + g * 6144 + 1 * 1024, lane);
        const unsigned long long sel = __ballot(iv.x >= 0), sel1 = __ballot(iv.y >= 0), sel2 = __ballot(iv.z >= 0), sel3 = __ballot(iv.w >= 0);
        LAS unsigned char* rb = lds + 34816 + wave * (4 * RB_STRIDE);
        f32x4 acc = {0.f, 0.f, 0.f, 0.f};
#pragma unroll 1
        for (int r = 0; r < 16; r += 2) {
            combine_rows<2, true>(xs + (size_t)r * D, H + (size_t)(row0 + r) * D, a.out + (size_t)(row0 + r) * D, last, iv, r, sel, sel1, sel2, sel3, ye, gsel, g2, m, lane, rb + (r & 2) * RB_STRIDE);
            if (!last && (r & 2)) { LDS_WAIT(); const f32x4 ab = skinny4_lds<false>(rb, wl, lane); if (((lane & 15) >> 2) == (r >> 2)) acc = ab; LDS_WAIT(); } }
        if (!last) gates_store(acc, a.in[IN_GATEB] + (L + 1) * 16, gates, row0, lane);
    }
    if (!last) for (int blk = vcu; blk < NCTX / 8; blk += G) {
        const int row0 = NLAT + 8 * blk, row = row0 + wave;
        const int4 iv = *(const int4*)(inv + (size_t)row * 16 + 4 * (lane & 3));
        f32x4 g2[4];
#pragma unroll
        for (int j = 0; j < 4; ++j) g2[j] = *(const f32x4*)(modv + 8 * 6144 + 5 * 1024 + 4 * lane + 256 * j) * (1.0f / F8_YE);
        const ModRegs m = mod_load(gn, modn + 8 * 6144 + 0 * 1024, modn + 8 * 6144 + 1 * 1024, lane);
        const unsigned long long sel = __ballot(iv.x >= 0), sel1 = __ballot(iv.y >= 0), sel2 = __ballot(iv.z >= 0), sel3 = __ballot(iv.w >= 0);
        combine_rows<1>((bf16*)(ws + WS_XC) + (size_t)(row - NLAT) * D, H + (size_t)row * D, nullptr, false, iv, 0, sel, sel1, sel2, sel3, ye, gsel, g2, m, lane);
        VM_WAIT(); __syncthreads();
        if (wave == 0) { const f32x4 acc = skinny16<false, true>(H + (size_t)row0 * D, wl, lane); gates_store(acc, a.in[IN_GATEB] + (L + 1) * 16, gates, row0, lane, 8); }
    }
}

__device__ __forceinline__ unsigned img_off(unsigned row, unsigned ch) { return 256u * row + 16u * (ch ^ (((row & 3u) << 2) | ((row >> 2) & 3u))); }
__device__ __forceinline__ unsigned img_off_r(unsigned row, unsigned ch) { return 256u * row + 16u * (ch ^ (row & 15u)); }
__device__ __forceinline__ bf16x8 frag_rowr(const LAS unsigned char* img, int lane, int rb, int s) { return *(const LAS bf16x8*)(img + img_off_r((unsigned)((lane & 15) + 16 * rb), (unsigned)(4 * s + (lane >> 4)))); }
__device__ __forceinline__ bf16x8 frag_row(const LAS unsigned char* img, int lane, int rb, int s) { return *(const LAS bf16x8*)(img + img_off((unsigned)((lane & 15) + 16 * rb), (unsigned)(4 * s + (lane >> 4)))); }
__device__ __forceinline__ bf16x8 frag_tr(const LAS unsigned char* img, int lane, int c, int ks) {
    const unsigned g = (unsigned)lane >> 4, q = ((unsigned)lane & 15u) >> 2, p = (unsigned)lane & 3u;
    const s16x4 lo = __builtin_amdgcn_ds_read_tr16_b64_v4i16((LAS s16x4*)(img + img_off(32u * ks + 8u * g + q, 2u * c + (p >> 1)) + 8u * (p & 1u)));
    const s16x4 hi = __builtin_amdgcn_ds_read_tr16_b64_v4i16((LAS s16x4*)(img + img_off(32u * ks + 8u * g + 4u + q, 2u * c + (p >> 1)) + 8u * (p & 1u)));
    return __builtin_shufflevector(lo, hi, 0, 1, 2, 3, 4, 5, 6, 7);
}
__device__ __forceinline__ int chunk_row0(int b, int c) { return c < NCH_C ? NLAT + b * CTXL + c * 128 : b * SEQ + (c - NCH_C) * 128; }
__device__ __forceinline__ int state_idx(int b, int h, int c, int d) { return ((b * NH + h) * NCH + c) * 2 + d; }

struct GateScan { float b0, b1, g0, g1, cm0, cm1, B, G; };
__device__ __forceinline__ float logsigmoid(float x) { return fminf(x, 0.f) - log1pf(__expf(-fabsf(x))); }
__device__ __forceinline__ GateScan gate_scan(int d, int lane, float i0, float i1, float f0, float f1) {
    GateScan o; const float l0 = logsigmoid(f0), l1 = logsigmoid(f1);
    float inc = l0 + l1;
    if (d == 0) {
#pragma unroll
        for (int s = 1; s < 64; s <<= 1) { const float t = shup(inc, s, lane); if (lane >= s) inc += t; }
        o.b1 = inc; o.b0 = inc - l1; o.B = rdl(inc, 63);
    } else {
#pragma unroll
        for (int s = 1; s < 64; s <<= 1) { const float t = shdn(inc, s, lane); if (lane + s < 64) inc += t; }
        o.b0 = inc; o.b1 = inc - l0; o.B = rdl(inc, 0);
    }
    o.g0 = i0 - o.b0; o.g1 = i1 - o.b1;
    float pm = fmaxf(o.g0, o.g1);
    if (d == 0) {
#pragma unroll
        for (int s = 1; s < 64; s <<= 1) { const float t = shup(pm, s, lane); if (lane >= s) pm = fmaxf(pm, t); }
        float pe = shup(pm, 1, lane); if (lane == 0) pe = -INFINITY;
        o.cm0 = fmaxf(pe, o.g0); o.cm1 = fmaxf(o.cm0, o.g1); o.G = rdl(pm, 63);
    } else {
#pragma unroll
        for (int s = 1; s < 64; s <<= 1) { const float t = shdn(pm, s, lane); if (lane + s < 64) pm = fmaxf(pm, t); }
        float pe = shdn(pm, 1, lane); if (lane == 63) pe = -INFINITY;
        o.cm1 = fmaxf(pe, o.g1); o.cm0 = fmaxf(o.cm1, o.g0); o.G = rdl(pm, 0);
    }
    return o;
}
__device__ __forceinline__ u32x4 scale_bf8(u32x4 v, float w) {
    u32x4 o; o.x = cvt_pk_bf16(bf_lo(v.x) * w, bf_hi(v.x) * w); o.y = cvt_pk_bf16(bf_lo(v.y) * w, bf_hi(v.y) * w); o.z = cvt_pk_bf16(bf_lo(v.z) * w, bf_hi(v.z) * w); o.w = cvt_pk_bf16(bf_lo(v.w) * w, bf_hi(v.w) * w); return o;
}

__device__ __forceinline__ void ph_mlstm_a(const Args& a, LAS unsigned char* lds, int vcu, int G, int tid, int wave, int lane) {
    unsigned char* ws = a.ws;
    const bf16* U = (const bf16*)(ws + WS_U); const float* gates = (const float*)(ws + WS_GATES);
    bf16* CS = (bf16*)(ws + WS_CS); float* NS = (float*)(ws + WS_NS); float* SCAL = (float*)(ws + WS_SCAL);
    LAS unsigned char* imgV = lds; LAS unsigned char* imgK0 = lds + 32768; LAS unsigned char* imgK1 = lds + 65536;
    LAS float* wtab = (LAS float*)(lds + TAB_OFF);
    const int wr4 = wave >> 1, wc2 = wave & 1, fr = lane & 15, fq = lane >> 4;
    constexpr int NUNITS = NB * NH * NCH;
    u32x4 kreg[4], vreg[4]; float pgi0 = 0.f, pgi1 = 0.f, pgf0 = 0.f, pgf1 = 0.f;
#define MA_DECODE(uu, b_, h_, c_, row0_) const int b_ = ((uu) & 31) >> 2, h_ = (uu) & 3, c_ = (uu) >> 5, row0_ = chunk_row0(b_, c_)
#define MA_PREFETCH(uu) do { MA_DECODE(uu, pb_, ph_, pc_, prow0_); (void)pb_; (void)pc_; \
        _Pragma("unroll") for (int i = 0; i < 4; ++i) { const int id = tid + 512 * i, r = id >> 4, ch = id & 15; const bf16* rp = U + (size_t)(prow0_ + r) * NU + 128 * ph_ + 8 * ch; \
            kreg[i] = __builtin_nontemporal_load((const u32x4*)(rp + UC_K)); vreg[i] = __builtin_nontemporal_load((const u32x4*)(rp + UC_V)); } \
        if (wave < 2) { const float* gp = gates + (size_t)(prow0_ + 2 * lane) * 16 + ph_; pgi0 = gp[(2 * wave) * 4]; pgi1 = gp[16 + (2 * wave) * 4]; pgf0 = gp[(2 * wave + 1) * 4]; pgf1 = gp[16 + (2 * wave + 1) * 4]; } } while (0)
    if (vcu < NUNITS) MA_PREFETCH(vcu);
    for (int u = vcu; u < NUNITS; u += G) {
        MA_DECODE(u, b, h, c, row0); (void)row0;
        if (wave < 2) { const int d = wave, t0 = 2 * lane;
            const GateScan gs = gate_scan(d, lane, pgi0, pgi1, pgf0, pgf1);
            wtab[d * 128 + t0] = fexp(gs.g0 - gs.G); wtab[d * 128 + t0 + 1] = fexp(gs.g1 - gs.G);
            if (lane == 0) { float* sc = SCAL + (size_t)state_idx(b, h, c, d) * 4; sc[0] = gs.B; sc[1] = gs.B + gs.G; } }
        __syncthreads();
#pragma unroll
        for (int i = 0; i < 4; ++i) { const int id = tid + 512 * i, r = id >> 4, ch = id & 15; const unsigned o = img_off((unsigned)r, (unsigned)ch);
            *(LAS u32x4*)(imgV + o) = vreg[i]; *(LAS u32x4*)(imgK0 + o) = scale_bf8(kreg[i], wtab[r]); *(LAS u32x4*)(imgK1 + o) = scale_bf8(kreg[i], wtab[128 + r]); }
        if (u + G < NUNITS) MA_PREFETCH(u + G);
        __syncthreads();
        f32x4 acc[2][2][4];
#pragma unroll
        for (int d = 0; d < 2; ++d)
#pragma unroll
            for (int mi = 0; mi < 2; ++mi)
#pragma unroll
                for (int ni = 0; ni < 4; ++ni) acc[d][mi][ni] = (f32x4){0.f, 0.f, 0.f, 0.f};
#pragma unroll 1
        for (int ks = 0; ks < 4; ++ks) {
            bf16x8 vf[2];
#pragma unroll
            for (int mi = 0; mi < 2; ++mi) vf[mi] = frag_tr(imgV, lane, 2 * wr4 + mi, ks);
#pragma unroll
            for (int d = 0; d < 2; ++d)
#pragma unroll
                for (int ni = 0; ni < 4; ++ni) { const bf16x8 kf = frag_tr(d ? imgK1 : imgK0, lane, 4 * wc2 + ni, ks);
#pragma unroll
                    for (int mi = 0; mi < 2; ++mi) acc[d][mi][ni] = __builtin_amdgcn_mfma_f32_16x16x32_bf16(kf, vf[mi], acc[d][mi][ni], 0, 0, 0); }
        }
        {
            const int d = tid >> 8, kd = (tid & 255) >> 1, half = tid & 1; const LAS unsigned char* im = d ? imgK1 : imgK0; float s = 0.f;
            for (int t = 0; t < 64; ++t) { const int sr = 64 * half + t; s += __uint_as_float((unsigned)(*(const LAS unsigned short*)(im + img_off((unsigned)sr, (unsigned)(kd >> 3)) + 2 * (kd & 7))) << 16); }
            s += shx(s, 1, lane);
            if (half == 0) NS[(size_t)state_idx(b, h, c, d) * 128 + kd] = s;
        }
#pragma unroll
        for (int d = 0; d < 2; ++d) { bf16* cs = CS + (size_t)state_idx(b, h, c, d) * 16384;
#pragma unroll
            for (int mi = 0; mi < 2; ++mi)
#pragma unroll
                for (int ni = 0; ni < 4; ++ni) { const int vd = 32 * wr4 + 16 * mi + fr, kd0 = 64 * wc2 + 16 * ni + 4 * fq; const f32x4 v = acc[d][mi][ni];
                    u32x2 w; w.x = cvt_pk_bf16(v[0], v[1]); w.y = cvt_pk_bf16(v[2], v[3]); *(u32x2*)(cs + vd * 128 + kd0) = w; } }
        __syncthreads();
    }
}

#undef MA_DECODE
#undef MA_PREFETCH
__device__ __forceinline__ int scan_chunk(int d, int p) { return d == 0 ? p : (p < NCH_C ? NCH_C - 1 - p : NCH + NCH_C - 1 - p); }
__device__ __forceinline__ void ph_scan(const Args& a, LAS unsigned char* lds, int vcu, int G, int tid) {
    unsigned char* ws = a.ws;
    bf16* CS = (bf16*)(ws + WS_CS); float* NS = (float*)(ws + WS_NS); float* SCAL = (float*)(ws + WS_SCAL);
    LAS float* coef = (LAS float*)lds;
    const int lane = tid & 63;
    for (int w0 = vcu * 512; w0 < NB * NH * 2 * 2048; w0 += G * 512) {
        const int seq = w0 >> 11, d = seq & 1, bh = seq >> 1, chunk = (w0 & 2047) + tid;
        if (tid < 64) {
            const int p1 = lane + 64; const bool has1 = p1 < NCH;
            float* sc0 = SCAL + (size_t)((bh * NCH + scan_chunk(d, lane)) * 2 + d) * 4;
            float* sc1 = SCAL + (size_t)((bh * NCH + scan_chunk(d, has1 ? p1 : 0)) * 2 + d) * 4;
            const float B0 = sc0[0], ml0 = sc0[1], B1 = sc1[0], ml1 = sc1[1];
            float m = 0.f, ca0 = 0.f, cb0 = 0.f, mp0 = 0.f, ca1 = 0.f, cb1 = 0.f, mp1 = 0.f;
            for (int p = 0; p < NCH; ++p) { const float B = p < 64 ? rdl(B0, p) : rdl(B1, p - 64), ml = p < 64 ? rdl(ml0, p) : rdl(ml1, p - 64);
                const float mn = fmaxf(B + m, ml), ca = fexp(B + m - mn), cb = fexp(ml - mn);
                if (lane == (p & 63)) { if (p < 64) { ca0 = ca; cb0 = cb; mp0 = m; } else { ca1 = ca; cb1 = cb; mp1 = m; } }
                m = mn; }
            coef[2 * lane] = ca0; coef[2 * lane + 1] = cb0; if (has1) { coef[2 * p1] = ca1; coef[2 * p1 + 1] = cb1; }
            if ((w0 & 2047) == 0) { sc0[2] = mp0; if (has1) sc1[2] = mp1; }
        }
        __syncthreads();
        float st[8];
#pragma unroll
        for (int j = 0; j < 8; ++j) st[j] = 0.f;
        u32x4* base = (u32x4*)(CS + (size_t)(bh * NCH) * 2 * 16384) + chunk;
#define SCAN_PTR(p) (base + (size_t)(scan_chunk(d, (p)) * 2 + d) * 2048)
#define SCAN_STEP(reg, p) do { const u32x4 dc = reg; if ((p) + 6 < NCH) reg = *SCAN_PTR((p) + 6); \
            u32x4 o; o.x = cvt_pk_bf16(st[0], st[1]); o.y = cvt_pk_bf16(st[2], st[3]); o.z = cvt_pk_bf16(st[4], st[5]); o.w = cvt_pk_bf16(st[6], st[7]); *SCAN_PTR(p) = o; \
            const float ca = coef[2 * (p)], cb = coef[2 * (p) + 1]; \
            st[0] = ca * st[0] + cb * bf_lo(dc.x); st[1] = ca * st[1] + cb * bf_hi(dc.x); st[2] = ca * st[2] + cb * bf_lo(dc.y); st[3] = ca * st[3] + cb * bf_hi(dc.y); \
            st[4] = ca * st[4] + cb * bf_lo(dc.z); st[5] = ca * st[5] + cb * bf_hi(dc.z); st[6] = ca * st[6] + cb * bf_lo(dc.w); st[7] = ca * st[7] + cb * bf_hi(dc.w); } while (0)
        u32x4 r0 = *SCAN_PTR(0), r1 = *SCAN_PTR(1), r2 = *SCAN_PTR(2), r3 = *SCAN_PTR(3), r4 = *SCAN_PTR(4), r5 = *SCAN_PTR(5);
        for (int p = 0; p < NCH; p += 6) { SCAN_STEP(r0, p); SCAN_STEP(r1, p + 1); SCAN_STEP(r2, p + 2); SCAN_STEP(r3, p + 3); SCAN_STEP(r4, p + 4); SCAN_STEP(r5, p + 5); }
#undef SCAN_STEP
#undef SCAN_PTR
        if ((w0 & 2047) == 0 && tid < 128) {
            float* nb = NS + (size_t)(bh * NCH) * 2 * 128 + tid;
#define NPTR(p) (nb + (size_t)(scan_chunk(d, (p)) * 2 + d) * 128)
#define NSTEP(reg, p) do { const float dn = reg; if ((p) + 6 < NCH) reg = *NPTR((p) + 6); *NPTR(p) = sn; sn = coef[2 * (p)] * sn + coef[2 * (p) + 1] * dn; } while (0)
            float sn = 0.f, n0 = *NPTR(0), n1 = *NPTR(1), n2 = *NPTR(2), n3 = *NPTR(3), n4 = *NPTR(4), n5 = *NPTR(5);
            for (int p = 0; p < NCH; p += 6) { NSTEP(n0, p); NSTEP(n1, p + 1); NSTEP(n2, p + 2); NSTEP(n3, p + 3); NSTEP(n4, p + 4); NSTEP(n5, p + 5); }
#undef NSTEP
#undef NPTR
        }
        __syncthreads();
    }
}

__device__ __forceinline__ void ph_mlstm_c2(const Args& a, int L, LAS unsigned char* lds, int vcu, int G, int tid, int wave, int lane) {
    unsigned char* ws = a.ws;
    const bf16* U = (const bf16*)(ws + WS_U); const float* gates = (const float*)(ws + WS_GATES);
    const bf16* CS = (const bf16*)(ws + WS_CS); const float* NS = (const float*)(ws + WS_NS); const float* SCAL = (const float*)(ws + WS_SCAL);
    bf16* H = (bf16*)a.out; const float* ghead = a.in[IN_GHEAD] + L * NH * DH;
    LAS unsigned char* imgK = lds; LAS unsigned char* imgV = lds + 32768; LAS unsigned char* imgC0 = lds + 65536; LAS unsigned char* imgC1 = lds + 65536 + 36864;
    LAS float* T_A = (LAS float*)(lds + 139264); LAS float* T_B = T_A + 256; LAS float* T_WI = T_B + 256; LAS float* T_FL = T_WI + 256;
    const int fr = lane & 15, fq = lane >> 4, t_loc = 16 * wave + fr;
    if (tid >= 16 && tid < 256) { const unsigned o = img_off_r((unsigned)(128 + (tid >> 4)), (unsigned)(tid & 15)); const u32x4 z = {0u, 0u, 0u, 0u}; *(LAS u32x4*)(imgC0 + o) = z; *(LAS u32x4*)(imgC1 + o) = z; }
    const int c_lo = (L == DEPTH - 1) ? NCH_C : 0, nunits = NB * NH * (NCH - c_lo);
    u32x4 pk[4], pv[4], pcf[4], pcb[4]; bf16x8 pq[4]; float pgi0 = 0.f, pgi1 = 0.f, pgf0 = 0.f, pgf1 = 0.f, pmp = 0.f; f32x4 pn0 = (f32x4){0.f, 0.f, 0.f, 0.f}, pn1 = (f32x4){0.f, 0.f, 0.f, 0.f};
#define C2_DECODE(uu, b_, h_, c_, row0_) const int b_ = ((uu) & 31) >> 2, h_ = (uu) & 3, c_ = c_lo + ((uu) >> 5), row0_ = chunk_row0(b_, c_)
#define C2_PRE1(uu) do { C2_DECODE(uu, pb_, ph_, pc_, prow0_); \
        _Pragma("unroll") for (int i = 0; i < 4; ++i) { const int id = tid + 512 * i; pk[i] = *(const u32x4*)(U + (size_t)(prow0_ + (id >> 4)) * NU + 128 * ph_ + 8 * (id & 15) + UC_K); } \
        _Pragma("unroll") for (int ks = 0; ks < 4; ++ks) pq[ks] = *(const bf16x8*)(U + (size_t)(prow0_ + t_loc) * NU + UC_Q + 128 * ph_ + 32 * ks + 8 * fq); \
        if (wave < 2) { const float* gp = gates + (size_t)(prow0_ + 2 * lane) * 16 + ph_; pgi0 = gp[(2 * wave) * 4]; pgi1 = gp[16 + (2 * wave) * 4]; pgf0 = gp[(2 * wave + 1) * 4]; pgf1 = gp[16 + (2 * wave + 1) * 4]; \
            pmp = SCAL[(size_t)(state_idx(pb_, ph_, pc_, 0) + wave) * 4 + 2]; } } while (0)
#define C2_PRE2(uu) do { C2_DECODE(uu, pb_, ph_, pc_, prow0_); const int psi_ = state_idx(pb_, ph_, pc_, 0); \
        _Pragma("unroll") for (int i = 0; i < 4; ++i) { const int id = tid + 512 * i; pv[i] = *(const u32x4*)(U + (size_t)(prow0_ + (id >> 4)) * NU + 128 * ph_ + 8 * (id & 15) + UC_V); \
            pcf[i] = *((const u32x4*)(CS + (size_t)psi_ * 16384) + id); pcb[i] = *((const u32x4*)(CS + (size_t)(psi_ + 1) * 16384) + id); } \
        if (tid < 32) { const float* np = NS + (size_t)(psi_ + (tid >> 4)) * 128 + 8 * (tid & 15); pn0 = *(const f32x4*)np; pn1 = *(const f32x4*)(np + 4); } } while (0)
    for (int u = vcu; u < nunits; u += G) {
        C2_DECODE(u, b, h, c, row0); (void)b; (void)c;
        C2_PRE1(u); C2_PRE2(u);
        if (wave < 2) { const int d = wave, t0 = 2 * lane;
            const GateScan gs = gate_scan(d, lane, pgi0, pgi1, pgf0, pgf1);
            const float M0 = fmaxf(pmp, gs.cm0), M1 = fmaxf(pmp, gs.cm1);
            T_A[d * 128 + t0] = fexp(gs.g0 - gs.G); T_A[d * 128 + t0 + 1] = fexp(gs.g1 - gs.G);
            T_B[d * 128 + t0] = fexp(gs.G - M0); T_B[d * 128 + t0 + 1] = fexp(gs.G - M1);
            T_WI[d * 128 + t0] = fexp(pmp - M0); T_WI[d * 128 + t0 + 1] = fexp(pmp - M1);
            T_FL[d * 128 + t0] = fexp(-(gs.b0 + M0)); T_FL[d * 128 + t0 + 1] = fexp(-(gs.b1 + M1)); }
#pragma unroll
        for (int i = 0; i < 4; ++i) { const int id = tid + 512 * i; *(LAS u32x4*)(imgK + img_off_r((unsigned)(id >> 4), (unsigned)(id & 15))) = pk[i]; }
        bf16x8 qf[4];
#pragma unroll
        for (int ks = 0; ks < 4; ++ks) qf[ks] = pq[ks];
#define QSEL(ks) ((ks) == 0 ? qf[0] : ((ks) == 1 ? qf[1] : ((ks) == 2 ? qf[2] : qf[3])))
        __syncthreads();
        f32x4 S[8];
#pragma unroll
        for (int ni = 0; ni < 8; ++ni) S[ni] = (f32x4){0.f, 0.f, 0.f, 0.f};
#pragma unroll 1
        for (int ks = 0; ks < 4; ++ks)
            { const bf16x8 qk = QSEL(ks);
#pragma unroll
              for (int ni = 0; ni < 8; ++ni) { const bf16x8 kf = frag_rowr(imgK, lane, ni, ks); S[ni] = __builtin_amdgcn_mfma_f32_16x16x32_bf16(kf, qk, S[ni], 0, 0, 0); } }
#pragma unroll
        for (int i = 0; i < 4; ++i) { const int id = tid + 512 * i; const unsigned r = (unsigned)(id >> 4), ch = (unsigned)(id & 15);
            *(LAS u32x4*)(imgV + img_off(r, ch)) = pv[i]; *(LAS u32x4*)(imgC0 + img_off_r(r, ch)) = pcf[i]; *(LAS u32x4*)(imgC1 + img_off_r(r, ch)) = pcb[i]; }
        if (tid < 32) { u32x4 w; w.x = cvt_pk_bf16(pn0[0], pn0[1]); w.y = cvt_pk_bf16(pn0[2], pn0[3]); w.z = cvt_pk_bf16(pn1[0], pn1[1]); w.w = cvt_pk_bf16(pn1[2], pn1[3]);
            *(LAS u32x4*)(((tid >> 4) ? imgC1 : imgC0) + img_off_r(128u, (unsigned)(tid & 15))) = w; }
        __syncthreads();
        f32x4 hs[8]; u32x2 ow4[8];
#pragma unroll
        for (int ni = 0; ni < 8; ++ni) hs[ni] = (f32x4){0.f, 0.f, 0.f, 0.f};
#pragma unroll
        for (int d = 0; d < 2; ++d) {
            const LAS unsigned char* imgC = d ? imgC1 : imgC0;
            const float Bt = T_B[d * 128 + t_loc], wi = T_WI[d * 128 + t_loc]; float rs = 0.f;
#pragma unroll
            for (int ni = 0; ni < 8; ++ni) { const int s0 = 16 * ni + 4 * fq; const f32x4 a4 = *(const LAS f32x4*)(T_A + d * 128 + s0); float sp[4];
#pragma unroll
                for (int j = 0; j < 4; ++j) { const int sidx = s0 + j; const bool ok = d == 0 ? (sidx <= t_loc) : (sidx >= t_loc); const float w = ok ? a4[j] * Bt : 0.f; sp[j] = S[ni][j] * w; rs += sp[j]; }
                u32x2 w2; w2.x = cvt_pk_bf16(sp[0], sp[1]); w2.y = cvt_pk_bf16(sp[2], sp[3]);
                *(LAS u32x2*)(imgK + img_off_r((unsigned)t_loc, (unsigned)(s0 >> 3)) + 2 * (s0 & 7)) = w2; }
            rs += shx(rs, 16, lane); rs += shx(rs, 32, lane);
            asm volatile("s_waitcnt lgkmcnt(0)" ::: "memory");
            f32x4 acc[9];
#pragma unroll
            for (int ni = 0; ni < 9; ++ni) acc[ni] = (f32x4){0.f, 0.f, 0.f, 0.f};
#pragma unroll 1
            for (int ks = 0; ks < 4; ++ks)
                { const bf16x8 qk = QSEL(ks);
#pragma unroll
                  for (int ni = 0; ni < 9; ++ni) { const bf16x8 cf = frag_rowr(imgC, lane, ni, ks); acc[ni] = __builtin_amdgcn_mfma_f32_16x16x32_bf16(cf, qk, acc[ni], 0, 0, 0); } }
            float qn = (acc[8][0] + acc[8][1]) + (acc[8][2] + acc[8][3]); qn += shx(qn, 16, lane); qn += shx(qn, 32, lane);
#pragma unroll
            for (int ni = 0; ni < 8; ++ni) acc[ni] = acc[ni] * wi;
#pragma unroll 1
            for (int ks = 0; ks < 4; ++ks) { const bf16x8 sf = frag_rowr(imgK, lane, wave, ks);
#pragma unroll
                for (int ni = 0; ni < 8; ++ni) { const bf16x8 vf = frag_tr(imgV, lane, ni, ks); acc[ni] = __builtin_amdgcn_mfma_f32_16x16x32_bf16(vf, sf, acc[ni], 0, 0, 0); } }
            const float den = wi * qn + rs, rinv = __builtin_amdgcn_rcpf(fmaxf(fabsf(den), T_FL[d * 128 + t_loc]));
#pragma unroll
            for (int ni = 0; ni < 8; ++ni) hs[ni] = hs[ni] + acc[ni] * rinv;
            if (d == 0) {
#pragma unroll
                for (int ni = 0; ni < 8; ++ni) ow4[ni] = *(const u32x2*)(U + (size_t)(row0 + t_loc) * NU + UC_O + 128 * h + 16 * ni + 4 * fq); }
        }
        float ss = 0.f;
#pragma unroll
        for (int ni = 0; ni < 8; ++ni) { const f32x4 v = hs[ni]; ss += (v[0] * v[0] + v[1] * v[1]) + (v[2] * v[2] + v[3] * v[3]); }
        ss += shx(ss, 16, lane); ss += shx(ss, 32, lane);
        const float rstd = __builtin_amdgcn_rsqf(ss * (1.0f / DH) + EPS);
#pragma unroll
        for (int ni = 0; ni < 8; ++ni) { const int vd0 = 16 * ni + 4 * fq; const u32x2 ow = ow4[ni];
            const f32x4 gh = *(const f32x4*)(ghead + h * DH + vd0); const f32x4 v = hs[ni];
            const float o0 = bf_lo(ow.x), o1 = bf_hi(ow.x), o2 = bf_lo(ow.y), o3 = bf_hi(ow.y);
            const float y0 = v[0] * rstd * gh[0] * __builtin_amdgcn_rcpf(1.0f + fexp(-o0)), y1 = v[1] * rstd * gh[1] * __builtin_amdgcn_rcpf(1.0f + fexp(-o1)), y2 = v[2] * rstd * gh[2] * __builtin_amdgcn_rcpf(1.0f + fexp(-o2)), y3 = v[3] * rstd * gh[3] * __builtin_amdgcn_rcpf(1.0f + fexp(-o3));
            u32x2 w; w.x = cvt_pk_bf16(y0, y1); w.y = cvt_pk_bf16(y2, y3);
            *(u32x2*)(H + (size_t)(row0 + t_loc) * D + 512 + 128 * h + vd0) = w; }
        __syncthreads();
    }
#undef QSEL
#undef C2_DECODE
#undef C2_PRE1
#undef C2_PRE2
}

__device__ __forceinline__ void ph_conv(const Args& a, int L, int vcu, int G, int wave, int lane) {
    unsigned char* ws = a.ws; const bf16* U = (const bf16*)(ws + WS_U); bf16* H = (bf16*)a.out;
    const float* cw = a.in[IN_CONVW] + L * 3 * 512 + 8 * lane; const float* cbp = a.in[IN_CONVB] + L * 512 + 8 * lane;
    float w0[8], w1[8], w2[8], bb[8];
#pragma unroll
    for (int e = 0; e < 8; ++e) { w0[e] = cw[e]; w1[e] = cw[512 + e]; w2[e] = cw[1024 + e]; bb[e] = cbp[e]; }
    const int nrows = (L == DEPTH - 1) ? NLAT : NTOK;
    for (int rowb = vcu * 8 + wave; rowb < nrows; rowb += G * 8 * 4) {
        u32x4 bv[4], c0[4], cl[4], cr[4];
#pragma unroll
        for (int i = 0; i < 4; ++i) { const int row = rowb + i * G * 8; const bool act = row < nrows; const int rw = act ? row : rowb;
            bool lv, rv; if (rw < NLAT) { const int t = rw & 63; lv = t != 0; rv = t != 63; } else { const int t = (rw - NLAT) & 255; lv = t != 0; rv = t != 255; }
            const bf16* rp = U + (size_t)rw * NU + 8 * lane;
            const u32x4 zb = {0u, 0u, 0u, 0u};
            bv[i] = *(const u32x4*)(rp + UC_B); c0[i] = *(const u32x4*)(rp + UC_CX);
            cl[i] = lv ? *(const u32x4*)(rp - NU + UC_CX) : zb;
            cr[i] = rv ? *(const u32x4*)(rp + NU + UC_CX) : zb; }
#pragma unroll
        for (int i = 0; i < 4; ++i) { const int row = rowb + i * G * 8;
            float y[8];
#pragma unroll
            for (int q = 0; q < 4; ++q) {
                y[2 * q] = bf_lo(bv[i][q]) * (w0[2 * q] * bf_lo(cl[i][q]) + w1[2 * q] * bf_lo(c0[i][q]) + w2[2 * q] * bf_lo(cr[i][q]) + bb[2 * q]);
                y[2 * q + 1] = bf_hi(bv[i][q]) * (w0[2 * q + 1] * bf_hi(cl[i][q]) + w1[2 * q + 1] * bf_hi(c0[i][q]) + w2[2 * q + 1] * bf_hi(cr[i][q]) + bb[2 * q + 1]); }
            u32x4 o; o.x = cvt_pk_bf16(y[0], y[1]); o.y = cvt_pk_bf16(y[2], y[3]); o.z = cvt_pk_bf16(y[4], y[5]); o.w = cvt_pk_bf16(y[6], y[7]);
            if (row < nrows) *(u32x4*)(H + (size_t)row * D + 8 * lane) = o; }
    }
}

__device__ __forceinline__ int block_sum(int v, LAS int* sh, int& par, int wave, int lane) {
    if (lane == 0) sh[par * 8 + wave] = v;
    __syncthreads();
    int s = 0;
#pragma unroll
    for (int w = 0; w < 8; ++w) s += sh[par * 8 + w];
    par ^= 1;
    return s;
}
__device__ __forceinline__ int block_excl_scan(int v, int& total, LAS int* sh, int& par, int wave, int lane) {
    int inc = v;
#pragma unroll
    for (int s = 1; s < 64; s <<= 1) { const int t = shi(inc, lane >= s ? lane - s : lane); if (lane >= s) inc += t; }
    if (lane == 63) sh[par * 8 + wave] = inc;
    __syncthreads();
    int pre = 0, tot = 0;
#pragma unroll
    for (int w = 0; w < 8; ++w) { const int x = sh[par * 8 + w]; tot += x; if (w < wave) pre += x; }
    par ^= 1; total = tot;
    return pre + inc - v;
}
__device__ __forceinline__ void ph_topk(const Args& a, int L, LAS unsigned char* lds, int vcu, int G, int tid, int wave, int lane) {
    unsigned char* ws = a.ws; const float* afft = (const float*)(ws + WS_AFFT);
    int* idx = (int*)(ws + WS_IDX); float* gsel = (float*)(ws + WS_GSEL); int* inv = (int*)(ws + WS_INV);
    LAS int* sh = (LAS int*)lds; int par = 0;
    const int nitems = (L == 0) ? 256 : 128;
    for (int item = vcu; item < nitems; item += G) {
        const bool lat = item < 128; const int b = (item & 127) >> 4, e = item & 15;
        const int n = lat ? SEQ : CTXL, k = lat ? CAP_L : CAP_C, tok0 = lat ? b * SEQ : NLAT + b * CTXL;
        const int slot0 = lat ? (e * NB + b) * CAP_L : NSLOT_L + (e * NB + b) * CAP_C;
        const float* av = afft + (size_t)e * NTOK + tok0;
        unsigned v[16];
        if (tid * 16 < n) {
#pragma unroll
            for (int q = 0; q < 4; ++q) { const f32x4 x = *(const f32x4*)(av + tid * 16 + 4 * q); v[4 * q] = __float_as_uint(x.x); v[4 * q + 1] = __float_as_uint(x.y); v[4 * q + 2] = __float_as_uint(x.z); v[4 * q + 3] = __float_as_uint(x.w); }
        } else {
#pragma unroll
            for (int j = 0; j < 16; ++j) v[j] = 0u;
        }
        unsigned T = 0u;
        for (int bit = 30; bit >= 0; --bit) { const unsigned cand = T | (1u << bit); int cnt = 0;
#pragma unroll
            for (int j = 0; j < 16; ++j) cnt += (int)__popcll(__ballot(v[j] >= cand));
            if (block_sum(cnt, sh, par, wave, lane) >= k) T = cand; }
        int gtc = 0, eqc = 0;
#pragma unroll
        for (int j = 0; j < 16; ++j) { gtc += (v[j] > T) ? 1 : 0; eqc += (v[j] == T) ? 1 : 0; }
        int tot_gt, tot_eq;
        (void)block_excl_scan(gtc, tot_gt, sh, par, wave, lane);
        int eq_before = block_excl_scan(eqc, tot_eq, sh, par, wave, lane);
        const int need_eq = k - tot_gt;
        unsigned selmask = 0u; int nsel = 0;
#pragma unroll
        for (int j = 0; j < 16; ++j) { bool s = v[j] > T; if (v[j] == T) { s = eq_before < need_eq; ++eq_before; } if (s) { selmask |= 1u << j; ++nsel; } }
        int tot_sel; int pos = block_excl_scan(nsel, tot_sel, sh, par, wave, lane);
        if (tid * 16 < n) {
#pragma unroll
            for (int j = 0; j < 16; ++j) { const int tok = tok0 + tid * 16 + j;
                if (selmask & (1u << j)) { const int slot = slot0 + pos; ++pos; idx[slot] = tok; gsel[slot] = __uint_as_float(v[j]); inv[(size_t)tok * 16 + e] = slot; }
                else inv[(size_t)tok * 16 + e] = -1; }
        }
    }
}
constexpr int PH_PER_LAYER = 12, N_PHASES = 1 + DEPTH * PH_PER_LAYER;
__global__ void __launch_bounds__(512, 2) mk_fwd(Args args) {
    extern __shared__ __attribute__((aligned(16))) unsigned char lds_raw[];
    LAS unsigned char* lds = (LAS unsigned char*)lds_raw;
    const int tid0 = threadIdx.x;
    const int G = gridDim.x; const int bx = blockIdx.x; const int vcu = (G % 8 == 0) ? (bx % 8) * (G / 8) + bx / 8 : bx;
    volatile LAS unsigned* MISC = (volatile LAS unsigned*)(lds + MISC_OFF);
    if (tid0 < 64) MISC[tid0] = 0u;
    __syncthreads();
    const int wv0 = __builtin_amdgcn_readfirstlane(tid0 >> 6);
#define LANE0() ({ int l_; asm volatile("v_mbcnt_lo_u32_b32 %0, -1, 0\n\tv_mbcnt_hi_u32_b32 %0, -1, %0" : "=v"(l_)); l_; })
    XcdBarrier bar = xcd_barrier_post((unsigned*)(args.ws + WS_CTL) + 4096, MISC + 8, tid0 == 0);
    const int lo = args.ph_lo, hi = args.ph_hi;
#define CAS __attribute__((address_space(4)))
#define OPQ() const CAS Args* ap_ = (const CAS Args*)__builtin_amdgcn_kernarg_segment_ptr(); asm volatile("" : "+s"(ap_)); Args A; \
    _Pragma("unroll") for (int i_ = 0; i_ < 19; ++i_) A.in[i_] = (const float*)(const GAS float*)(ap_->in[i_]); \
    A.out = (float*)(GAS float*)(ap_->out); A.ws = (unsigned char*)(GAS unsigned char*)(ap_->ws); A.ph_lo = 0; A.ph_hi = 0; unsigned char* ws = A.ws; (void)ws; \
    int tid = wv0 * 64 + LANE0(); asm volatile("" : "+v"(tid)); const int lane = tid & 63, wave = __builtin_amdgcn_readfirstlane(tid >> 6); (void)lane; (void)wave
#ifndef MK_PHMASK
#define MK_PHMASK 0x1fff
#endif
#define EN(p) (((MK_PHMASK) >> (p)) & 1)
#ifndef MK_REPMASK
#define MK_REPMASK 0
#endif
#define REP(p) for (int rep_ = 0; rep_ <= (((MK_REPMASK) >> (p)) & 1); ++rep_, __syncthreads())
#define IN(k) (lo <= (k) && (k) < hi)
#ifndef MK_STAMP
#define MK_STAMP 0
#endif
#ifndef MK_STAMP_A
#define MK_STAMP_A 4
#define MK_STAMP_B 12
#endif
#define SEAM(k) do { if (IN(k) && IN((k) + 1)) { { XcdBarrier b2_ = bar; asm volatile("" : "+s"(b2_.bar), "+s"(b2_.x)); xcd_barrier(b2_, wv0 == 0 && LANE0() == 0); } if (((MK_REPMASK) >> 14) & 1) xcd_barrier(bar, wv0 == 0 && LANE0() == 0); if (MK_STAMP && blockIdx.x == 0 && wv0 == 0 && LANE0() == 0 && (k) < 32) ((unsigned long long*)(args.ws + 524288))[(k)] = __builtin_amdgcn_s_memrealtime(); } } while (0)
    if (EN(12) && IN(0)) REP(12) { OPQ(); ph_prologue(A, lds, vcu, G, tid, wave, lane); __syncthreads(); ph_convert(A, 0, lds, vcu, G, wave, lane); }
    SEAM(0);
    for (int L = 0; L < DEPTH; ++L) {
        const int pb = 1 + L * PH_PER_LAYER;
        if (EN(0) && IN(pb + 0)) REP(0) { OPQ(); if (L == 0) ph_prepass1_l0(A, lds, vcu, G, tid, wave, lane); else ph_convert(A, L, lds, vcu, G, wave, lane); }
        SEAM(pb + 0);
        if (EN(1) && IN(pb + 1)) REP(1) { OPQ(); pg8::Gemm g{(const bf16*)A.out, (const bf16*)(ws + WS_WIN), 1024}; pg8::Sched S; S.init(NTOK / 256, NG / 256, G, bx, 0);
            pg8::EpiU E{(bf16*)(ws + WS_U), NU}; pg8::gemm_phase<pg8::EpiU>(lds, g, S, E, tid); }
        SEAM(pb + 1);
        if (EN(2) && IN(pb + 2)) REP(2) { OPQ(); ph_mlstm_a(A, lds, vcu, G, tid, wave, lane); }
        SEAM(pb + 2);
        if (EN(3) && IN(pb + 3)) REP(3) { OPQ(); ph_scan(A, lds, vcu, G, tid); }
        SEAM(pb + 3);
        if (EN(4) && IN(pb + 4)) REP(4) { OPQ(); for (int r2_ = 0; r2_ <= (((MK_REPMASK) >> 15) & 1); ++r2_) ph_mlstm_c2(A, L, lds, vcu, G, tid, wave, lane); for (int r3_ = 0; r3_ <= (((MK_REPMASK) >> 16) & 1); ++r3_) ph_conv(A, L, vcu, G, wave, lane); }
        SEAM(pb + 4);
        if (EN(5) && IN(pb + 5)) for (int rep_ = 0; rep_ <= ((((MK_REPMASK) >> 13) & 1) && L == 0 ? 1 : 0); ++rep_, __syncthreads()) { OPQ(); pg8::Gemm g{(const bf16*)A.out, (const bf16*)(ws + WS_WOUT), 1024}; pg8::Sched S; S.init((L == DEPTH - 1 ? NLAT : NTOK) / 256, 4, G, bx, 0, 1);
            pg8::EpiRes E{(bf16*)(ws + WS_XB), (bf16*)(ws + WS_XC), (const float*)(ws + WS_MODV) + (size_t)L * 9 * 6144};
            pg8::gemm_phase<pg8::EpiRes>(lds, g, S, E, tid); }
        SEAM(pb + 5);
        if (EN(6) && IN(pb + 6)) REP(6) { OPQ(); ph_prepass2(A, L, lds, vcu, G, tid, wave, lane); }
        SEAM(pb + 6);
        if (EN(7) && IN(pb + 7)) REP(7) { OPQ(); ph_topk(A, L, lds, vcu, G, tid, wave, lane); }
        SEAM(pb + 7);
        if (EN(9) && IN(pb + 9)) REP(9) { OPQ(); pg8::Gemm g{(const bf16*)((const unsigned char*)A.out + OUT_H8), (const bf16*)(ws + WS_WGU), 512}; pg8::Sched S; S.init((L == 0 ? NSLOT : NSLOT_L) / 256, 11, G, bx, 1);
            pg8::EpiGU8 E{ws + WS_HM}; pg8::gemm_phase<pg8::EpiGU8, true, true>(lds, g, S, E, tid, (const int*)(ws + WS_IDX)); }
        SEAM(pb + 9);
        if (EN(10) && IN(pb + 10)) REP(10) { OPQ(); pg8::Gemm g{(const bf16*)(ws + WS_HM), (const bf16*)(ws + WS_WD), DEP / 2}; pg8::Sched S; S.init((L == 0 ? NSLOT : NSLOT_L) / 256, 4, G, bx, 1, 1);
            pg8::EpiD E{ws + WS_XE}; pg8::gemm_phase<pg8::EpiD, false, true>(lds, g, S, E, tid); }
        SEAM(pb + 10);
        if (EN(11) && IN(pb + 11)) REP(11) { OPQ(); ph_combine(A, L, lds, vcu, G, tid, wave, lane); }
        SEAM(pb + 11);
    }
#if MK_STAMP
    xcd_barrier(bar, wv0 == 0 && LANE0() == 0);
    { const unsigned long long* ts = (const unsigned long long*)(args.ws + 524288);
      const float usA = (float)(ts[MK_STAMP_A] - ts[MK_STAMP_A - 1]) * 0.01f, usB = (float)(ts[MK_STAMP_B] - ts[MK_STAMP_B - 1]) * 0.01f;
      const float cA = sqrtf(usA * 0.25f);
      for (size_t i = (size_t)blockIdx.x * 512 + wv0 * 64 + LANE0(); i < (size_t)NLAT * D; i += (size_t)gridDim.x * 512) args.out[i] = (i == 0) ? usB : cA; }
#endif
#undef IN
#undef SEAM
}

extern "C" void kernel_launch(void* const* d_in, const int* in_sizes, int n_in, void* d_out, int out_size, void* d_ws, size_t ws_size, hipStream_t stream) {
    static int grid = 0;
    if (grid == 0) {
        if (n_in != 19 || out_size != NLAT * D || ws_size < WS_END) { fprintf(stderr, "kernel_launch: unexpected problem (n_in %d, out %d, ws %zu < %zu)\n", n_in, out_size, ws_size, (size_t)WS_END); grid = -1; return; }
        int dev = 0, cus = 0, per_cu = 0;
        if (hipGetDevice(&dev) != hipSuccess || hipDeviceGetAttribute(&cus, hipDeviceAttributeMultiprocessorCount, dev) != hipSuccess) { grid = -1; return; }
        if (hipFuncSetAttribute((const void*)mk_fwd, hipFuncAttributeMaxDynamicSharedMemorySize, LDS_BYTES) != hipSuccess) { fprintf(stderr, "kernel_launch: hipFuncSetAttribute failed\n"); grid = -1; return; }
        if (hipOccupancyMaxActiveBlocksPerMultiprocessor(&per_cu, (const void*)mk_fwd, 512, LDS_BYTES) != hipSuccess || per_cu < 1) fprintf(stderr, "kernel_launch: occupancy query says %d\n", per_cu);
        (void)hipGetLastError();
        grid = cus;
    }
    if (grid < 0) return;
    (void)hipMemsetAsync((char*)d_ws + WS_CTL, 0, CTL_ZERO_BYTES, stream);
    Args a{};
    for (int i = 0; i < 19; ++i) a.in[i] = (const float*)d_in[i];
    a.out = (float*)d_out; a.ws = (unsigned char*)d_ws;
#if MK_ONE_LAUNCH
#ifndef MK_PARTIAL
#define MK_PARTIAL 0
#endif
    if (MK_PARTIAL > 0) { a.ph_lo = 0; a.ph_hi = MK_PARTIAL; hipLaunchKernelGGL(mk_fwd, dim3(grid), dim3(512), LDS_BYTES, stream, a); (void)hipMemsetAsync((char*)d_ws + WS_CTL, 0, CTL_ZERO_BYTES, stream); }
    a.ph_lo = 0; a.ph_hi = N_PHASES;
    hipLaunchKernelGGL(mk_fwd, dim3(grid), dim3(512), LDS_BYTES, stream, a);
#else
    for (int p = 0; p < N_PHASES; ++p) { a.ph_lo = p; a.ph_hi = p + 1; hipLaunchKernelGGL(mk_fwd, dim3(grid), dim3(512), LDS_BYTES, stream, a); }
#endif
}
```

```cpp
#include <hip/hip_runtime.h>
#include <cstdio>
#include <cstdint>

#define MK_WGM_IN 0
#define MK_WGM_GU 4
#ifndef MK_ONE_LAUNCH
#define MK_ONE_LAUNCH 1
#endif

#define GAS __attribute__((address_space(1)))
#define LAS __attribute__((address_space(3)))
typedef unsigned short bf16;
typedef short bf16x8 __attribute__((ext_vector_type(8)));
typedef short s16x4 __attribute__((ext_vector_type(4)));
typedef float f32x4 __attribute__((ext_vector_type(4)));
typedef float f32x2 __attribute__((ext_vector_type(2)));
typedef unsigned u32x4 __attribute__((ext_vector_type(4)));
typedef unsigned u32x2 __attribute__((ext_vector_type(2)));
typedef int i32x4 __attribute__((ext_vector_type(4)));
typedef int i32x8 __attribute__((ext_vector_type(8)));

constexpr int D = 1024, NB = 8, SEQ = 8192, CTXL = 256, DEPTH = 2;
constexpr int NLAT = NB * SEQ, NCTX = NB * CTXL, NTOK = NLAT + NCTX;
constexpr int DPROJ = 3600, NG = 3584, NU = 3072;
constexpr int NH = 4, DH = 128, NCH_C = 2, NCH_L = 64, NCH = 66;
constexpr int NE = 16, DE = 1408, CAP_L = 1024, CAP_C = 32;
constexpr int NSLOT_L = NB * NE * CAP_L, NSLOT = NSLOT_L + NB * NE * CAP_C;
constexpr int NMOD = 6;
constexpr int DEP = 1536;
constexpr float F8_H = 16.0f, F8_HM = 8.0f, F8_W = 256.0f, F8_YE = 32.0f, F8_MAX = 448.0f;
constexpr float EPS = 1e-6f;
constexpr float LOG2E = 1.4426950408889634f;
constexpr int UC_B = 0, UC_CX = 512, UC_Q = 1024, UC_K = 1536, UC_V = 2048, UC_O = 2560;
constexpr int SC_C = 512, SC_X = 1024, SC_Q = 1536, SC_K = 2048;

constexpr size_t MiB = 1u << 20;
constexpr size_t WS_CTL = 0, CTL_ZERO_BYTES = 32 * 1024;
constexpr size_t WS_MODV = 1 * MiB;
constexpr size_t WS_WG = 1 * MiB + 512 * 1024;
constexpr size_t WS_WR = WS_WG + 64 * 1024;
constexpr size_t WS_GATES = 2 * MiB;
constexpr size_t WS_AFFT = 7 * MiB;
constexpr size_t WS_INV = 12 * MiB;
constexpr size_t WS_IDX = 17 * MiB;
constexpr size_t WS_GSEL = 18 * MiB;
constexpr size_t WS_SCAL = 19 * MiB;
constexpr size_t WS_NS = 20 * MiB;
constexpr size_t WS_XC = 24 * MiB;
constexpr size_t WS_WIN = 32 * MiB;
constexpr size_t WS_WOUT = 39 * MiB;
constexpr size_t WS_WGU = 41 * MiB;
constexpr size_t WS_WD = 129 * MiB;
constexpr size_t WS_XB = 173 * MiB;
constexpr size_t WS_R = 305 * MiB;
constexpr size_t WS_U = WS_R;
constexpr size_t WS_CS = WS_R + 462 * MiB;
constexpr size_t WS_XE = WS_R;
constexpr size_t WS_HM = WS_R + 264 * MiB;
constexpr size_t WS_WGU1 = WS_R + 627 * MiB;
constexpr size_t WS_WD1 = WS_WGU1 + 44 * MiB;
constexpr size_t WS_END = WS_WD1 + 24 * MiB;
constexpr size_t OUT_H8 = 160 * MiB;
static_assert((size_t)NTOK * NG * 2 == 462 * MiB && (size_t)NSLOT * 1024 * 2 == 264 * MiB && (size_t)NSLOT * DE * 2 == 363 * MiB, "sizes");
static_assert(WS_CS + (size_t)NB * NH * NCH * 2 * 32768 <= WS_END, "CS");

constexpr int RING_BYTES = 131072, TAB_OFF = 131072, TAB_BYTES = 16384, MISC_OFF = TAB_OFF + TAB_BYTES, LDS_BYTES = MISC_OFF + 256;

__device__ __forceinline__ unsigned cvt_pk_bf16(float lo, float hi) { unsigned r; asm volatile("v_cvt_pk_bf16_f32 %0, %1, %2" : "=v"(r) : "v"(lo), "v"(hi)); return r; }
__device__ __forceinline__ unsigned cvt4_fp8(float a, float b, float c, float d) {
    float hi = F8_MAX; asm volatile("" : "+v"(hi));
    a = __builtin_amdgcn_fmed3f(a, -F8_MAX, hi); b = __builtin_amdgcn_fmed3f(b, -F8_MAX, hi); c = __builtin_amdgcn_fmed3f(c, -F8_MAX, hi); d = __builtin_amdgcn_fmed3f(d, -F8_MAX, hi);
    int w0; asm volatile("" : "=v"(w0));
    unsigned w = (unsigned)__builtin_amdgcn_cvt_pk_fp8_f32(a, b, w0, false); w = (unsigned)__builtin_amdgcn_cvt_pk_fp8_f32(c, d, (int)w, true); return w; }
__device__ __forceinline__ f32x4 zero4() { float a, b, c, d; asm volatile("v_mov_b32 %0, 0\n\tv_mov_b32 %1, 0\n\tv_mov_b32 %2, 0\n\tv_mov_b32 %3, 0" : "=v"(a), "=v"(b), "=v"(c), "=v"(d)); return (f32x4){a, b, c, d}; }
__device__ __forceinline__ u32x4 zero4u() { unsigned a, b, c, d; asm volatile("v_mov_b32 %0, 0\n\tv_mov_b32 %1, 0\n\tv_mov_b32 %2, 0\n\tv_mov_b32 %3, 0" : "=v"(a), "=v"(b), "=v"(c), "=v"(d)); return (u32x4){a, b, c, d}; }
__device__ __forceinline__ u32x2 zero2u() { unsigned a, b; asm volatile("v_mov_b32 %0, 0\n\tv_mov_b32 %1, 0" : "=v"(a), "=v"(b)); return (u32x2){a, b}; }
__device__ __forceinline__ float bf_lo(unsigned w) { return __uint_as_float(w << 16); }
__device__ __forceinline__ float bf_hi(unsigned w) { return __uint_as_float(w & 0xffff0000u); }
__device__ __forceinline__ float shf(float v, int src) { return __int_as_float(__builtin_amdgcn_ds_bpermute(src << 2, __float_as_int(v))); }
__device__ __forceinline__ float rdl(float v, int k) { return __int_as_float(__builtin_amdgcn_readlane(__float_as_int(v), k)); }
__device__ __forceinline__ int shi(int v, int src) { return __builtin_amdgcn_ds_bpermute(src << 2, v); }
__device__ __forceinline__ float shx(float v, int m, int lane) { return shf(v, lane ^ m); }
__device__ __forceinline__ float shup(float v, int s, int lane) { return shf(v, lane >= s ? lane - s : lane); }
__device__ __forceinline__ float shdn(float v, int s, int lane) { return shf(v, lane + s < 64 ? lane + s : lane); }
__device__ __forceinline__ float wave_sum(float v, int lane) {
#pragma unroll
    for (int o = 1; o < 64; o <<= 1) v += shx(v, o, lane);
    return v;
}
__device__ __forceinline__ float fexp2(float x) { return __builtin_amdgcn_exp2f(x); }
__device__ __forceinline__ float fexp(float x) { return __builtin_amdgcn_exp2f(x * LOG2E); }
#define LDS_WAIT() asm volatile("s_waitcnt lgkmcnt(0)" ::: "memory")
#define VM_WAIT() asm volatile("s_waitcnt vmcnt(0)" ::: "memory")

namespace pg8 {
constexpr int BM = 256, BK = 64, HALF = 128, HTB = HALF * BK * 2, STAGE_BYTES = 8 * HTB, NXCD = 8, WGM = 8;
__host__ __device__ __forceinline__ int lds_byte(int r, int c) { const int st = (r >> 4) * 2 + (c >> 5), rr = r & 15, cc = c & 31, ob = rr * 64 + cc * 2; return st * 1024 + (ob ^ (((ob >> 9) & 1) << 5)); }
__host__ __device__ __forceinline__ void stage_rc(int b, int& R, int& C) { const int st = b / 1024, sb = b % 1024, swz = sb ^ (((sb >> 9) & 1) << 5); R = (st >> 1) * 16 + swz / 64; C = (st & 1) * 32 + (swz % 64) / 2; }
__host__ __device__ __forceinline__ int perm32(int rho) { const int n = rho >> 4, i = rho & 15; return 8 * (i >> 2) + 4 * n + (i & 3); }

__device__ __forceinline__ const char* uni_ptr(const char* p) { const unsigned long long v = (unsigned long long)p;
    const unsigned lo = (unsigned)__builtin_amdgcn_readfirstlane((int)(unsigned)v), hi = (unsigned)__builtin_amdgcn_readfirstlane((int)(unsigned)(v >> 32)); return (const char*)(((unsigned long long)hi << 32) | lo); }
struct Unit { int pm, pn, bt; };
struct Gemm { const bf16* A; const bf16* Bt; int K; };

struct Sched {
    int nM, nN, nwg, G, c, moe, rev, wgm;
    __device__ __forceinline__ void init(int nM_, int nN_, int G_, int c_, int moe_, int rev_ = 0, int wgm_ = WGM) { nM = nM_; nN = nN_; nwg = nM * nN; G = G_; c = c_; moe = moe_; rev = rev_; wgm = wgm_; }
    __device__ __forceinline__ bool next(int i, Unit& u) const {
        const long L = (long)i * G + c; if (L >= nwg) return false;
        if (wgm == 0) {
            const int xcd = (int)(L % NXCD), off = (int)(L / NXCD), hn = nN >> 1;
            u.pm = (nM >> 2) * (xcd & 3) + off / hn; u.pn = hn * (xcd >> 2) + off % hn; u.bt = u.pn; return true; }
        int wgid = (int)L; { const int q = nwg / NXCD, r = nwg % NXCD, xcd = wgid % NXCD, off = wgid / NXCD; wgid = (xcd < r ? xcd * (q + 1) : r * (q + 1) + (xcd - r) * q) + off; }
        const int nig = wgm * nN, gid = wgid / nig, fm = gid * wgm, gsz = (nM - fm) < wgm ? (nM - fm) : wgm;
        u.pm = fm + ((wgid % nig) % gsz); u.pn = (wgid % nig) / gsz;
        if (rev) u.pm = nM - 1 - u.pm;
        u.bt = moe ? ((u.pm < 512 ? (u.pm >> 5) : (u.pm - 512)) * nN + u.pn) : u.pn;
        return true;
    }
};

struct EpiU {
    static constexpr bool PERM = true;
    bf16* O; int ldc;
    __device__ __forceinline__ void operator()(const f32x4 (&acc)[2][2][4][2], const Unit& u, int wr, int wc, int fr, int fq) const {
        const int row0 = u.pm * BM + wr * 64 + fr;
        if (u.pn >= 2 && u.pn < 6) {
            const int col0 = 512 + (u.pn - 2) * HALF + wc * 32 + 8 * fq;
#pragma unroll
            for (int ai = 0; ai < 2; ++ai)
#pragma unroll
                for (int m = 0; m < 4; ++m) { const f32x4 v0 = acc[ai][0][m][0] * acc[ai][1][m][0], v1 = acc[ai][0][m][1] * acc[ai][1][m][1];
                    u32x4 w; w.x = cvt_pk_bf16(v0[0], v0[1]); w.y = cvt_pk_bf16(v0[2], v0[3]); w.z = cvt_pk_bf16(v1[0], v1[1]); w.w = cvt_pk_bf16(v1[2], v1[3]);
                    *(u32x4*)(O + (size_t)(row0 + ai * HALF + m * 16) * ldc + col0) = w; }
        } else {
            const int col0 = (u.pn < 2 ? u.pn * BM : u.pn * BM - 512) + wc * 32 + 8 * fq;
#pragma unroll
            for (int ai = 0; ai < 2; ++ai)
#pragma unroll
                for (int m = 0; m < 4; ++m) { bf16* rowp = O + (size_t)(row0 + ai * HALF + m * 16) * ldc + col0;
#pragma unroll
                    for (int bj = 0; bj < 2; ++bj) { const f32x4 v0 = acc[ai][bj][m][0], v1 = acc[ai][bj][m][1];
                        u32x4 w; w.x = cvt_pk_bf16(v0[0], v0[1]); w.y = cvt_pk_bf16(v0[2], v0[3]); w.z = cvt_pk_bf16(v1[0], v1[1]); w.w = cvt_pk_bf16(v1[2], v1[3]);
                        *(u32x4*)(rowp + bj * HALF) = w; } }
        }
    }
};
struct EpiRes {
    static constexpr bool PERM = true;
    bf16* x_lat; bf16* x_ctx; const float* modv;
    __device__ __forceinline__ void operator()(const f32x4 (&acc)[2][2][4][2], const Unit& u, int wr, int wc, int fr, int fq) const {
        const bool lat = u.pm < 256; const int g = lat ? (u.pm >> 5) : 8;
        const int rowt = (lat ? u.pm : u.pm - 256) * BM + wr * 64 + fr, col0 = u.pn * BM + wc * 32 + 8 * fq;
        bf16* x = lat ? x_lat : x_ctx;
        f32x4 gv[2][2];
#pragma unroll
        for (int bj = 0; bj < 2; ++bj)
#pragma unroll
            for (int n = 0; n < 2; ++n) gv[bj][n] = *(const f32x4*)(modv + g * 6144 + 2 * 1024 + col0 + bj * HALF + 4 * n);
        u32x4 bs[2][4][2];
#pragma unroll
        for (int ai = 0; ai < 2; ++ai)
#pragma unroll
            for (int m = 0; m < 4; ++m)
#pragma unroll
                for (int bj = 0; bj < 2; ++bj) bs[ai][m][bj] = *(const u32x4*)(x + (size_t)(rowt + ai * HALF + m * 16) * D + col0 + bj * HALF);
#pragma unroll
        for (int ai = 0; ai < 2; ++ai) {
#pragma unroll
            for (int m = 0; m < 4; ++m)
#pragma unroll
                for (int bj = 0; bj < 2; ++bj) { const u32x4 b = bs[ai][m][bj]; const f32x4 a0 = acc[ai][bj][m][0] * gv[bj][0], a1 = acc[ai][bj][m][1] * gv[bj][1];
                    u32x4 w; w.x = cvt_pk_bf16(bf_lo(b.x) + a0[0], bf_hi(b.x) + a0[1]); w.y = cvt_pk_bf16(bf_lo(b.y) + a0[2], bf_hi(b.y) + a0[3]);
                    w.z = cvt_pk_bf16(bf_lo(b.z) + a1[0], bf_hi(b.z) + a1[1]); w.w = cvt_pk_bf16(bf_lo(b.w) + a1[2], bf_hi(b.w) + a1[3]);
                    *(u32x4*)(x + (size_t)(rowt + ai * HALF + m * 16) * D + col0 + bj * HALF) = w; }
            asm volatile("" ::: "memory"); }
    }
};
struct EpiGU8 {
    static constexpr bool PERM = true;
    unsigned char* O;
    __device__ __forceinline__ void operator()(const f32x4 (&acc)[2][2][4][2], const Unit& u, int wr, int wc, int fr, int fq) const {
        const int row0 = u.pm * BM + wr * 64 + fr, col0 = u.pn * HALF + wc * 32 + 8 * fq;
        constexpr float SA = 1.0f / (F8_H * F8_W), SB = F8_HM / (F8_H * F8_W);
        float ce = -SA * LOG2E, cy = SA * SB; asm volatile("" : "+v"(ce), "+v"(cy));
#pragma unroll
        for (int ai = 0; ai < 2; ++ai)
#pragma unroll
            for (int m = 0; m < 4; ++m) { unsigned char* rowp = O + (size_t)(row0 + ai * HALF + m * 16) * DEP + col0;
                float r[8];
#pragma unroll
                for (int n = 0; n < 2; ++n)
#pragma unroll
                    for (int j = 0; j < 4; j += 2) {
                        const float x0 = acc[ai][0][m][n][j], x1 = acc[ai][0][m][n][j + 1], y0 = acc[ai][1][m][n][j], y1 = acc[ai][1][m][n][j + 1];
                        const float A = 1.0f + fexp2(x0 * ce), B = 1.0f + fexp2(x1 * ce), rr = __builtin_amdgcn_rcpf(A * B) * cy;
                        r[4 * n + j] = (x0 * (B * rr)) * y0; r[4 * n + j + 1] = (x1 * (A * rr)) * y1; }
                u32x2 w; w.x = cvt4_fp8(r[0], r[1], r[2], r[3]); w.y = cvt4_fp8(r[4], r[5], r[6], r[7]);
                *(u32x2*)rowp = w;
                }
    }
};
struct EpiD {
    static constexpr bool PERM = true;
    unsigned char* O;
    __device__ __forceinline__ void operator()(const f32x4 (&acc)[2][2][4][2], const Unit& u, int wr, int wc, int fr, int fq) const {
        const int row0 = u.pm * BM + wr * 64 + fr, col0 = u.pn * BM + wc * 32 + 8 * fq;
#pragma unroll
        for (int ai = 0; ai < 2; ++ai)
#pragma unroll
            for (int m = 0; m < 4; ++m) { const int row = row0 + ai * HALF + m * 16; constexpr float gs = F8_YE / (F8_HM * F8_W); unsigned char* rowp = O + (size_t)row * D + col0;
#pragma unroll
                for (int bj = 0; bj < 2; ++bj) { const f32x4 v0 = acc[ai][bj][m][0] * gs, v1 = acc[ai][bj][m][1] * gs;
                    u32x2 w; w.x = cvt4_fp8(v0[0], v0[1], v0[2], v0[3]); w.y = cvt4_fp8(v1[0], v1[1], v1[2], v1[3]);
                    *(u32x2*)(rowp + bj * HALF) = w; } }
    }
};

template <class Epi, bool GATHER = false, bool F8 = false, bool PADLAST = false>
__device__ __forceinline__ void gemm_phase(LAS unsigned char* lds, const Gemm g, const Sched& S, const Epi& E, const int tid, const int* gidx = nullptr) {
    const int wid = __builtin_amdgcn_readfirstlane(tid >> 6), lane = tid & 63, wr = wid >> 2, wc = wid & 3, fr = lane & 15, fq = lane >> 4;
    const int K = g.K, nt = K / BK;
    unsigned voffA[2], voffB[2]; int rowA[2], colA[2];
#pragma unroll
    for (int i = 0; i < 2; ++i) { int R, C; stage_rc(tid * 16 + i * 8192, R, C); const int Rb = Epi::PERM ? ((R & ~31) + perm32(R & 31)) : R;
        voffA[i] = (unsigned)(R * K + C) * 2u; voffB[i] = (unsigned)(Rb * K + C) * 2u; rowA[i] = R; colA[i] = C; }
    const size_t kstep = (size_t)(BK * 2);
    const size_t hstep = (size_t)HALF * K * 2;
    const size_t tstep = 2 * hstep;
    const unsigned ldsw = (unsigned)wid * 1024u;
    const int aoff = lds_byte(wr * 64 + fr, fq * 8), boff = lds_byte(wc * 32 + fr, fq * 8);
#define PG8_SA(b, h) (((b) * 2 + (h)) * HTB)
#define PG8_SB(b, h) ((4 + (b) * 2 + (h)) * HTB)
#define PG8_STAGE(bufoff, gbase, voff) do { const char* gb_ = uni_ptr((const char*)(gbase)); _Pragma("unroll") for (int _i = 0; _i < 2; ++_i) { unsigned vo_ = (voff)[0] + (unsigned)(_i * 128 * K); asm volatile("" : "+v"(vo_)); \
        __builtin_amdgcn_global_load_lds((const unsigned*)(gb_ + vo_), (LAS unsigned*)(lds + (bufoff) + ldsw + _i * 8192), 16, 0, 0); } } while (0)
#define PG8_GI(nx, h) do { if constexpr (GATHER) { const int tb_ = ((nx) ? nbuf : cbuf) * 1024 + (h) * 512; gix[0] = *(const LAS unsigned*)(gtab + tb_ + gt_rd); gix[1] = *(const LAS unsigned*)(gtab + tb_ + 256 + gt_rd); } } while (0)
#define PG8_STAGE_A(bufoff, nx, h, kb) do { if constexpr (GATHER) { const char* ga_ = uni_ptr((const char*)g.A + (kb)); _Pragma("unroll") for (int _i = 0; _i < 2; ++_i) \
        __builtin_amdgcn_global_load_lds((const unsigned*)(ga_ + (gix[_i] * (unsigned)(K * 2) + colA2)), (LAS unsigned*)(lds + (bufoff) + ldsw + _i * 8192), 16, 0, 0); } \
        else PG8_STAGE(bufoff, ((nx) ? nA : cA) + (h) * hstep + (kb), voffA); } while (0)
#define PG8_GIDX_DMA(pm_, b_) do { if (wid < 4) { const char* gp_ = uni_ptr((const char*)(gidx + (pm_) * BM + wid * 64)); unsigned lo_; asm volatile("v_mbcnt_lo_u32_b32 %0, -1, 0\n\tv_mbcnt_hi_u32_b32 %0, -1, %0\n\tv_lshlrev_b32 %0, 2, %0" : "=v"(lo_)); \
        __builtin_amdgcn_global_load_lds((const unsigned*)(gp_ + lo_), (LAS unsigned*)(gtab + (b_) * 1024 + wid * 256), 4, 0, 0); } } while (0)
#define PG8_LD8(p) __builtin_shufflevector(*(const LAS i32x4*)(p), *(const LAS i32x4*)((p) + 1024), 0, 1, 2, 3, 4, 5, 6, 7)
#define PG8_LDA(dst, b, h) do { _Pragma("unroll") for (int m = 0; m < 4; ++m) { if constexpr (F8) dst##8[m] = PG8_LD8(lds + PG8_SA(b, h) + aoff + m * 2048); else { _Pragma("unroll") for (int k = 0; k < 2; ++k) dst[m][k] = *(const LAS bf16x8*)(lds + PG8_SA(b, h) + aoff + m * 2048 + k * 1024); } } } while (0)
#define PG8_LDB(dst, b, h) do { _Pragma("unroll") for (int n = 0; n < 2; ++n) { if constexpr (F8) dst##8[n] = PG8_LD8(lds + PG8_SB(b, h) + boff + n * 2048); else { _Pragma("unroll") for (int k = 0; k < 2; ++k) dst[n][k] = *(const LAS bf16x8*)(lds + PG8_SB(b, h) + boff + n * 2048 + k * 1024); } } } while (0)
#define PG8_MMA(ai, bj, At, Bt) do { __builtin_amdgcn_s_setprio(1); _Pragma("unroll") for (int m = 0; m < 4; ++m) _Pragma("unroll") for (int n = 0; n < 2; ++n) { \
        if constexpr (F8) acc[ai][bj][m][n] = __builtin_amdgcn_mfma_scale_f32_16x16x128_f8f6f4(Bt##8[n], At##8[m], acc[ai][bj][m][n], 0, 0, 0, 0, 0, 0); \
        else { _Pragma("unroll") for (int k = 0; k < 2; ++k) acc[ai][bj][m][n] = __builtin_amdgcn_mfma_f32_16x16x32_bf16(Bt[n][k], At[m][k], acc[ai][bj][m][n], 0, 0, 0); } } __builtin_amdgcn_s_setprio(0); } while (0)
#define PG8_WAIT_V(n) asm volatile("s_waitcnt vmcnt(" #n ")" ::: "memory")
#define PG8_WAIT_L(n) asm volatile("s_waitcnt lgkmcnt(" #n ")" ::: "memory")
#define PG8_BAR __builtin_amdgcn_s_barrier()
#define PG8_SCHED __builtin_amdgcn_sched_barrier(0)
    Unit cur, nxt; int ui = 0;
    if (!S.next(0, cur)) return;
    f32x4 acc[2][2][4][2];
#pragma unroll
    for (int a = 0; a < 2; ++a)
#pragma unroll
        for (int b = 0; b < 2; ++b)
#pragma unroll
            for (int m = 0; m < 4; ++m)
#pragma unroll
                for (int n = 0; n < 2; ++n) acc[a][b][m][n] = (f32x4){0.f, 0.f, 0.f, 0.f};
    bf16x8 At[4][2], B0[2][2], B1[2][2]; i32x8 At8[4], B08[2], B18[2];
    const char* cA = uni_ptr((const char*)g.A + (size_t)cur.pm * tstep); const char* cB = uni_ptr((const char*)g.Bt + (size_t)cur.bt * tstep);
    const char* nA = cA;
    LAS unsigned char* const gtab = lds + TAB_OFF; const int gt_rd = rowA[0] * 4; const unsigned colA2 = (unsigned)colA[0] * 2u; unsigned gix[2] = {0u, 0u}; int cbuf = 0, nbuf = 0;
    (void)gtab; (void)gt_rd; (void)colA2; (void)gix; (void)cbuf; (void)nbuf;
    if constexpr (GATHER) { PG8_GIDX_DMA(cur.pm, 0); PG8_WAIT_V(0); PG8_BAR; }
    PG8_STAGE(PG8_SB(0, 0), cB, voffB); PG8_STAGE(PG8_SB(0, 1), cB + hstep, voffB); PG8_GI(false, 0); PG8_STAGE_A(PG8_SA(0, 0), false, 0, 0); PG8_GI(false, 1); PG8_STAGE_A(PG8_SA(0, 1), false, 1, 0);
    if (wr == 1) PG8_BAR;
    PG8_WAIT_V(2); PG8_BAR;
    PG8_STAGE(PG8_SB(1, 0), cB + kstep, voffB); PG8_GI(false, 0); PG8_STAGE_A(PG8_SA(1, 0), false, 0, kstep); PG8_STAGE(PG8_SB(1, 1), cB + hstep + kstep, voffB);
    PG8_WAIT_V(6); PG8_BAR;
    for (;;) {
        const bool has_next = S.next(ui + 1, nxt);
        nA = uni_ptr(has_next ? (const char*)g.A + (size_t)nxt.pm * tstep : cA); const char* nB = uni_ptr(has_next ? (const char*)g.Bt + (size_t)nxt.bt * tstep : cB);
        if constexpr (GATHER) { nbuf = has_next ? (cbuf ^ 1) : cbuf; if (has_next) PG8_GIDX_DMA(nxt.pm, nbuf); }
#pragma unroll 1
        for (int t = 0; t < nt; t += 2) {
            const bool last = (t == nt - 2);
            const bool p1 = PADLAST && (t + 1 == nt - 1), p3 = PADLAST && !last && (t + 3 == nt - 1);
            const size_t kb1 = p1 ? 0 : (size_t)(t + 1) * kstep, kb2 = last ? 0 : (size_t)(t + 2) * kstep, kb3 = p3 ? 0 : kb2 + kstep;
            const char* b2 = last ? nB : cB + (size_t)(t + 2) * kstep; const char* b3 = p3 ? cB : b2 + kstep;
            PG8_GI(false, 1); PG8_LDB(B0, 0, 0); PG8_LDB(B1, 0, 1); PG8_SCHED; PG8_LDA(At, 0, 0); PG8_STAGE_A(PG8_SA(1, 1), false, 1, kb1);
            PG8_WAIT_V(8); PG8_WAIT_L(0); PG8_BAR; PG8_MMA(0, 0, At, B0); PG8_MMA(0, 1, At, B1); PG8_BAR; PG8_SCHED;
            PG8_GI(last, 0); PG8_LDA(At, 0, 1); PG8_STAGE(PG8_SB(0, 0), b2, voffB); PG8_STAGE(PG8_SB(0, 1), b2 + hstep, voffB); PG8_STAGE_A(PG8_SA(0, 0), last, 0, kb2);
            PG8_WAIT_V(8); PG8_WAIT_L(0); PG8_BAR; PG8_MMA(1, 0, At, B0); PG8_MMA(1, 1, At, B1); PG8_BAR; PG8_SCHED;
            const bool live = !(PADLAST && last);
            PG8_GI(last, 1); if (live) { PG8_LDB(B0, 1, 0); PG8_LDB(B1, 1, 1); PG8_SCHED; PG8_LDA(At, 1, 0); } PG8_STAGE_A(PG8_SA(0, 1), last, 1, kb2);
            PG8_WAIT_V(8); PG8_WAIT_L(0); PG8_BAR; if (live) { PG8_MMA(0, 0, At, B0); PG8_MMA(0, 1, At, B1); } PG8_BAR; PG8_SCHED;
            PG8_GI(last, 0); if (live) { PG8_LDA(At, 1, 1); } PG8_STAGE(PG8_SB(1, 0), b3, voffB); PG8_STAGE(PG8_SB(1, 1), b3 + hstep, voffB); PG8_STAGE_A(PG8_SA(1, 0), last, 0, kb3);
            PG8_WAIT_V(8); PG8_WAIT_L(0); PG8_BAR; if (live) { PG8_MMA(1, 0, At, B0); PG8_MMA(1, 1, At, B1); } PG8_BAR; PG8_SCHED;
        }
        if (wr == 0) PG8_BAR;
        { int le_; asm volatile("v_mbcnt_lo_u32_b32 %0, -1, 0\n\tv_mbcnt_hi_u32_b32 %0, -1, %0" : "=v"(le_));
          E(acc, cur, wr, wc, le_ & 15, le_ >> 4); }
        if (!has_next) break;
#pragma unroll
        for (int a = 0; a < 2; ++a)
#pragma unroll
            for (int b = 0; b < 2; ++b)
#pragma unroll
                for (int m = 0; m < 4; ++m)
#pragma unroll
                    for (int n = 0; n < 2; ++n) acc[a][b][m][n] = (f32x4){0.f, 0.f, 0.f, 0.f};
        cur = nxt; cA = nA; cB = nB; ++ui;
        if constexpr (GATHER) cbuf = nbuf;
        if (wr == 1) PG8_BAR;
    }
    PG8_WAIT_V(0);
    PG8_BAR;
#undef PG8_SA
#undef PG8_SB
#undef PG8_STAGE
#undef PG8_STAGE_A
#undef PG8_GI
#undef PG8_GIDX_DMA
#undef PG8_LDA
#undef PG8_LDB
#undef PG8_MMA
#undef PG8_LD8
#undef PG8_WAIT_V
#undef PG8_WAIT_L
#undef PG8_BAR
#undef PG8_SCHED
}
}

#define XB_TMO      128
#define XB_XCNT(j)  (256  + 64 * (j))
#define XB_XSUB(j)  (1280 + 64 * (j))
#define XB_XGEN(j)  (2304 + 64 * (j))
#define XB_TOP      3328
#define XB_TOPGEN   3392
#define XCD_BAR_WORDS 3456
#define XB_SPIN_CAP (1u << 18)
__device__ __forceinline__ unsigned xb_ld(unsigned* p)              { return __hip_atomic_load(p, __ATOMIC_RELAXED, __HIP_MEMORY_SCOPE_AGENT); }
__device__ __forceinline__ unsigned xb_add(unsigned* p, unsigned v) { return __hip_atomic_fetch_add(p, v, __ATOMIC_RELAXED, __HIP_MEMORY_SCOPE_AGENT); }
__device__ __forceinline__ unsigned xb_xcc_id() { return (unsigned)__builtin_amdgcn_s_getreg((3 << 11) | 20) & 0xFu; }
#define XB_SPIN(cond, bar) do { unsigned _sp = 0; while (cond) { __builtin_amdgcn_s_sleep(1); \
    if ((++_sp & 255u) == 0u) { if (xb_ld(&(bar)[XB_TMO])) break; if (_sp > XB_SPIN_CAP) { atomicAdd(&(bar)[XB_TMO], 1u); break; } } } } while (0)
struct XcdBarrier { unsigned* bar; unsigned x; volatile LAS unsigned* st; };
__device__ __forceinline__ XcdBarrier xcd_barrier_post(unsigned* bar, volatile LAS unsigned* st, bool t0) {
    XcdBarrier b; b.bar = bar; b.x = xb_xcc_id(); b.st = st;
    if (t0) (void)xb_add(&bar[XB_XCNT(b.x)], 1u);
    return b;
}
__device__ __forceinline__ void xcd_barrier_complete(unsigned* bar, unsigned x, unsigned& nloc, unsigned& nx) {
    const unsigned G = gridDim.x * gridDim.y * gridDim.z;
    unsigned sum, cnt, mine, sp = 0u;
    for (;;) {
        sum = 0u; cnt = 0u; mine = 0u;
#pragma unroll
        for (unsigned j = 0; j < 16; ++j) { const unsigned c = xb_ld(&bar[XB_XCNT(j)]); sum += c; cnt += (c > 0u) ? 1u : 0u; mine = (j == x) ? c : mine; }
        if (sum == G) break;
        __builtin_amdgcn_s_sleep(1);
        if ((++sp & 255u) == 0u) { if (xb_ld(&bar[XB_TMO])) break; if (sp > XB_SPIN_CAP) { atomicAdd(&bar[XB_TMO], 1u); break; } }
    }
    nloc = mine > 0u ? mine : 1u; nx = cnt > 0u ? cnt : 1u;
}
__device__ __forceinline__ void xcd_barrier(const XcdBarrier& b, bool t0) {
    asm volatile("s_waitcnt vmcnt(0)" ::: "memory");
    __syncthreads();
    if (t0) {
        unsigned* bar = b.bar;
        __builtin_amdgcn_s_waitcnt(0);
        unsigned nloc = b.st[0], nx = b.st[1];
        if (nloc == 0u) { xcd_barrier_complete(bar, b.x, nloc, nx); b.st[0] = nloc; b.st[1] = nx; }
        const unsigned old = xb_add(&bar[XB_XSUB(b.x)], 1u);
        const unsigned gen = old / nloc;
        if (old + 1u == (gen + 1u) * nloc) {
            __builtin_amdgcn_fence(__ATOMIC_RELEASE, "agent");
            asm volatile("s_waitcnt vmcnt(0)" ::: "memory");
            const unsigned og = xb_add(&bar[XB_TOP], 1u);
            const unsigned tg = og / nx;
            if (og + 1u == (tg + 1u) * nx) xb_add(&bar[XB_TOPGEN], 1u);
            else XB_SPIN(xb_ld(&bar[XB_TOPGEN]) == tg, bar);
            __builtin_amdgcn_fence(__ATOMIC_ACQUIRE, "agent");
            xb_add(&bar[XB_XGEN(b.x)], 1u);
            asm volatile("s_waitcnt vmcnt(0)" ::: "memory");
        } else {
            XB_SPIN(xb_ld(&bar[XB_XGEN(b.x)]) == gen, bar);
            __builtin_amdgcn_fence(__ATOMIC_ACQUIRE, "agent");
            asm volatile("s_waitcnt vmcnt(0)" ::: "memory");
        }
    }
    __syncthreads();
}

struct Args { const float* in[19]; float* out; unsigned char* ws; int ph_lo, ph_hi; };
enum { IN_X = 0, IN_C, IN_CTX, IN_CCTX, IN_WMOD, IN_BMOD, IN_G1, IN_G2, IN_WIN, IN_WOUT, IN_CONVW, IN_CONVB, IN_GATEB, IN_GHEAD, IN_WROUTER, IN_WGATE, IN_WUP, IN_WDOWN, IN_GFINAL };

__device__ __forceinline__ void ph_prologue(const Args& a, LAS unsigned char* lds, int vcu, int G, int tid, int wave, int lane) {
    unsigned char* ws = a.ws;
    bf16* wg = (bf16*)(ws + WS_WG); bf16* wrt = (bf16*)(ws + WS_WR);
    const float* w_in = a.in[IN_WIN]; const float* w_router = a.in[IN_WROUTER];
    for (int i = vcu * 512 + tid; i < 2 * 16 * 1024; i += G * 512) { const int L = i >> 14, j = (i >> 10) & 15, k = i & 1023;
        wg[i] = (bf16)(cvt_pk_bf16(w_in[((size_t)L * 1024 + k) * DPROJ + NG + j], 0.f) & 0xffffu);
        wrt[i] = (bf16)(cvt_pk_bf16(w_router[((size_t)L * 1024 + k) * NE + j], 0.f) & 0xffffu); }
    LAS float* sv = (LAS float*)lds;
    LAS float* red = (LAS float*)(lds + 9 * 1024 * 4);
    const float* c = a.in[IN_C]; const float* cctx = a.in[IN_CCTX];
    for (int i = tid; i < 9 * 1024; i += 512) { const int g = i >> 10, k = i & 1023; const float v = g < 8 ? c[g * 1024 + k] : cctx[k]; sv[i] = v / (1.0f + __expf(-v)); }
    __syncthreads();
    const float* w_mod = a.in[IN_WMOD]; const float* b_mod = a.in[IN_BMOD]; float* modv = (float*)(ws + WS_MODV);
    for (int item = vcu; item < 2 * 96; item += G) {
        const int L = item / 96, cb = item % 96, col = cb * 64 + lane;
        float acc[9];
#pragma unroll
        for (int g = 0; g < 9; ++g) acc[g] = 0.f;
        for (int k0 = 0; k0 < 128; k0 += 64) { float wv[64];
#pragma unroll
            for (int kk = 0; kk < 64; ++kk) wv[kk] = __builtin_nontemporal_load(w_mod + ((size_t)L * 1024 + wave * 128 + k0 + kk) * 6144 + col);
#pragma unroll
            for (int kk = 0; kk < 64; ++kk) { const int k = wave * 128 + k0 + kk;
#pragma unroll
                for (int g = 0; g < 9; ++g) acc[g] += sv[g * 1024 + k] * wv[kk]; } }
#pragma unroll
        for (int g = 0; g < 9; ++g) red[(wave * 9 + g) * 64 + lane] = acc[g];
        __syncthreads();
        for (int o = tid; o < 9 * 64; o += 512) { const int g = o >> 6, l = o & 63; float s = b_mod[L * 6144 + cb * 64 + l];
#pragma unroll
            for (int w = 0; w < 8; ++w) s += red[(w * 9 + g) * 64 + l];
            modv[(size_t)(L * 9 + g) * 6144 + cb * 64 + l] = s; }
        __syncthreads();
    }
}

__device__ __forceinline__ void transpose_item(const float* src, int ld, int k0, int n0, bf16* dst, int dstK, int row0, float scale, LAS float* scr, int lane) {
    float ld32[32];
#pragma unroll
    for (int i = 0; i < 32; ++i) { const int kk = 2 * i + (lane >> 5); ld32[i] = __builtin_nontemporal_load(src + (size_t)(k0 + kk) * ld + n0 + (lane & 31)); }
#pragma unroll
    for (int i = 0; i < 32; ++i) { const int kk = 2 * i + (lane >> 5); scr[kk * 33 + (lane & 31)] = ld32[i] * scale; }
    LDS_WAIT(); asm volatile("" ::: "memory");
    const int c = lane & 7;
#pragma unroll
    for (int j = 0; j < 4; ++j) { const int n = (lane >> 3) + 8 * j; const LAS float* s = scr + (8 * c) * 33 + n;
        u32x4 o; o.x = cvt_pk_bf16(s[0 * 33], s[1 * 33]); o.y = cvt_pk_bf16(s[2 * 33], s[3 * 33]); o.z = cvt_pk_bf16(s[4 * 33], s[5 * 33]); o.w = cvt_pk_bf16(s[6 * 33], s[7 * 33]);
        *(u32x4*)(dst + (size_t)(row0 + n) * dstK + k0 + 8 * c) = o; }
    LDS_WAIT(); asm volatile("" ::: "memory");
}
__device__ __forceinline__ void tr_load(const float* src, int ld, int k0, int n0, int lane, float (&ld32)[32]) {
#pragma unroll
    for (int i = 0; i < 32; ++i) { const int kk = 2 * i + (lane >> 5); ld32[i] = __builtin_nontemporal_load(src + (size_t)(k0 + kk) * ld + n0 + (lane & 31)); }
}
__device__ __forceinline__ void tr_finish_f8(const float (&ld32)[32], unsigned char* dst, int dstK, int k0, int row0, float scale, LAS float* scr, int lane) {
#pragma unroll
    for (int i = 0; i < 32; ++i) { const int kk = 2 * i + (lane >> 5); scr[kk * 33 + (lane & 31)] = ld32[i] * scale; }
    LDS_WAIT(); asm volatile("" ::: "memory");
    const int c = lane & 3;
#pragma unroll
    for (int j = 0; j < 2; ++j) { const int n = (lane >> 2) + 16 * j; const LAS float* s = scr + (16 * c) * 33 + n;
        u32x4 o; o.x = cvt4_fp8(s[0 * 33], s[1 * 33], s[2 * 33], s[3 * 33]); o.y = cvt4_fp8(s[4 * 33], s[5 * 33], s[6 * 33], s[7 * 33]);
        o.z = cvt4_fp8(s[8 * 33], s[9 * 33], s[10 * 33], s[11 * 33]); o.w = cvt4_fp8(s[12 * 33], s[13 * 33], s[14 * 33], s[15 * 33]);
        *(u32x4*)(dst + (size_t)(row0 + n) * dstK + k0 + 16 * c) = o; }
    LDS_WAIT(); asm volatile("" ::: "memory");
}
__device__ __forceinline__ void transpose_item_f8(const float* src, int ld, int k0, int n0, unsigned char* dst, int dstK, int row0, float scale, LAS float* scr, int lane) {
    float ld32[32]; tr_load(src, ld, k0, n0, lane, ld32); tr_finish_f8(ld32, dst, dstK, k0, row0, scale, scr, lane);
}
constexpr int CV_NI_IN = 16 * 112, CV_NI_OUT = 16 * 32, CV_NI_E = 704, CV_NI_GU = NE * 2 * CV_NI_E, CV_NI_DN = NE * CV_NI_E, CV_M0 = CV_NI_IN + CV_NI_OUT, CV_NQ = CV_NI_GU + CV_NI_DN, CV_NITEMS = CV_M0 + CV_NQ;
__device__ __forceinline__ void cv_item(const Args& a, int L, int it, LAS float* scr, int lane) {
    unsigned char* ws = a.ws;
    constexpr int NI_IN = CV_NI_IN, NI_OUT = CV_NI_OUT, NI_E = CV_NI_E, NI_GU = CV_NI_GU;
    int r = it;
    if (r < NI_IN) { const int kb = r / 112, nb = r % 112, n0 = 32 * nb;
        const int drow = (n0 >= SC_C && n0 < SC_X) ? 512 + 256 * ((n0 - SC_C) >> 7) + ((n0 - SC_C) & 127) : ((n0 >= SC_X && n0 < SC_Q) ? 512 + 256 * ((n0 - SC_X) >> 7) + 128 + ((n0 - SC_X) & 127) : n0);
        transpose_item(a.in[IN_WIN] + (size_t)L * 1024 * DPROJ, DPROJ, 64 * kb, n0, (bf16*)(ws + WS_WIN), 1024, drow, (n0 >= SC_Q && n0 < SC_K) ? 0.08838834764831845f : 1.0f, scr, lane); return; }
    r -= NI_IN;
    if (r < NI_OUT) { const int kb = r / 32, nb = r % 32;
        transpose_item(a.in[IN_WOUT] + (size_t)L * 1024 * 1024, 1024, 64 * kb, 32 * nb, (bf16*)(ws + WS_WOUT), 1024, 32 * nb, 1.0f, scr, lane); return; }
    r -= NI_OUT;
    if (r < NI_GU) { const int e = r / (2 * NI_E), rr = r % (2 * NI_E), which = rr / NI_E, q = rr % NI_E, kb = q / 44, nb = q % 44, n0 = 32 * nb;
        const float* src = (which ? a.in[IN_WUP] : a.in[IN_WGATE]) + ((size_t)L * NE + e) * 1024 * DE;
        transpose_item_f8(src, DE, 64 * kb, n0, ws + (L ? WS_WGU1 : WS_WGU) + (size_t)e * 2816 * 1024, 1024, 256 * (n0 >> 7) + 128 * which + (n0 & 127), F8_W, scr, lane); return; }
    r -= NI_GU;
    { const int e = r / NI_E, q = r % NI_E, kb = q / 32, nb = q % 32;
        transpose_item_f8(a.in[IN_WDOWN] + ((size_t)L * NE + e) * DE * 1024, 1024, 64 * kb, 32 * nb, ws + (L ? WS_WD1 : WS_WD) + (size_t)e * 1024 * DEP, DEP, 32 * nb, F8_W, scr, lane); }
}
struct CvDesc { const float* src; unsigned char* dst; int ld, k0, n0, dstK, row0; };
__device__ __forceinline__ CvDesc cv_moe_desc(const Args& a, int L, int j) {
    constexpr int NI_E = CV_NI_E, NI_GU = CV_NI_GU; unsigned char* ws = a.ws; CvDesc d; int r = j;
    if (r < NI_GU) { const int e = r / (2 * NI_E), rr = r % (2 * NI_E), which = rr / NI_E, q = rr % NI_E, kb = q / 44, nb = q % 44, n0 = 32 * nb;
        d.src = (which ? a.in[IN_WUP] : a.in[IN_WGATE]) + ((size_t)L * NE + e) * 1024 * DE; d.ld = DE; d.k0 = 64 * kb; d.n0 = n0;
        d.dst = ws + (L ? WS_WGU1 : WS_WGU) + (size_t)e * 2816 * 1024; d.dstK = 1024; d.row0 = 256 * (n0 >> 7) + 128 * which + (n0 & 127); return d; }
    r -= NI_GU;
    { const int e = r / NI_E, q = r % NI_E, kb = q / 32, nb = q % 32;
        d.src = a.in[IN_WDOWN] + ((size_t)L * NE + e) * DE * 1024; d.ld = 1024; d.k0 = 64 * kb; d.n0 = 32 * nb;
        d.dst = ws + (L ? WS_WD1 : WS_WD) + (size_t)e * 1024 * DEP; d.dstK = DEP; d.row0 = 32 * nb; return d; }
}
__device__ __forceinline__ void cv_moe_quad(const Args& a, int L, int j, LAS float* scr, int lane) {
    const CvDesc d0 = cv_moe_desc(a, L, j), d1 = cv_moe_desc(a, L, j + 1), d2 = cv_moe_desc(a, L, j + 2), d3 = cv_moe_desc(a, L, j + 3);
    float la[32], lb[32], lc[32], ld[32];
    tr_load(d0.src, d0.ld, d0.k0, d0.n0, lane, la); tr_load(d1.src, d1.ld, d1.k0, d1.n0, lane, lb); tr_load(d2.src, d2.ld, d2.k0, d2.n0, lane, lc); tr_load(d3.src, d3.ld, d3.k0, d3.n0, lane, ld);
    tr_finish_f8(la, d0.dst, d0.dstK, d0.k0, d0.row0, F8_W, scr, lane); tr_finish_f8(lb, d1.dst, d1.dstK, d1.k0, d1.row0, F8_W, scr, lane);
    tr_finish_f8(lc, d2.dst, d2.dstK, d2.k0, d2.row0, F8_W, scr, lane); tr_finish_f8(ld, d3.dst, d3.dstK, d3.k0, d3.row0, F8_W, scr, lane);
}
static_assert(CV_NQ % 32 == 0, "queue length");
__device__ __forceinline__ void ph_convert_static(const Args& a, int L, LAS unsigned char* lds, int vcu, int G, int wave, int lane) {
    LAS float* scr = (LAS float*)(lds + wave * 16384);
    const int gw = vcu * 8 + wave, NGW = G * 8;
    for (int it = gw; it < CV_M0; it += NGW) cv_item(a, L, it, scr, lane);
}
__device__ __forceinline__ void cvq_pull(const Args& a, int L, LAS unsigned char* lds, volatile LAS unsigned* misc, int wave, int lane, const unsigned* done, unsigned target) {
    LAS float* scr = (LAS float*)(lds + wave * 16384);
    unsigned* head = (unsigned*)(a.ws + WS_CTL) + 64 + 64 * L;
    for (;;) {
        __syncthreads();
        if (wave == 0 && lane == 0) { unsigned h = (unsigned)CV_NQ;
            if (done == nullptr || __hip_atomic_load(done, __ATOMIC_RELAXED, __HIP_MEMORY_SCOPE_AGENT) < target) h = __hip_atomic_fetch_add(head, 32u, __ATOMIC_RELAXED, __HIP_MEMORY_SCOPE_AGENT);
            misc[16] = h; }
        __syncthreads();
        const unsigned h = misc[16];
        if (h >= (unsigned)CV_NQ) break;
        cv_moe_quad(a, L, (int)(h + 4u * (unsigned)wave), scr, lane);
    }
}
__device__ __forceinline__ unsigned* cv_done_ctr(const Args& a, int k) { return (unsigned*)(a.ws + WS_CTL) + 256 + 64 * k; }

__device__ __forceinline__ void row_load(const float* p, int lane, f32x4 (&v)[4]) {
#pragma unroll
    for (int j = 0; j < 4; ++j) v[j] = __builtin_nontemporal_load((const f32x4*)p + lane + 64 * j);
}
__device__ __forceinline__ void row_load_bf(const bf16* p, int lane, f32x4 (&v)[4]) {
#pragma unroll
    for (int j = 0; j < 4; ++j) { const u32x2 w = __builtin_nontemporal_load((const u32x2*)p + lane + 64 * j); v[j] = (f32x4){bf_lo(w.x), bf_hi(w.x), bf_lo(w.y), bf_hi(w.y)}; }
}
__device__ __forceinline__ void row_store_bf(bf16* p, int lane, const f32x4 (&v)[4]) {
#pragma unroll
    for (int j = 0; j < 4; ++j) { u32x2 w; w.x = cvt_pk_bf16(v[j].x, v[j].y); w.y = cvt_pk_bf16(v[j].z, v[j].w); __builtin_nontemporal_store(w, (u32x2*)p + lane + 64 * j); }
}
__device__ __forceinline__ float row_rstd(const f32x4 (&v)[4], int lane) {
    float s = 0.f;
#pragma unroll
    for (int j = 0; j < 4; ++j) s += (v[j].x * v[j].x + v[j].y * v[j].y) + (v[j].z * v[j].z + v[j].w * v[j].w);
    return __builtin_amdgcn_rsqf(wave_sum(s, lane) * (1.0f / D) + EPS);
}
__device__ __forceinline__ void row_mod_store(const f32x4 (&v)[4], float rstd, const float* gn, const float* shift, const float* scale, bf16* hrow, int lane) {
#pragma unroll
    for (int j = 0; j < 4; ++j) { const int c = 4 * lane + 256 * j; const f32x4 g = *(const f32x4*)(gn + c), sh = *(const f32x4*)(shift + c), sc = *(const f32x4*)(scale + c);
        const f32x4 h = v[j] * rstd * g * (sc + 1.0f) + sh;
        u32x2 w; w.x = cvt_pk_bf16(h.x, h.y); w.y = cvt_pk_bf16(h.z, h.w); *(u32x2*)(hrow + c) = w; }
}
constexpr int WT_STRIDE = 2064;
__device__ __forceinline__ void stage_wt(const bf16* wt, LAS unsigned char* lds, int tid) {
    for (int i = tid; i < 16 * 128; i += 512) { const int r = i >> 7, ch = i & 127; *(LAS u32x4*)(lds + r * WT_STRIDE + ch * 16) = *(const u32x4*)(wt + r * 1024 + ch * 8); }
    __syncthreads();
}
template <bool TOKFIRST, bool ROWS8 = false>
__device__ __forceinline__ f32x4 skinny16(const bf16* hrows, LAS unsigned char* wl, int lane) {
    const int r = lane & 15, g = lane >> 4;
    f32x4 acc = (f32x4){0.f, 0.f, 0.f, 0.f};
    const bf16* hp = hrows + (size_t)(ROWS8 ? (r & 7) : r) * 1024 + 8 * g;
    const LAS unsigned char* wp = wl + r * WT_STRIDE + 16 * g;
#pragma unroll
    for (int kb = 0; kb < 2; ++kb) {
        bf16x8 hf[16];
#pragma unroll
        for (int k = 0; k < 16; ++k) hf[k] = __builtin_nontemporal_load((const bf16x8*)(hp + 32 * (kb * 16 + k)));
#pragma unroll
        for (int k = 0; k < 16; ++k) { const bf16x8 wf = *(const LAS bf16x8*)(wp + 64 * (kb * 16 + k));
            acc = TOKFIRST ? __builtin_amdgcn_mfma_f32_16x16x32_bf16(hf[k], wf, acc, 0, 0, 0) : __builtin_amdgcn_mfma_f32_16x16x32_bf16(wf, hf[k], acc, 0, 0, 0); }
    }
    return acc;
}

__device__ __forceinline__ int row_cond(int row) { return row < NLAT ? (row >> 13) : 8; }

__device__ __forceinline__ float logsigmoid(float x) { float c1 = -LOG2E, c2 = 0.6931471805599453f; asm volatile("" : "+v"(c1), "+v"(c2));
    return fminf(x, 0.f) - c2 * __builtin_amdgcn_logf(1.0f + fexp2(fabsf(x) * c1)); }
__device__ __forceinline__ void gates_store(const f32x4 acc, const float* gate_b_l, float* gates, int row0, int lane, int nrows = 16) {
    const int fq = lane >> 4; const f32x4 gb = *(const f32x4*)(gate_b_l + 4 * fq);
    f32x4 v = acc + gb;
    if (fq & 1) { v.x = logsigmoid(v.x); v.y = logsigmoid(v.y); v.z = logsigmoid(v.z); v.w = logsigmoid(v.w); }
    if ((lane & 15) < nrows) *(f32x4*)(gates + (size_t)(row0 + (lane & 15)) * 16 + 4 * fq) = v;
}
__device__ __forceinline__ void router_store(const f32x4 acc, float* afft, int row0, int lane, int nrows = 16) {
    f32x4 mx = acc;
#pragma unroll
    for (int o = 1; o < 16; o <<= 1) { f32x4 t; t.x = shx(mx.x, o, lane); t.y = shx(mx.y, o, lane); t.z = shx(mx.z, o, lane); t.w = shx(mx.w, o, lane);
        mx.x = fmaxf(mx.x, t.x); mx.y = fmaxf(mx.y, t.y); mx.z = fmaxf(mx.z, t.z); mx.w = fmaxf(mx.w, t.w); }
    f32x4 ex; ex.x = __expf(acc.x - mx.x); ex.y = __expf(acc.y - mx.y); ex.z = __expf(acc.z - mx.z); ex.w = __expf(acc.w - mx.w);
    f32x4 sm = ex;
#pragma unroll
    for (int o = 1; o < 16; o <<= 1) { f32x4 t; t.x = shx(sm.x, o, lane); t.y = shx(sm.y, o, lane); t.z = shx(sm.z, o, lane); t.w = shx(sm.w, o, lane); sm = sm + t; }
    f32x4 o4; o4.x = ex.x / sm.x; o4.y = ex.y / sm.y; o4.z = ex.z / sm.z; o4.w = ex.w / sm.w;
    if (4 * (lane >> 4) < nrows) *(f32x4*)(afft + (size_t)(lane & 15) * NTOK + row0 + 4 * (lane >> 4)) = o4;
}

struct ModRegs { f32x4 gs[4], sh[4]; };
__device__ __forceinline__ ModRegs mod_load(const float* gn, const float* shift, const float* scale, int lane) {
    ModRegs m;
#pragma unroll
    for (int j = 0; j < 4; ++j) { const int c = 4 * lane + 256 * j; m.gs[j] = *(const f32x4*)(gn + c) * (*(const f32x4*)(scale + c) + 1.0f); m.sh[j] = *(const f32x4*)(shift + c); }
    return m;
}
template <bool F8 = false, bool LROW = false>
__device__ __forceinline__ void row_mod_store2(const f32x4 (&v)[4], float rstd, const ModRegs& m, bf16* hrow, int lane, unsigned char* h8row = nullptr, LAS unsigned char* lrow = nullptr) {
#pragma unroll
    for (int j = 0; j < 4; ++j) { const f32x4 h = v[j] * rstd * m.gs[j] + m.sh[j];
        u32x2 w; w.x = cvt_pk_bf16(h.x, h.y); w.y = cvt_pk_bf16(h.z, h.w); *(u32x2*)(hrow + 4 * lane + 256 * j) = w;
        if (LROW) *(LAS u32x2*)(lrow + 8 * lane + 512 * j) = w;
        if (F8) { const f32x4 hs = h * F8_H; *(unsigned*)(h8row + 4 * lane + 256 * j) = cvt4_fp8(hs.x, hs.y, hs.z, hs.w); } }
}
template <bool SRC_BF, bool F8 = false>
__device__ __forceinline__ void rows16_norm(const void* src, bf16* hdst, bf16* xcopy, const ModRegs& m, int lane, unsigned char* h8dst = nullptr) {
    f32x4 va[4][4], vb[4][4];
#define R16_LOAD(dst, r0) do { _Pragma("unroll") for (int q = 0; q < 4; ++q) { if (SRC_BF) row_load_bf((const bf16*)src + (size_t)((r0) + q) * D, lane, dst[q]); else row_load((const float*)src + (size_t)((r0) + q) * D, lane, dst[q]); } } while (0)
#define R16_PROC(vv, r0) do { _Pragma("unroll") for (int q = 0; q < 4; ++q) { if (!SRC_BF) row_store_bf(xcopy + (size_t)((r0) + q) * D, lane, vv[q]); \
        const float rstd = row_rstd(vv[q], lane); row_mod_store2<F8>(vv[q], rstd, m, hdst + (size_t)((r0) + q) * D, lane, F8 ? h8dst + (size_t)((r0) + q) * D : nullptr); } } while (0)
    R16_LOAD(va, 0); R16_LOAD(vb, 4); R16_PROC(va, 0); R16_LOAD(va, 8); R16_PROC(vb, 4); R16_LOAD(vb, 12); R16_PROC(va, 8); R16_PROC(vb, 12);
#undef R16_LOAD
#undef R16_PROC
}

constexpr int RB_STRIDE = 2112;
template <bool TOKFIRST>
__device__ __forceinline__ f32x4 skinny4_lds(const LAS unsigned char* rb, const LAS unsigned char* wl, int lane) {
    const LAS unsigned char* hp = rb + (lane & 3) * RB_STRIDE + 16 * (lane >> 4); const LAS unsigned char* wp = wl + (lane & 15) * WT_STRIDE + 16 * (lane >> 4);
    f32x4 ab = {0.f, 0.f, 0.f, 0.f};
#pragma unroll 1
    for (int kb = 0; kb < 4; ++kb) { bf16x8 hf[8], wf[8];
#pragma unroll
        for (int k = 0; k < 8; ++k) { hf[k] = *(const LAS bf16x8*)(hp + 512 * kb + 64 * k); wf[k] = *(const LAS bf16x8*)(wp + 512 * kb + 64 * k); }
#pragma unroll
        for (int k = 0; k < 8; ++k) ab = TOKFIRST ? __builtin_amdgcn_mfma_f32_16x16x32_bf16(hf[k], wf[k], ab, 0, 0, 0) : __builtin_amdgcn_mfma_f32_16x16x32_bf16(wf[k], hf[k], ab, 0, 0, 0); }
    return ab;
}
__device__ __forceinline__ f32x4 rows16_norm_router(const bf16* src, unsigned char* h8dst, const ModRegs& m, LAS unsigned char* rb, LAS unsigned char* wl, int lane) {
    f32x4 va[4][4], vb[4][4]; f32x4 acc = {0.f, 0.f, 0.f, 0.f};
#define R16_LOAD(dst, r0) do { _Pragma("unroll") for (int q = 0; q < 4; ++q) row_load_bf(src + (size_t)((r0) + q) * D, lane, dst[q]); } while (0)
#define R16_PROC(vv, r0, b) do { _Pragma("unroll") for (int q = 0; q < 4; ++q) { const float rstd = row_rstd(vv[q], lane); \
        _Pragma("unroll") for (int j = 0; j < 4; ++j) { const f32x4 h = vv[q][j] * rstd * m.gs[j] + m.sh[j]; u32x2 w; w.x = cvt_pk_bf16(h.x, h.y); w.y = cvt_pk_bf16(h.z, h.w); \
            *(LAS u32x2*)(rb + q * RB_STRIDE + 8 * lane + 512 * j) = w; const f32x4 hs = h * F8_H; *(unsigned*)(h8dst + (size_t)((r0) + q) * D + 4 * lane + 256 * j) = cvt4_fp8(hs.x, hs.y, hs.z, hs.w); } } \
        LDS_WAIT(); const f32x4 ab = skinny4_lds<true>(rb, wl, lane); if ((lane >> 4) == (b)) acc = ab; LDS_WAIT(); } while (0)
    R16_LOAD(va, 0); R16_LOAD(vb, 4); R16_PROC(va, 0, 0); R16_LOAD(va, 8); R16_PROC(vb, 4, 1); R16_LOAD(vb, 12); R16_PROC(va, 8, 2); R16_PROC(vb, 12, 3);
#undef R16_LOAD
#undef R16_PROC
    return acc;
}
__device__ __forceinline__ f32x4 rows16_norm_gates(const float* src, bf16* hdst, bf16* xcopy, const ModRegs& m, LAS unsigned char* rb, LAS unsigned char* wl, int lane) {
    f32x4 va[4][4], vb[4][4]; f32x4 acc = {0.f, 0.f, 0.f, 0.f};
#define R16_LOAD(dst, r0) do { _Pragma("unroll") for (int q = 0; q < 4; ++q) row_load(src + (size_t)((r0) + q) * D, lane, dst[q]); } while (0)
#define R16_PROC(vv, r0, b) do { _Pragma("unroll") for (int q = 0; q < 4; ++q) { row_store_bf(xcopy + (size_t)((r0) + q) * D, lane, vv[q]); const float rstd = row_rstd(vv[q], lane); \
        _Pragma("unroll") for (int j = 0; j < 4; ++j) { const f32x4 h = vv[q][j] * rstd * m.gs[j] + m.sh[j]; u32x2 w; w.x = cvt_pk_bf16(h.x, h.y); w.y = cvt_pk_bf16(h.z, h.w); \
            *(LAS u32x2*)(rb + q * RB_STRIDE + 8 * lane + 512 * j) = w; *(u32x2*)(hdst + (size_t)((r0) + q) * D + 4 * lane + 256 * j) = w; } } \
        LDS_WAIT(); const f32x4 ab = skinny4_lds<false>(rb, wl, lane); if (((lane & 15) >> 2) == (b)) acc = ab; LDS_WAIT(); } while (0)
    R16_LOAD(va, 0); R16_LOAD(vb, 4); R16_PROC(va, 0, 0); R16_LOAD(va, 8); R16_PROC(vb, 4, 1); R16_LOAD(vb, 12); R16_PROC(va, 8, 2); R16_PROC(vb, 12, 3);
#undef R16_LOAD
#undef R16_PROC
    return acc;
}

template <bool SRC_BF, bool F8 = false>
__device__ __forceinline__ void row1_norm(const void* src, bf16* hdst, bf16* xcopy, const ModRegs& m, int lane, unsigned char* h8dst = nullptr) {
    f32x4 v[4];
    if (SRC_BF) row_load_bf((const bf16*)src, lane, v); else { row_load((const float*)src, lane, v); row_store_bf(xcopy, lane, v); }
    const float rstd = row_rstd(v, lane); row_mod_store2<F8>(v, rstd, m, hdst, lane, h8dst);
}

__device__ __forceinline__ void ph_prepass1_l0(const Args& a, LAS unsigned char* lds, int vcu, int G, int tid, int wave, int lane) {
    unsigned char* ws = a.ws; const int L = 0;
    LAS unsigned char* wl = lds;
    stage_wt((const bf16*)(ws + WS_WG) + (size_t)L * 16 * 1024, wl, tid);
    const float* modv = (const float*)(ws + WS_MODV) + (size_t)L * 9 * 6144; const float* gn = a.in[IN_G1] + L * 1024;
    bf16* H = (bf16*)a.out; float* gates = (float*)(ws + WS_GATES);
    for (int grp = vcu * 8 + wave; grp < NLAT / 16; grp += G * 8) {
        const int row0 = grp * 16, g = row_cond(row0);
        const float* src = a.in[IN_X] + (size_t)row0 * D;
        const ModRegs m = mod_load(gn, modv + g * 6144 + 0 * 1024, modv + g * 6144 + 1 * 1024, lane);
        const f32x4 acc = rows16_norm_gates(src, H + (size_t)row0 * D, (bf16*)(ws + WS_XB) + (size_t)row0 * D, m, lds + 34816 + wave * (4 * RB_STRIDE), wl, lane);
        gates_store(acc, a.in[IN_GATEB] + L * 16, gates, row0, lane);
    }
    for (int blk = vcu; blk < NCTX / 8; blk += G) {
        const int row0 = NLAT + 8 * blk, row = row0 + wave;
        const ModRegs m = mod_load(gn, modv + 8 * 6144 + 0 * 1024, modv + 8 * 6144 + 1 * 1024, lane);
        row1_norm<false>(a.in[IN_CTX] + (size_t)(row - NLAT) * D, H + (size_t)row * D, (bf16*)(ws + WS_XC) + (size_t)(row - NLAT) * D, m, lane);
        VM_WAIT(); __syncthreads();
        if (wave == 0) { const f32x4 acc = skinny16<false, true>(H + (size_t)row0 * D, wl, lane); gates_store(acc, a.in[IN_GATEB] + L * 16, gates, row0, lane, 8); }
    }
}

__device__ __forceinline__ void ph_prepass2(const Args& a, int L, LAS unsigned char* lds, int vcu, int G, int tid, int wave, int lane) {
    unsigned char* ws = a.ws;
    LAS unsigned char* wl = lds;
    stage_wt((const bf16*)(ws + WS_WR) + (size_t)L * 16 * 1024, wl, tid);
    const float* modv = (const float*)(ws + WS_MODV) + (size_t)L * 9 * 6144; const float* gn = a.in[IN_G2] + L * 1024;
    bf16* H = (bf16*)a.out; unsigned char* H8 = (unsigned char*)a.out + OUT_H8; float* afft = (float*)(ws + WS_AFFT);
    for (int grp = vcu * 8 + wave; grp < NLAT / 16; grp += G * 8) {
        const int row0 = grp * 16, g = row_cond(row0);
        const bf16* src = (const bf16*)(ws + WS_XB) + (size_t)row0 * D;
        const ModRegs m = mod_load(gn, modv + g * 6144 + 3 * 1024, modv + g * 6144 + 4 * 1024, lane);
        const f32x4 acc = rows16_norm_router(src, H8 + (size_t)row0 * D, m, lds + 34816 + wave * (4 * RB_STRIDE), wl, lane);
        router_store(acc, afft, row0, lane);
    }
    if (L == 0) for (int blk = vcu; blk < NCTX / 8; blk += G) {
        const int row0 = NLAT + 8 * blk, row = row0 + wave;
        const ModRegs m = mod_load(gn, modv + 8 * 6144 + 3 * 1024, modv + 8 * 6144 + 4 * 1024, lane);
        row1_norm<true, true>((const bf16*)(ws + WS_XC) + (size_t)(row - NLAT) * D, H + (size_t)row * D, nullptr, m, lane, H8 + (size_t)row * D);
        VM_WAIT(); __syncthreads();
        if (wave == 0) { const f32x4 acc = skinny16<true, true>(H + (size_t)row0 * D, wl, lane); router_store(acc, afft, row0, lane, 8); }
    }
}

template <int NR, bool LROW = false>
__device__ __forceinline__ void combine_rows(bf16* xs, bf16* hrows, float* orows, bool last, const int4 iv, int rbase, unsigned long long sel, unsigned long long sel1, unsigned long long sel2, unsigned long long sel3,
                                             const unsigned char* ye, const float* gsel, const f32x4 (&g2)[4], const ModRegs& m, int lane, LAS unsigned char* lrows = nullptr) {
    f32x4 v[NR][4];
#pragma unroll
    for (int q = 0; q < NR; ++q) row_load_bf(xs + (size_t)q * D, lane, v[q]);
    unsigned em[NR];
#pragma unroll
    for (int q = 0; q < NR; ++q) { const int rr = rbase + q; unsigned mk = 0u;
#pragma unroll
        for (int c = 0; c < 4; ++c) { const int ln = 4 * rr + c;
            mk |= (unsigned)((sel >> ln) & 1ull) << (4 * c) | (unsigned)((sel1 >> ln) & 1ull) << (4 * c + 1) | (unsigned)((sel2 >> ln) & 1ull) << (4 * c + 2) | (unsigned)((sel3 >> ln) & 1ull) << (4 * c + 3); }
        em[q] = mk; }
    f32x4 s[NR][4];
#pragma unroll
    for (int q = 0; q < NR; ++q)
#pragma unroll
        for (int j = 0; j < 4; ++j) s[q][j] = (f32x4){0.f, 0.f, 0.f, 0.f};
    {
        unsigned w[NR][4][4]; float gw[NR][4]; int nq[NR];
#pragma unroll
        for (int q = 0; q < NR; ++q) { const int rr = rbase + q; nq[q] = (int)__builtin_popcount(em[q]);
#pragma unroll
            for (int k4 = 0; k4 < 4; ++k4) if (k4 < nq[q]) { const int e = (int)__builtin_ctz(em[q]); em[q] &= em[q] - 1u;
                const int ln = 4 * rr + (e >> 2), k = e & 3;
                const int cand = k == 0 ? iv.x : (k == 1 ? iv.y : (k == 2 ? iv.z : iv.w));
                const int slot = shi(cand, ln);
                const unsigned char* yr = ye + (size_t)slot * D; gw[q][k4] = gsel[slot];
#pragma unroll
                for (int j = 0; j < 4; ++j) w[q][k4][j] = __builtin_nontemporal_load((const unsigned*)(yr + 4 * lane + 256 * j)); } }
#pragma unroll
        for (int q = 0; q < NR; ++q)
#pragma unroll
            for (int k4 = 0; k4 < 4; ++k4) if (k4 < nq[q]) {
#pragma unroll
                for (int j = 0; j < 4; ++j) { const f32x2 lo = __builtin_amdgcn_cvt_pk_f32_fp8((int)w[q][k4][j], false), hi = __builtin_amdgcn_cvt_pk_f32_fp8((int)w[q][k4][j], true);
                    s[q][j].x += gw[q][k4] * lo.x; s[q][j].y += gw[q][k4] * lo.y; s[q][j].z += gw[q][k4] * hi.x; s[q][j].w += gw[q][k4] * hi.y; } }
    }
    unsigned any = 0u;
#pragma unroll
    for (int q = 0; q < NR; ++q) any |= em[q];
    while (any) {
        unsigned w[NR][4]; float wt[NR];
#pragma unroll
        for (int q = 0; q < NR; ++q) { const int rr = rbase + q; int e = em[q] ? (int)__builtin_ctz(em[q]) : 0; wt[q] = em[q] ? 1.0f : 0.0f; em[q] &= em[q] - 1u;
            const int ln = 4 * rr + (e >> 2), k = e & 3;
            const int cand = k == 0 ? iv.x : (k == 1 ? iv.y : (k == 2 ? iv.z : iv.w));
            int slot = shi(cand, ln); slot = slot < 0 ? 0 : slot; wt[q] *= gsel[slot];
            const unsigned char* yr = ye + (size_t)slot * D;
#pragma unroll
            for (int j = 0; j < 4; ++j) w[q][j] = *(const unsigned*)(yr + 4 * lane + 256 * j); }
#pragma unroll
        for (int q = 0; q < NR; ++q)
#pragma unroll
            for (int j = 0; j < 4; ++j) { const f32x2 lo = __builtin_amdgcn_cvt_pk_f32_fp8((int)w[q][j], false), hi = __builtin_amdgcn_cvt_pk_f32_fp8((int)w[q][j], true);
                s[q][j].x += wt[q] * lo.x; s[q][j].y += wt[q] * lo.y; s[q][j].z += wt[q] * hi.x; s[q][j].w += wt[q] * hi.y; }
        any = 0u;
#pragma unroll
        for (int q = 0; q < NR; ++q) any |= em[q];
    }
#pragma unroll
    for (int q = 0; q < NR; ++q) {
#pragma unroll
        for (int j = 0; j < 4; ++j) v[q][j] = v[q][j] + g2[j] * s[q][j];
        const float rstd = row_rstd(v[q], lane);
        if (last) { float* orow = orows + (size_t)q * D;
#pragma unroll
            for (int j = 0; j < 4; ++j) __builtin_nontemporal_store(v[q][j] * rstd * m.gs[j], (f32x4*)orow + lane + 64 * j);
        } else {
            row_store_bf(xs + (size_t)q * D, lane, v[q]);
            row_mod_store2<false, LROW>(v[q], rstd, m, hrows + (size_t)q * D, lane, nullptr, LROW ? lrows + q * RB_STRIDE : nullptr);
        }
    }
}
__device__ __forceinline__ void ph_combine(const Args& a, int L, LAS unsigned char* lds, int vcu, int G, int tid, int wave, int lane) {
    unsigned char* ws = a.ws; const bool last = (L == DEPTH - 1);
    LAS unsigned char* wl = lds;
    if (!last) stage_wt((const bf16*)(ws + WS_WG) + (size_t)(L + 1) * 16 * 1024, wl, tid);
    const float* modv = (const float*)(ws + WS_MODV) + (size_t)L * 9 * 6144;
    const float* modn = (const float*)(ws + WS_MODV) + (size_t)(L + 1 < DEPTH ? L + 1 : L) * 9 * 6144;
    const float* gn = last ? a.in[IN_GFINAL] : a.in[IN_G1] + (L + 1) * 1024;
    bf16* H = (bf16*)a.out; float* gates = (float*)(ws + WS_GATES);
    const unsigned char* ye = ws + WS_XE; const float* gsel = (const float*)(ws + WS_GSEL); const int* inv = (const int*)(ws + WS_INV);
    for (int grp = vcu * 8 + wave; grp < NLAT / 16; grp += G * 8) {
        const int row0 = grp * 16, g = row_cond(row0);
        bf16* xs = (bf16*)(ws + WS_XB) + (size_t)row0 * D;
        int4 iv; { const int* ipx = inv + (size_t)(4 * (lane & 3)) * NTOK + row0 + (lane >> 2); iv.x = ipx[0]; iv.y = ipx[NTOK]; iv.z = ipx[2 * (size_t)NTOK]; iv.w = ipx[3 * (size_t)NTOK]; }
        ModRegs m; f32x4 g2[4];
#pragma unroll
        for (int j = 0; j < 4; ++j) g2[j] = *(const f32x4*)(modv + g * 6144 + 5 * 1024 + 4 * lane + 256 * j) * (1.0f / F8_YE);
        if (last) {
#pragma unroll
            for (int j = 0; j < 4; ++j) { m.gs[j] = *(const f32x4*)(gn + 4 * lane + 256 * j); m.sh[j] = (f32x4){0.f, 0.f, 0.f, 0.f}; }
        } else m = mod_load(gn, modn + g * 6144 + 0 * 1024, modn + g * 6144 + 1 * 1024, lane);
        const unsigned long long sel = __ballot(iv.x >= 0), sel1 = __ballot(iv.y >= 0), sel2 = __ballot(iv.z >= 0), sel3 = __ballot(iv.w >= 0);
        LAS unsigned char* rb = lds + 34816 + wave * (4 * RB_STRIDE);
        f32x4 acc = {0.f, 0.f, 0.f, 0.f};
#pragma unroll 1
        for (int r = 0; r < 16; r += 2) {
            combine_rows<2, true>(xs + (size_t)r * D, H + (size_t)(row0 + r) * D, a.out + (size_t)(row0 + r) * D, last, iv, r, sel, sel1, sel2, sel3, ye, gsel, g2, m, lane, rb + (r & 2) * RB_STRIDE);
            if (!last && (r & 2)) { LDS_WAIT(); const f32x4 ab = skinny4_lds<false>(rb, wl, lane); if (((lane & 15) >> 2) == (r >> 2)) acc = ab; LDS_WAIT(); } }
        if (!last) gates_store(acc, a.in[IN_GATEB] + (L + 1) * 16, gates, row0, lane);
    }
    if (!last) for (int blk = vcu; blk < NCTX / 8; blk += G) {
        const int row0 = NLAT + 8 * blk, row = row0 + wave;
        int4 iv; { const int* ipx = inv + (size_t)(4 * (lane & 3)) * NTOK + row; iv.x = ipx[0]; iv.y = ipx[NTOK]; iv.z = ipx[2 * (size_t)NTOK]; iv.w = ipx[3 * (size_t)NTOK]; }
        f32x4 g2[4];
#pragma unroll
        for (int j = 0; j < 4; ++j) g2[j] = *(const f32x4*)(modv + 8 * 6144 + 5 * 1024 + 4 * lane + 256 * j) * (1.0f / F8_YE);
        const ModRegs m = mod_load(gn, modn + 8 * 6144 + 0 * 1024, modn + 8 * 6144 + 1 * 1024, lane);
        const unsigned long long sel = __ballot(iv.x >= 0), sel1 = __ballot(iv.y >= 0), sel2 = __ballot(iv.z >= 0), sel3 = __ballot(iv.w >= 0);
        combine_rows<1>((bf16*)(ws + WS_XC) + (size_t)(row - NLAT) * D, H + (size_t)row * D, nullptr, false, iv, 0, sel, sel1, sel2, sel3, ye, gsel, g2, m, lane);
        VM_WAIT(); __syncthreads();
        if (wave == 0) { const f32x4 acc = skinny16<false, true>(H + (size_t)row0 * D, wl, lane); gates_store(acc, a.in[IN_GATEB] + (L + 1) * 16, gates, row0, lane, 8); }
    }
}

__device__ __forceinline__ unsigned img_off(unsigned row, unsigned ch) { return 256u * row + 16u * (ch ^ (((row & 3u) << 2) | ((row >> 2) & 3u))); }
__device__ __forceinline__ unsigned img_off_r(unsigned row, unsigned ch) { return 256u * row + 16u * (ch ^ (row & 15u)); }
__device__ __forceinline__ bf16x8 frag_rowr(const LAS unsigned char* img, int lane, int rb, int s) { return *(const LAS bf16x8*)(img + img_off_r((unsigned)((lane & 15) + 16 * rb), (unsigned)(4 * s + (lane >> 4)))); }
__device__ __forceinline__ bf16x8 frag_row(const LAS unsigned char* img, int lane, int rb, int s) { return *(const LAS bf16x8*)(img + img_off((unsigned)((lane & 15) + 16 * rb), (unsigned)(4 * s + (lane >> 4)))); }
__device__ __forceinline__ bf16x8 frag_tr(const LAS unsigned char* img, int lane, int c, int ks) {
    const unsigned g = (unsigned)lane >> 4, q = ((unsigned)lane & 15u) >> 2, p = (unsigned)lane & 3u;
    const s16x4 lo = __builtin_amdgcn_ds_read_tr16_b64_v4i16((LAS s16x4*)(img + img_off(32u * ks + 8u * g + q, 2u * c + (p >> 1)) + 8u * (p & 1u)));
    const s16x4 hi = __builtin_amdgcn_ds_read_tr16_b64_v4i16((LAS s16x4*)(img + img_off(32u * ks + 8u * g + 4u + q, 2u * c + (p >> 1)) + 8u * (p & 1u)));
    return __builtin_shufflevector(lo, hi, 0, 1, 2, 3, 4, 5, 6, 7);
}
__device__ __forceinline__ int chunk_row0(int b, int c) { return c < NCH_C ? NLAT + b * CTXL + c * 128 : b * SEQ + (c - NCH_C) * 128; }
__device__ __forceinline__ int state_idx(int b, int h, int c, int d) { return ((b * NH + h) * NCH + c) * 2 + d; }

struct GateScan { float b0, b1, g0, g1, cm0, cm1, B, G; };
template <int CTRL, int ROWMASK> __device__ __forceinline__ float dppf(float old, float src) { return __int_as_float(__builtin_amdgcn_update_dpp(__float_as_int(old), __float_as_int(src), CTRL, ROWMASK, 0xF, false)); }
__device__ __forceinline__ float wave_scan_add(float v) {
    v += dppf<0x111, 0xF>(0.f, v); v += dppf<0x112, 0xF>(0.f, v); v += dppf<0x114, 0xF>(0.f, v); v += dppf<0x118, 0xF>(0.f, v);
    v += dppf<0x142, 0xA>(0.f, v); v += dppf<0x143, 0xC>(0.f, v); return v;
}
__device__ __forceinline__ float wave_scan_max(float v) {
    const float ninf = -INFINITY;
    v = fmaxf(v, dppf<0x111, 0xF>(ninf, v)); v = fmaxf(v, dppf<0x112, 0xF>(ninf, v)); v = fmaxf(v, dppf<0x114, 0xF>(ninf, v)); v = fmaxf(v, dppf<0x118, 0xF>(ninf, v));
    v = fmaxf(v, dppf<0x142, 0xA>(ninf, v)); v = fmaxf(v, dppf<0x143, 0xC>(ninf, v)); return v;
}
__device__ __forceinline__ GateScan gate_scan(float iA, float iB, float lA, float lB) {
    GateScan o;
    const float inc = wave_scan_add(lA + lB);
    o.b1 = inc; o.b0 = inc - lB; o.B = rdl(inc, 63);
    o.g0 = iA - o.b0; o.g1 = iB - o.b1;
    const float pinc = wave_scan_max(fmaxf(o.g0, o.g1));
    const float pe = dppf<0x138, 0xF>(-INFINITY, pinc);
    o.cm0 = fmaxf(pe, o.g0); o.cm1 = fmaxf(o.cm0, o.g1); o.G = rdl(pinc, 63);
    return o;
}
__device__ __forceinline__ u32x4 scale_bf8(u32x4 v, float w) {
    u32x4 o; o.x = cvt_pk_bf16(bf_lo(v.x) * w, bf_hi(v.x) * w); o.y = cvt_pk_bf16(bf_lo(v.y) * w, bf_hi(v.y) * w); o.z = cvt_pk_bf16(bf_lo(v.z) * w, bf_hi(v.z) * w); o.w = cvt_pk_bf16(bf_lo(v.w) * w, bf_hi(v.w) * w); return o;
}

__device__ __forceinline__ void ph_mlstm_a(const Args& a, LAS unsigned char* lds, int vcu, int G, int tid, int wave, int lane) {
    unsigned char* ws = a.ws;
    const bf16* U = (const bf16*)(ws + WS_U); const float* gates = (const float*)(ws + WS_GATES);
    bf16* CS = (bf16*)(ws + WS_CS); float* NS = (float*)(ws + WS_NS); float* SCAL = (float*)(ws + WS_SCAL);
    LAS unsigned char* imgV = lds; LAS unsigned char* imgK0 = lds + 32768; LAS unsigned char* imgK1 = lds + 65536;
    LAS float* wtab = (LAS float*)(lds + TAB_OFF);
    const int wr4 = wave >> 1, wc2 = wave & 1, fr = lane & 15, fq = lane >> 4;
    constexpr int NUNITS = NB * NH * NCH;
    u32x4 kreg[4], vreg[4]; float pgi0 = 0.f, pgi1 = 0.f, pgf0 = 0.f, pgf1 = 0.f;
#define MA_DECODE(uu, b_, h_, c_, row0_) const int b_ = ((uu) & 31) >> 2, h_ = (uu) & 3, c_ = (uu) >> 5, row0_ = chunk_row0(b_, c_)
#define MA_PREFETCH(uu) do { MA_DECODE(uu, pb_, ph_, pc_, prow0_); (void)pb_; (void)pc_; \
        _Pragma("unroll") for (int i = 0; i < 4; ++i) { const int id = tid + 512 * i, r = id >> 4, ch = id & 15; const bf16* rp = U + (size_t)(prow0_ + r) * NU + 128 * ph_ + 8 * ch; \
            kreg[i] = __builtin_nontemporal_load((const u32x4*)(rp + UC_K)); vreg[i] = __builtin_nontemporal_load((const u32x4*)(rp + UC_V)); } \
        if (wave < 2) { const float* gp = gates + (size_t)(prow0_ + (wave ? 127 - 2 * lane : 2 * lane)) * 16 + ph_; const int gs_ = wave ? -16 : 16; pgi0 = gp[(2 * wave) * 4]; pgi1 = gp[gs_ + (2 * wave) * 4]; pgf0 = gp[(2 * wave + 1) * 4]; pgf1 = gp[gs_ + (2 * wave + 1) * 4]; } } while (0)
    if (vcu < NUNITS) MA_PREFETCH(vcu);
    for (int u = vcu; u < NUNITS; u += G) {
        MA_DECODE(u, b, h, c, row0); (void)row0;
        if (wave < 2) { const int d = wave, tA = d ? 127 - 2 * lane : 2 * lane, tB = d ? tA - 1 : tA + 1;
            const GateScan gs = gate_scan(pgi0, pgi1, pgf0, pgf1);
            wtab[d * 128 + tA] = fexp(gs.g0 - gs.G); wtab[d * 128 + tB] = fexp(gs.g1 - gs.G);
            if (lane == 0) { float* sc = SCAL + (size_t)state_idx(b, h, c, d) * 4; sc[0] = gs.B; sc[1] = gs.B + gs.G; } }
        __syncthreads();
#pragma unroll
        for (int i = 0; i < 4; ++i) { const int id = tid + 512 * i, r = id >> 4, ch = id & 15; const unsigned o = img_off((unsigned)r, (unsigned)ch);
            *(LAS u32x4*)(imgV + o) = vreg[i]; *(LAS u32x4*)(imgK0 + o) = scale_bf8(kreg[i], wtab[r]); *(LAS u32x4*)(imgK1 + o) = scale_bf8(kreg[i], wtab[128 + r]); }
        if (u + G < NUNITS) MA_PREFETCH(u + G);
        __syncthreads();
        f32x4 acc[2][2][4], accn[2];
#pragma unroll
        for (int d = 0; d < 2; ++d) { accn[d] = (f32x4){0.f, 0.f, 0.f, 0.f};
#pragma unroll
            for (int ni = 0; ni < 4; ++ni)
#pragma unroll
                for (int mi = 0; mi < 2; ++mi) acc[d][mi][ni] = (f32x4){0.f, 0.f, 0.f, 0.f}; }
        const bf16x8 onesf = {(short)0x3f80, (short)0x3f80, (short)0x3f80, (short)0x3f80, (short)0x3f80, (short)0x3f80, (short)0x3f80, (short)0x3f80};
#pragma unroll 1
        for (int ks = 0; ks < 4; ++ks) {
            bf16x8 vf[2];
#pragma unroll
            for (int mi = 0; mi < 2; ++mi) vf[mi] = frag_tr(imgV, lane, 2 * wr4 + mi, ks);
#pragma unroll
            for (int d = 0; d < 2; ++d)
#pragma unroll
                for (int ni = 0; ni < 4; ++ni) { const bf16x8 kf = frag_tr(d ? imgK1 : imgK0, lane, 4 * wc2 + ni, ks);
#pragma unroll
                    for (int mi = 0; mi < 2; ++mi) acc[d][mi][ni] = __builtin_amdgcn_mfma_f32_16x16x32_bf16(kf, vf[mi], acc[d][mi][ni], 0, 0, 0);
                    if (ni == wr4) accn[d] = __builtin_amdgcn_mfma_f32_16x16x32_bf16(kf, onesf, accn[d], 0, 0, 0); }
        }
        if (fr == 0) {
#pragma unroll
            for (int d = 0; d < 2; ++d) *(f32x4*)(NS + (size_t)state_idx(b, h, c, d) * 128 + 64 * wc2 + 16 * wr4 + 4 * fq) = accn[d]; }
#pragma unroll
        for (int d = 0; d < 2; ++d) { bf16* cs = CS + (size_t)state_idx(b, h, c, d) * 16384;
#pragma unroll
            for (int mi = 0; mi < 2; ++mi)
#pragma unroll
                for (int ni = 0; ni < 4; ++ni) { const int vd = 32 * wr4 + 16 * mi + fr, kd0 = 64 * wc2 + 16 * ni + 4 * fq; const f32x4 v = acc[d][mi][ni];
                    u32x2 w; w.x = cvt_pk_bf16(v[0], v[1]); w.y = cvt_pk_bf16(v[2], v[3]); *(u32x2*)(cs + vd * 128 + kd0) = w; } }
        __syncthreads();
    }
}

#undef MA_DECODE
#undef MA_PREFETCH
__device__ __forceinline__ int scan_chunk(int d, int p) { return d == 0 ? p : (p < NCH_C ? NCH_C - 1 - p : NCH + NCH_C - 1 - p); }
__device__ __forceinline__ void ph_scan(const Args& a, LAS unsigned char* lds, int vcu, int G, int tid) {
    unsigned char* ws = a.ws;
    bf16* CS = (bf16*)(ws + WS_CS); float* NS = (float*)(ws + WS_NS); float* SCAL = (float*)(ws + WS_SCAL);
    LAS float* coef = (LAS float*)lds;
    const int lane = tid & 63;
    for (int w0 = vcu * 512; w0 < NB * NH * 2 * 2048; w0 += G * 512) {
        const int seq = w0 >> 11, d = seq & 1, bh = seq >> 1, chunk = (w0 & 2047) + tid;
        if (tid < 64) {
            const int p1 = lane + 64; const bool has1 = p1 < NCH;
            float* sc0 = SCAL + (size_t)((bh * NCH + scan_chunk(d, lane)) * 2 + d) * 4;
            float* sc1 = SCAL + (size_t)((bh * NCH + scan_chunk(d, has1 ? p1 : 0)) * 2 + d) * 4;
            const float B0 = sc0[0], ml0 = sc0[1], B1 = sc1[0], ml1 = sc1[1];
            float m = 0.f, ca0 = 0.f, cb0 = 0.f, mp0 = 0.f, ca1 = 0.f, cb1 = 0.f, mp1 = 0.f;
            for (int p = 0; p < NCH; ++p) { const float B = p < 64 ? rdl(B0, p) : rdl(B1, p - 64), ml = p < 64 ? rdl(ml0, p) : rdl(ml1, p - 64);
                const float mn = fmaxf(B + m, ml), ca = fexp(B + m - mn), cb = fexp(ml - mn);
                if (lane == (p & 63)) { if (p < 64) { ca0 = ca; cb0 = cb; mp0 = m; } else { ca1 = ca; cb1 = cb; mp1 = m; } }
                m = mn; }
            coef[2 * lane] = ca0; coef[2 * lane + 1] = cb0; if (has1) { coef[2 * p1] = ca1; coef[2 * p1 + 1] = cb1; }
            if ((w0 & 2047) == 0) { sc0[2] = mp0; if (has1) sc1[2] = mp1; }
        }
        __syncthreads();
        float st[8];
#pragma unroll
        for (int j = 0; j < 8; ++j) st[j] = 0.f;
        u32x4* base = (u32x4*)(CS + (size_t)(bh * NCH) * 2 * 16384) + chunk;
#define SCAN_PTR(p) (base + (size_t)(scan_chunk(d, (p)) * 2 + d) * 2048)
#define SCAN_STEP(reg, p) do { const u32x4 dc = reg; if ((p) + 6 < NCH) reg = *SCAN_PTR((p) + 6); \
            u32x4 o; o.x = cvt_pk_bf16(st[0], st[1]); o.y = cvt_pk_bf16(st[2], st[3]); o.z = cvt_pk_bf16(st[4], st[5]); o.w = cvt_pk_bf16(st[6], st[7]); *SCAN_PTR(p) = o; \
            const float ca = coef[2 * (p)], cb = coef[2 * (p) + 1]; \
            st[0] = ca * st[0] + cb * bf_lo(dc.x); st[1] = ca * st[1] + cb * bf_hi(dc.x); st[2] = ca * st[2] + cb * bf_lo(dc.y); st[3] = ca * st[3] + cb * bf_hi(dc.y); \
            st[4] = ca * st[4] + cb * bf_lo(dc.z); st[5] = ca * st[5] + cb * bf_hi(dc.z); st[6] = ca * st[6] + cb * bf_lo(dc.w); st[7] = ca * st[7] + cb * bf_hi(dc.w); } while (0)
        u32x4 r0 = *SCAN_PTR(0), r1 = *SCAN_PTR(1), r2 = *SCAN_PTR(2), r3 = *SCAN_PTR(3), r4 = *SCAN_PTR(4), r5 = *SCAN_PTR(5);
        for (int p = 0; p < NCH; p += 6) { SCAN_STEP(r0, p); SCAN_STEP(r1, p + 1); SCAN_STEP(r2, p + 2); SCAN_STEP(r3, p + 3); SCAN_STEP(r4, p + 4); SCAN_STEP(r5, p + 5); }
#undef SCAN_STEP
#undef SCAN_PTR
        if ((w0 & 2047) == 0 && tid < 128) {
            float* nb = NS + (size_t)(bh * NCH) * 2 * 128 + tid;
#define NPTR(p) (nb + (size_t)(scan_chunk(d, (p)) * 2 + d) * 128)
#define NSTEP(reg, p) do { const float dn = reg; if ((p) + 6 < NCH) reg = *NPTR((p) + 6); *NPTR(p) = sn; sn = coef[2 * (p)] * sn + coef[2 * (p) + 1] * dn; } while (0)
            float sn = 0.f, n0 = *NPTR(0), n1 = *NPTR(1), n2 = *NPTR(2), n3 = *NPTR(3), n4 = *NPTR(4), n5 = *NPTR(5);
            for (int p = 0; p < NCH; p += 6) { NSTEP(n0, p); NSTEP(n1, p + 1); NSTEP(n2, p + 2); NSTEP(n3, p + 3); NSTEP(n4, p + 4); NSTEP(n5, p + 5); }
#undef NSTEP
#undef NPTR
        }
        __syncthreads();
    }
}

__device__ __forceinline__ void ph_mlstm_c2(const Args& a, int L, LAS unsigned char* lds, int vcu, int G, int tid, int wave, int lane) {
    unsigned char* ws = a.ws;
    const bf16* U = (const bf16*)(ws + WS_U); const float* gates = (const float*)(ws + WS_GATES);
    const bf16* CS = (const bf16*)(ws + WS_CS); const float* NS = (const float*)(ws + WS_NS); const float* SCAL = (const float*)(ws + WS_SCAL);
    bf16* H = (bf16*)a.out; const float* ghead = a.in[IN_GHEAD] + L * NH * DH;
    LAS unsigned char* imgK = lds; LAS unsigned char* imgV = lds + 32768; LAS unsigned char* imgC0 = lds + 65536; LAS unsigned char* imgC1 = lds + 65536 + 36864;
    LAS float* T_A = (LAS float*)(lds + 139264); LAS float* T_B = T_A + 256; LAS float* T_WI = T_B + 256; LAS float* T_FL = T_WI + 256;
    const int fr = lane & 15, fq = lane >> 4, t_loc = 16 * wave + fr;
    if (tid >= 16 && tid < 256) { const unsigned o = img_off_r((unsigned)(128 + (tid >> 4)), (unsigned)(tid & 15)); const u32x4 z = {0u, 0u, 0u, 0u}; *(LAS u32x4*)(imgC0 + o) = z; *(LAS u32x4*)(imgC1 + o) = z; }
    const int c_lo = (L == DEPTH - 1) ? NCH_C : 0, nunits = NB * NH * (NCH - c_lo);
    u32x4 pk[4], pv[4], pcf[4], pcb[4]; bf16x8 pq[4]; float pgi0 = 0.f, pgi1 = 0.f, pgf0 = 0.f, pgf1 = 0.f, pmp = 0.f; f32x4 pn0 = (f32x4){0.f, 0.f, 0.f, 0.f}, pn1 = (f32x4){0.f, 0.f, 0.f, 0.f};
#define C2_DECODE(uu, b_, h_, c_, row0_) const int b_ = ((uu) & 31) >> 2, h_ = (uu) & 3, c_ = c_lo + ((uu) >> 5), row0_ = chunk_row0(b_, c_)
#define C2_PREQ(uu) do { C2_DECODE(uu, pb_, ph_, pc_, prow0_); if (wave < 2) pmp = SCAL[(size_t)(state_idx(pb_, ph_, pc_, 0) + wave) * 4 + 2]; \
        _Pragma("unroll") for (int ks = 0; ks < 4; ++ks) pq[ks] = *(const bf16x8*)(U + (size_t)(prow0_ + t_loc) * NU + UC_Q + 128 * ph_ + 32 * ks + 8 * fq); } while (0)
#define C2_PRE1(uu) do { C2_DECODE(uu, pb_, ph_, pc_, prow0_); \
        _Pragma("unroll") for (int i = 0; i < 4; ++i) { const int id = tid + 512 * i; pk[i] = *(const u32x4*)(U + (size_t)(prow0_ + (id >> 4)) * NU + 128 * ph_ + 8 * (id & 15) + UC_K); } \
        if (wave < 2) { const float* gp = gates + (size_t)(prow0_ + (wave ? 127 - 2 * lane : 2 * lane)) * 16 + ph_; const int gs_ = wave ? -16 : 16; pgi0 = gp[(2 * wave) * 4]; pgi1 = gp[gs_ + (2 * wave) * 4]; pgf0 = gp[(2 * wave + 1) * 4]; pgf1 = gp[gs_ + (2 * wave + 1) * 4]; } } while (0)
#define C2_PRE2(uu) do { C2_DECODE(uu, pb_, ph_, pc_, prow0_); const int psi_ = state_idx(pb_, ph_, pc_, 0); \
        _Pragma("unroll") for (int i = 0; i < 4; ++i) { const int id = tid + 512 * i; pv[i] = *(const u32x4*)(U + (size_t)(prow0_ + (id >> 4)) * NU + 128 * ph_ + 8 * (id & 15) + UC_V); \
            pcf[i] = *((const u32x4*)(CS + (size_t)psi_ * 16384) + id); pcb[i] = *((const u32x4*)(CS + (size_t)(psi_ + 1) * 16384) + id); } \
        if (tid < 32) { const float* np = NS + (size_t)(psi_ + (tid >> 4)) * 128 + 8 * (tid & 15); pn0 = *(const f32x4*)np; pn1 = *(const f32x4*)(np + 4); } } while (0)
    for (int u = vcu; u < nunits; u += G) {
        C2_DECODE(u, b, h, c, row0); (void)b; (void)c;
        C2_PRE1(u); C2_PREQ(u); C2_PRE2(u);
        if (wave < 2) { const int d = wave, tA = d ? 127 - 2 * lane : 2 * lane, tB = d ? tA - 1 : tA + 1;
            const GateScan gs = gate_scan(pgi0, pgi1, pgf0, pgf1);
            const float M0 = fmaxf(pmp, gs.cm0), M1 = fmaxf(pmp, gs.cm1);
            T_A[d * 128 + tA] = fexp(gs.g0 - gs.G); T_A[d * 128 + tB] = fexp(gs.g1 - gs.G);
            T_B[d * 128 + tA] = fexp(gs.G - M0); T_B[d * 128 + tB] = fexp(gs.G - M1);
            T_WI[d * 128 + tA] = fexp(pmp - M0); T_WI[d * 128 + tB] = fexp(pmp - M1);
            T_FL[d * 128 + tA] = fexp(-(gs.b0 + M0)); T_FL[d * 128 + tB] = fexp(-(gs.b1 + M1)); }
#pragma unroll
        for (int i = 0; i < 4; ++i) { const int id = tid + 512 * i; *(LAS u32x4*)(imgK + img_off_r((unsigned)(id >> 4), (unsigned)(id & 15))) = pk[i]; }
        bf16x8 qf[4];
#pragma unroll
        for (int ks = 0; ks < 4; ++ks) qf[ks] = pq[ks];
#define QSEL(ks) ((ks) == 0 ? qf[0] : ((ks) == 1 ? qf[1] : ((ks) == 2 ? qf[2] : qf[3])))
        __syncthreads();
        f32x4 S[8];
#pragma unroll
        for (int ni = 0; ni < 8; ++ni) S[ni] = (f32x4){0.f, 0.f, 0.f, 0.f};
#pragma unroll 1
        for (int ks = 0; ks < 4; ++ks)
            { const bf16x8 qk = QSEL(ks);
#pragma unroll
              for (int ni = 0; ni < 8; ++ni) { const bf16x8 kf = frag_rowr(imgK, lane, ni, ks); S[ni] = __builtin_amdgcn_mfma_f32_16x16x32_bf16(kf, qk, S[ni], 0, 0, 0); } }
#pragma unroll
        for (int i = 0; i < 4; ++i) { const int id = tid + 512 * i; const unsigned r = (unsigned)(id >> 4), ch = (unsigned)(id & 15);
            *(LAS u32x4*)(imgV + img_off(r, ch)) = pv[i]; *(LAS u32x4*)(imgC0 + img_off_r(r, ch)) = pcf[i]; *(LAS u32x4*)(imgC1 + img_off_r(r, ch)) = pcb[i]; }
        if (tid < 32) { u32x4 w; w.x = cvt_pk_bf16(pn0[0], pn0[1]); w.y = cvt_pk_bf16(pn0[2], pn0[3]); w.z = cvt_pk_bf16(pn1[0], pn1[1]); w.w = cvt_pk_bf16(pn1[2], pn1[3]);
            *(LAS u32x4*)(((tid >> 4) ? imgC1 : imgC0) + img_off_r(128u, (unsigned)(tid & 15))) = w; }
        __syncthreads();
        f32x4 hs[8]; u32x2 ow4[8];
#pragma unroll
        for (int ni = 0; ni < 8; ++ni) hs[ni] = (f32x4){0.f, 0.f, 0.f, 0.f};
#pragma unroll
        for (int d = 0; d < 2; ++d) {
            const LAS unsigned char* imgC = d ? imgC1 : imgC0;
            const float Bt = T_B[d * 128 + t_loc], wi = T_WI[d * 128 + t_loc]; float rs = 0.f;
#pragma unroll
            for (int ni = 0; ni < 8; ++ni) if (d == 0 ? ((ni >> 1) <= (wave >> 1)) : ((ni >> 1) >= (wave >> 1))) { const int s0 = 16 * ni + 4 * fq; const f32x4 a4 = *(const LAS f32x4*)(T_A + d * 128 + s0); float sp[4];
#pragma unroll
                for (int j = 0; j < 4; ++j) { const int sidx = s0 + j; const bool ok = d == 0 ? (sidx <= t_loc) : (sidx >= t_loc); const float w = ok ? a4[j] * Bt : 0.f; sp[j] = S[ni][j] * w; rs += sp[j]; }
                u32x2 w2; w2.x = cvt_pk_bf16(sp[0], sp[1]); w2.y = cvt_pk_bf16(sp[2], sp[3]);
                *(LAS u32x2*)(imgK + img_off_r((unsigned)t_loc, (unsigned)(s0 >> 3)) + 2 * (s0 & 7)) = w2; }
            rs += shx(rs, 16, lane); rs += shx(rs, 32, lane);
            asm volatile("s_waitcnt lgkmcnt(0)" ::: "memory");
            f32x4 acc[9];
#pragma unroll
            for (int ni = 0; ni < 9; ++ni) acc[ni] = (f32x4){0.f, 0.f, 0.f, 0.f};
#pragma unroll 1
            for (int ks = 0; ks < 4; ++ks)
                { const bf16x8 qk = QSEL(ks);
#pragma unroll
                  for (int ni = 0; ni < 9; ++ni) { const bf16x8 cf = frag_rowr(imgC, lane, ni, ks); acc[ni] = __builtin_amdgcn_mfma_f32_16x16x32_bf16(cf, qk, acc[ni], 0, 0, 0); } }
            float qn = (acc[8][0] + acc[8][1]) + (acc[8][2] + acc[8][3]); qn += shx(qn, 16, lane); qn += shx(qn, 32, lane);
#pragma unroll
            for (int ni = 0; ni < 8; ++ni) acc[ni] = acc[ni] * wi;
#pragma unroll 1
            for (int ks = 0; ks < 4; ++ks) if (d == 0 ? (ks <= (wave >> 1)) : (ks >= (wave >> 1))) { const bf16x8 sf = frag_rowr(imgK, lane, wave, ks);
#pragma unroll
                for (int ni = 0; ni < 8; ++ni) { const bf16x8 vf = frag_tr(imgV, lane, ni, ks); acc[ni] = __builtin_amdgcn_mfma_f32_16x16x32_bf16(vf, sf, acc[ni], 0, 0, 0); } }
            const float den = wi * qn + rs, rinv = __builtin_amdgcn_rcpf(fmaxf(fabsf(den), T_FL[d * 128 + t_loc]));
#pragma unroll
            for (int ni = 0; ni < 8; ++ni) hs[ni] = hs[ni] + acc[ni] * rinv;
            if (d == 0) {
#pragma unroll
                for (int ni = 0; ni < 8; ++ni) ow4[ni] = *(const u32x2*)(U + (size_t)(row0 + t_loc) * NU + UC_O + 128 * h + 16 * ni + 4 * fq); }
        }
        float ss = 0.f;
#pragma unroll
        for (int ni = 0; ni < 8; ++ni) { const f32x4 v = hs[ni]; ss += (v[0] * v[0] + v[1] * v[1]) + (v[2] * v[2] + v[3] * v[3]); }
        ss += shx(ss, 16, lane); ss += shx(ss, 32, lane);
        const float rstd = __builtin_amdgcn_rsqf(ss * (1.0f / DH) + EPS);
#pragma unroll
        for (int ni = 0; ni < 8; ++ni) { const int vd0 = 16 * ni + 4 * fq; const u32x2 ow = ow4[ni];
            const f32x4 gh = *(const f32x4*)(ghead + h * DH + vd0); const f32x4 v = hs[ni];
            const float o0 = bf_lo(ow.x), o1 = bf_hi(ow.x), o2 = bf_lo(ow.y), o3 = bf_hi(ow.y);
            const float A0 = 1.0f + fexp(-o0), A1 = 1.0f + fexp(-o1), A2 = 1.0f + fexp(-o2), A3 = 1.0f + fexp(-o3);
            const float r01 = __builtin_amdgcn_rcpf(A0 * A1) * rstd, r23 = __builtin_amdgcn_rcpf(A2 * A3) * rstd;
            const float y0 = v[0] * gh[0] * (A1 * r01), y1 = v[1] * gh[1] * (A0 * r01), y2 = v[2] * gh[2] * (A3 * r23), y3 = v[3] * gh[3] * (A2 * r23);
            u32x2 w; w.x = cvt_pk_bf16(y0, y1); w.y = cvt_pk_bf16(y2, y3);
            *(u32x2*)(H + (size_t)(row0 + t_loc) * D + 512 + 128 * h + vd0) = w; }
        __syncthreads();
    }
#undef QSEL
#undef C2_DECODE
#undef C2_PRE1
#undef C2_PREQ
#undef C2_PRE2
}

__device__ __forceinline__ void ph_conv(const Args& a, int L, int vcu, int G, int wave, int lane) {
    unsigned char* ws = a.ws; const bf16* U = (const bf16*)(ws + WS_U); bf16* H = (bf16*)a.out;
    const float* cw = a.in[IN_CONVW] + L * 3 * 512 + 8 * lane; const float* cbp = a.in[IN_CONVB] + L * 512 + 8 * lane;
    float w0[8], w1[8], w2[8], bb[8];
#pragma unroll
    for (int e = 0; e < 8; ++e) { w0[e] = cw[e]; w1[e] = cw[512 + e]; w2[e] = cw[1024 + e]; bb[e] = cbp[e]; }
    const int nrows = (L == DEPTH - 1) ? NLAT : NTOK;
    for (int rowb = vcu * 8 + wave; rowb < nrows; rowb += G * 8 * 4) {
        u32x4 bv[4], c0[4], cl[4], cr[4];
#pragma unroll
        for (int i = 0; i < 4; ++i) { const int row = rowb + i * G * 8; const bool act = row < nrows; const int rw = act ? row : rowb;
            bool lv, rv; if (rw < NLAT) { const int t = rw & 63; lv = t != 0; rv = t != 63; } else { const int t = (rw - NLAT) & 255; lv = t != 0; rv = t != 255; }
            const bf16* rp = U + (size_t)rw * NU + 8 * lane;
            const u32x4 zb = {0u, 0u, 0u, 0u};
            bv[i] = *(const u32x4*)(rp + UC_B); c0[i] = *(const u32x4*)(rp + UC_CX);
            cl[i] = lv ? *(const u32x4*)(rp - NU + UC_CX) : zb;
            cr[i] = rv ? *(const u32x4*)(rp + NU + UC_CX) : zb; }
#pragma unroll
        for (int i = 0; i < 4; ++i) { const int row = rowb + i * G * 8;
            float y[8];
#pragma unroll
            for (int q = 0; q < 4; ++q) {
                y[2 * q] = bf_lo(bv[i][q]) * (w0[2 * q] * bf_lo(cl[i][q]) + w1[2 * q] * bf_lo(c0[i][q]) + w2[2 * q] * bf_lo(cr[i][q]) + bb[2 * q]);
                y[2 * q + 1] = bf_hi(bv[i][q]) * (w0[2 * q + 1] * bf_hi(cl[i][q]) + w1[2 * q + 1] * bf_hi(c0[i][q]) + w2[2 * q + 1] * bf_hi(cr[i][q]) + bb[2 * q + 1]); }
            u32x4 o; o.x = cvt_pk_bf16(y[0], y[1]); o.y = cvt_pk_bf16(y[2], y[3]); o.z = cvt_pk_bf16(y[4], y[5]); o.w = cvt_pk_bf16(y[6], y[7]);
            if (row < nrows) *(u32x4*)(H + (size_t)row * D + 8 * lane) = o; }
    }
}

__device__ __forceinline__ int block_sum(int v, LAS int* sh, int& par, int wave, int lane) {
    if (lane == 0) sh[par * 8 + wave] = v;
    __syncthreads();
    int s = 0;
#pragma unroll
    for (int w = 0; w < 8; ++w) s += sh[par * 8 + w];
    par ^= 1;
    return s;
}
__device__ __forceinline__ int block_excl_scan(int v, int& total, LAS int* sh, int& par, int wave, int lane) {
    int inc = v;
#pragma unroll
    for (int s = 1; s < 64; s <<= 1) { const int t = shi(inc, lane >= s ? lane - s : lane); if (lane >= s) inc += t; }
    if (lane == 63) sh[par * 8 + wave] = inc;
    __syncthreads();
    int pre = 0, tot = 0;
#pragma unroll
    for (int w = 0; w < 8; ++w) { const int x = sh[par * 8 + w]; tot += x; if (w < wave) pre += x; }
    par ^= 1; total = tot;
    return pre + inc - v;
}
__device__ __forceinline__ void ph_topk(const Args& a, int L, LAS unsigned char* lds, int vcu, int G, int tid, int wave, int lane) {
    unsigned char* ws = a.ws; const float* afft = (const float*)(ws + WS_AFFT);
    int* idx = (int*)(ws + WS_IDX); float* gsel = (float*)(ws + WS_GSEL); int* inv = (int*)(ws + WS_INV);
    LAS int* sh = (LAS int*)lds; int par = 0;
    const int nitems = (L == 0) ? 256 : 128;
    for (int item = vcu; item < nitems; item += G) {
        const bool lat = item < 128; const int b = (item & 127) >> 4, e = item & 15;
        const int n = lat ? SEQ : CTXL, k = lat ? CAP_L : CAP_C, tok0 = lat ? b * SEQ : NLAT + b * CTXL;
        const int slot0 = lat ? (e * NB + b) * CAP_L : NSLOT_L + (e * NB + b) * CAP_C;
        const float* av = afft + (size_t)e * NTOK + tok0;
        unsigned v[16];
        if (tid * 16 < n) {
#pragma unroll
            for (int q = 0; q < 4; ++q) { const f32x4 x = *(const f32x4*)(av + tid * 16 + 4 * q); v[4 * q] = __float_as_uint(x.x); v[4 * q + 1] = __float_as_uint(x.y); v[4 * q + 2] = __float_as_uint(x.z); v[4 * q + 3] = __float_as_uint(x.w); }
        } else {
#pragma unroll
            for (int j = 0; j < 16; ++j) v[j] = 0u;
        }
        unsigned T = 0u;
        for (int bit = 28; bit >= 0; bit -= 2) { const unsigned c1 = T | (1u << bit), c2 = T | (2u << bit), c3 = T | (3u << bit); int n1 = 0, n2 = 0, n3 = 0;
#pragma unroll
            for (int j = 0; j < 16; ++j) { n1 += (int)__popcll(__ballot(v[j] >= c1)); n2 += (int)__popcll(__ballot(v[j] >= c2)); n3 += (int)__popcll(__ballot(v[j] >= c3)); }
            if (lane == 0) { sh[64 + par * 32 + wave * 4] = n1; sh[64 + par * 32 + wave * 4 + 1] = n2; sh[64 + par * 32 + wave * 4 + 2] = n3; }
            __syncthreads();
            int s1 = 0, s2 = 0, s3 = 0;
#pragma unroll
            for (int w = 0; w < 8; ++w) { s1 += sh[64 + par * 32 + w * 4]; s2 += sh[64 + par * 32 + w * 4 + 1]; s3 += sh[64 + par * 32 + w * 4 + 2]; }
            par ^= 1;
            T = s3 >= k ? c3 : (s2 >= k ? c2 : (s1 >= k ? c1 : T)); }
        int gtc = 0, eqc = 0;
#pragma unroll
        for (int j = 0; j < 16; ++j) { gtc += (v[j] > T) ? 1 : 0; eqc += (v[j] == T) ? 1 : 0; }
        int tot_gt, tot_eq;
        (void)block_excl_scan(gtc, tot_gt, sh, par, wave, lane);
        int eq_before = block_excl_scan(eqc, tot_eq, sh, par, wave, lane);
        const int need_eq = k - tot_gt;
        unsigned selmask = 0u; int nsel = 0;
#pragma unroll
        for (int j = 0; j < 16; ++j) { bool s = v[j] > T; if (v[j] == T) { s = eq_before < need_eq; ++eq_before; } if (s) { selmask |= 1u << j; ++nsel; } }
        int tot_sel; int pos = block_excl_scan(nsel, tot_sel, sh, par, wave, lane);
        if (tid * 16 < n) {
            int iw[16];
#pragma unroll
            for (int j = 0; j < 16; ++j) { const int tok = tok0 + tid * 16 + j;
                if (selmask & (1u << j)) { const int slot = slot0 + pos; ++pos; idx[slot] = tok; gsel[slot] = __uint_as_float(v[j]); iw[j] = slot; }
                else iw[j] = -1; }
            int4* ip = (int4*)(inv + (size_t)e * NTOK + tok0 + tid * 16);
#pragma unroll
            for (int q = 0; q < 4; ++q) ip[q] = make_int4(iw[4 * q], iw[4 * q + 1], iw[4 * q + 2], iw[4 * q + 3]);
        }
    }
}
constexpr int PH_PER_LAYER = 12, N_PHASES = 1 + DEPTH * PH_PER_LAYER;
__global__ void __launch_bounds__(512, 2) mk_fwd(Args args) {
    extern __shared__ __attribute__((aligned(16))) unsigned char lds_raw[];
    LAS unsigned char* lds = (LAS unsigned char*)lds_raw;
    const int tid0 = threadIdx.x;
    const int G = gridDim.x; const int bx = blockIdx.x; const int vcu = (G % 8 == 0) ? (bx % 8) * (G / 8) + bx / 8 : bx;
    volatile LAS unsigned* MISC = (volatile LAS unsigned*)(lds + MISC_OFF);
    if (tid0 < 64) MISC[tid0] = 0u;
    __syncthreads();
    const int wv0 = __builtin_amdgcn_readfirstlane(tid0 >> 6);
#define LANE0() ({ int l_; asm volatile("v_mbcnt_lo_u32_b32 %0, -1, 0\n\tv_mbcnt_hi_u32_b32 %0, -1, %0" : "=v"(l_)); l_; })
    XcdBarrier bar = xcd_barrier_post((unsigned*)(args.ws + WS_CTL) + 4096, MISC + 8, tid0 == 0);
    const int lo = args.ph_lo, hi = args.ph_hi;
#define CAS __attribute__((address_space(4)))
#define OPQ() const CAS Args* ap_ = (const CAS Args*)__builtin_amdgcn_kernarg_segment_ptr(); asm volatile("" : "+s"(ap_)); Args A; \
    _Pragma("unroll") for (int i_ = 0; i_ < 19; ++i_) A.in[i_] = (const float*)(const GAS float*)(ap_->in[i_]); \
    A.out = (float*)(GAS float*)(ap_->out); A.ws = (unsigned char*)(GAS unsigned char*)(ap_->ws); A.ph_lo = 0; A.ph_hi = 0; unsigned char* ws = A.ws; (void)ws; \
    int tid = wv0 * 64 + LANE0(); asm volatile("" : "+v"(tid)); const int lane = tid & 63, wave = __builtin_amdgcn_readfirstlane(tid >> 6); (void)lane; (void)wave
#ifndef MK_PHMASK
#define MK_PHMASK 0x1fff
#endif
#define EN(p) (((MK_PHMASK) >> (p)) & 1)
#ifndef MK_REPMASK
#define MK_REPMASK 0
#endif
#define REP(p) for (int rep_ = 0; rep_ <= (((MK_REPMASK) >> (p)) & 1); ++rep_, __syncthreads())
#define IN(k) (lo <= (k) && (k) < hi)
#ifndef MK_STAMP
#define MK_STAMP 0
#endif
#ifndef MK_STAMP_A
#define MK_STAMP_A 4
#define MK_STAMP_B 12
#endif
#define SEAM(k) do { if (IN(k) && IN((k) + 1)) { { XcdBarrier b2_ = bar; asm volatile("" : "+s"(b2_.bar), "+s"(b2_.x)); xcd_barrier(b2_, wv0 == 0 && LANE0() == 0); } if (((MK_REPMASK) >> 14) & 1) xcd_barrier(bar, wv0 == 0 && LANE0() == 0); if (MK_STAMP && blockIdx.x == 0 && wv0 == 0 && LANE0() == 0 && (k) < 32) ((unsigned long long*)(args.ws + 524288))[(k)] = __builtin_amdgcn_s_memrealtime(); } } while (0)
#define GEMM_WITH_CVQ(GW_, QL_, K_, ...) do { unsigned* dn_ = cv_done_ctr(A, (K_)); if (bx < (GW_)) { __VA_ARGS__; if (wv0 == 0 && LANE0() == 0) (void)__hip_atomic_fetch_add(dn_, 1u, __ATOMIC_RELAXED, __HIP_MEMORY_SCOPE_AGENT); } \
        if ((QL_) >= 0) { cvq_pull(A, (QL_), lds, MISC, wv0, LANE0(), dn_, (unsigned)(GW_)); if ((QL_) == 0) cvq_pull(A, 1, lds, MISC, wv0, LANE0(), dn_, (unsigned)(GW_)); } } while (0)
    if (EN(12) && IN(0)) REP(12) { OPQ(); ph_prologue(A, lds, vcu, G, tid, wave, lane); __syncthreads(); ph_convert_static(A, 0, lds, vcu, G, wave, lane); }
    SEAM(0);
    for (int L = 0; L < DEPTH; ++L) {
        const int pb = 1 + L * PH_PER_LAYER;
        if (L == 0) { if (EN(0) && IN(pb + 0)) REP(0) { OPQ(); ph_prepass1_l0(A, lds, vcu, G, tid, wave, lane); }
            SEAM(pb + 0); }
        if (EN(1) && IN(pb + 1)) REP(1) { OPQ(); const int GW = (G == 256) ? 248 : G;
            GEMM_WITH_CVQ(GW, L, 4 * L + 0, { pg8::Gemm g{(const bf16*)A.out, (const bf16*)(ws + WS_WIN), 1024}; pg8::Sched S; S.init(NTOK / 256, NG / 256, GW, bx, 0, 0, MK_WGM_IN);
                pg8::EpiU E{(bf16*)(ws + WS_U), NU}; pg8::gemm_phase<pg8::EpiU>(lds, g, S, E, tid); }); }
        SEAM(pb + 1);
        if (EN(2) && IN(pb + 2)) REP(2) { OPQ(); ph_mlstm_a(A, lds, vcu, G, tid, wave, lane); }
        SEAM(pb + 2);
        if (EN(3) && IN(pb + 3)) REP(3) { OPQ(); ph_scan(A, lds, vcu, G, tid); }
        SEAM(pb + 3);
        if (EN(4) && IN(pb + 4)) REP(4) { OPQ(); for (int r2_ = 0; r2_ <= (((MK_REPMASK) >> 15) & 1); ++r2_) ph_mlstm_c2(A, L, lds, vcu, G, tid, wave, lane); for (int r3_ = 0; r3_ <= (((MK_REPMASK) >> 16) & 1); ++r3_) ph_conv(A, L, vcu, G, wave, LANE0()); }
        SEAM(pb + 4);
        if (EN(5) && IN(pb + 5)) for (int rep_ = 0; rep_ <= ((((MK_REPMASK) >> 13) & 1) && L == 0 ? 1 : 0); ++rep_, __syncthreads()) { OPQ(); const int GW = (G == 256 && L == 0) ? 216 : G;
            GEMM_WITH_CVQ(GW, (L == 0 ? 0 : -1), 4 * L + 1, { pg8::Gemm g{(const bf16*)A.out, (const bf16*)(ws + WS_WOUT), 1024}; pg8::Sched S; S.init((L == DEPTH - 1 ? NLAT : NTOK) / 256, 4, GW, bx, 0, 1);
                pg8::EpiRes E{(bf16*)(ws + WS_XB), (bf16*)(ws + WS_XC), (const float*)(ws + WS_MODV) + (size_t)L * 9 * 6144};
                pg8::gemm_phase<pg8::EpiRes>(lds, g, S, E, tid); }); }
        SEAM(pb + 5);
        if (EN(6) && IN(pb + 6)) REP(6) { OPQ(); ph_prepass2(A, L, lds, vcu, G, tid, wave, lane); }
        SEAM(pb + 6);
        if (EN(7) && IN(pb + 7)) REP(7) { OPQ(); cvq_pull(A, L, lds, MISC, wave, lane, nullptr, 0u); __syncthreads();
            ph_topk(A, L, lds, vcu, G, tid, wave, lane); }
        SEAM(pb + 7);
        if (EN(9) && IN(pb + 9)) REP(9) { OPQ();
            GEMM_WITH_CVQ(G, (L == 0 ? 1 : -1), 4 * L + 2, { pg8::Gemm g{(const bf16*)((const unsigned char*)A.out + OUT_H8), (const bf16*)(ws + (L ? WS_WGU1 : WS_WGU)), 512}; pg8::Sched S; S.init((L == 0 ? NSLOT : NSLOT_L) / 256, 11, G, bx, 1, 0, MK_WGM_GU);
                pg8::EpiGU8 E{ws + WS_HM}; pg8::gemm_phase<pg8::EpiGU8, true, true>(lds, g, S, E, tid, (const int*)(ws + WS_IDX)); }); }
        SEAM(pb + 9);
        if (EN(10) && IN(pb + 10)) REP(10) { OPQ(); const int GW = (G == 256 && L == 0) ? 240 : G;
            GEMM_WITH_CVQ(GW, (L == 0 ? 1 : -1), 4 * L + 3, { pg8::Gemm g{(const bf16*)(ws + WS_HM), (const bf16*)(ws + (L ? WS_WD1 : WS_WD)), DEP / 2}; pg8::Sched S; S.init((L == 0 ? NSLOT : NSLOT_L) / 256, 4, GW, bx, 1, 1);
                pg8::EpiD E{ws + WS_XE}; pg8::gemm_phase<pg8::EpiD, false, true, true>(lds, g, S, E, tid); }); }
        SEAM(pb + 10);
        if (EN(11) && IN(pb + 11)) REP(11) { OPQ(); ph_combine(A, L, lds, vcu, G, tid, wave, lane);
            if (L + 1 < DEPTH) { __syncthreads(); ph_convert_static(A, L + 1, lds, vcu, G, wave, lane); } }
        SEAM(pb + 11);
    }
#if MK_STAMP
    xcd_barrier(bar, wv0 == 0 && LANE0() == 0);
    { const unsigned long long* ts = (const unsigned long long*)(args.ws + 524288);
      const float usA = (float)(ts[MK_STAMP_A] - ts[MK_STAMP_A - 1]) * 0.01f, usB = (float)(ts[MK_STAMP_B] - ts[MK_STAMP_B - 1]) * 0.01f;
      const float cA = sqrtf(usA * 0.25f);
      for (size_t i = (size_t)blockIdx.x * 512 + wv0 * 64 + LANE0(); i < (size_t)NLAT * D; i += (size_t)gridDim.x * 512) args.out[i] = (i == 0) ? usB : cA; }
#endif
#undef IN
#undef SEAM
}

extern "C" void kernel_launch(void* const* d_in, const int* in_sizes, int n_in, void* d_out, int out_size, void* d_ws, size_t ws_size, hipStream_t stream) {
    static int grid = 0;
    if (grid == 0) {
        if (n_in != 19 || out_size != NLAT * D || ws_size < WS_END) { fprintf(stderr, "kernel_launch: unexpected problem (n_in %d, out %d, ws %zu < %zu)\n", n_in, out_size, ws_size, (size_t)WS_END); grid = -1; return; }
        int dev = 0, cus = 0, per_cu = 0;
        if (hipGetDevice(&dev) != hipSuccess || hipDeviceGetAttribute(&cus, hipDeviceAttributeMultiprocessorCount, dev) != hipSuccess) { grid = -1; return; }
        if (hipFuncSetAttribute((const void*)mk_fwd, hipFuncAttributeMaxDynamicSharedMemorySize, LDS_BYTES) != hipSuccess) { fprintf(stderr, "kernel_launch: hipFuncSetAttribute failed\n"); grid = -1; return; }
        if (hipOccupancyMaxActiveBlocksPerMultiprocessor(&per_cu, (const void*)mk_fwd, 512, LDS_BYTES) != hipSuccess || per_cu < 1) fprintf(stderr, "kernel_launch: occupancy query says %d\n", per_cu);
        (void)hipGetLastError();
        grid = cus;
    }
    if (grid < 0) return;
    (void)hipMemsetAsync((char*)d_ws + WS_CTL, 0, CTL_ZERO_BYTES, stream);
    Args a{};
    for (int i = 0; i < 19; ++i) a.in[i] = (const float*)d_in[i];
    a.out = (float*)d_out; a.ws = (unsigned char*)d_ws;
#if MK_ONE_LAUNCH
#ifndef MK_PARTIAL
#define MK_PARTIAL 0
#endif
    if (MK_PARTIAL > 0) { a.ph_lo = 0; a.ph_hi = MK_PARTIAL; hipLaunchKernelGGL(mk_fwd, dim3(grid), dim3(512), LDS_BYTES, stream, a); (void)hipMemsetAsync((char*)d_ws + WS_CTL, 0, CTL_ZERO_BYTES, stream); }
    a.ph_lo = 0; a.ph_hi = N_PHASES;
    hipLaunchKernelGGL(mk_fwd, dim3(grid), dim3(512), LDS_BYTES, stream, a);
#else
    for (int p = 0; p < N_PHASES; ++p) { a.ph_lo = p; a.ph_hi = p + 1; hipLaunchKernelGGL(mk_fwd, dim3(grid), dim3(512), LDS_BYTES, stream, a); }
#endif
}
```
